# Optimizing an MI355X kernel written in HIP

```python
import math
import jax, jax.numpy as jnp
from jax import lax
import numpy as np

D_MODEL = 2048
BATCH = 4
SEQ = 2048
DEPTH = 4

CTX_LEN = 256
GRID_W = 64
N_MIXERS = 3
Q_BLOCK = 128
ROPE_THETA = 10000.0
EPS = 1e-6

A_HEADS = 16
A_KV_HEADS = 4
A_HEAD_DIM = 128
A_WIDTH = A_HEADS * A_HEAD_DIM
A_KV_WIDTH = A_KV_HEADS * A_HEAD_DIM
A_IN = 2 * A_WIDTH + 2 * A_KV_WIDTH

B_HEADS = 8
B_HEAD_DIM = 128
B_WIDTH = B_HEADS * 2 * B_HEAD_DIM
B_IN = 4 * B_WIDTH

C_WIDTH = D_MODEL
C_BLOCKS = 8
C_BLOCK_DIM = C_WIDTH // C_BLOCKS
CONV_W = 4
CONV_LEFT = 2
LRU_C = 8.0

kernel_name = 'hybrid_gqa_diffattn_rglru_dit'


def _n_slots(m):
    return (DEPTH - m + N_MIXERS - 1) // N_MIXERS


def _rms(x, g):
    xf = x.astype(jnp.float32)
    y = xf * lax.rsqrt(jnp.mean(xf * xf, axis=-1, keepdims=True) + EPS)
    return (y * g.astype(jnp.float32)).astype(x.dtype)


def _ada(cvec, w, b):
    m = jax.nn.silu(cvec) @ w + b
    return jnp.split(m, 3, axis=-1)


def _axial_rope_tables(rows, dtype):
    row = jnp.repeat(jnp.arange(rows, dtype=jnp.float32), GRID_W)
    col = jnp.tile(jnp.arange(GRID_W, dtype=jnp.float32), rows)
    half = A_HEAD_DIM // 4
    freqs = ROPE_THETA ** (-jnp.arange(half, dtype=jnp.float32) / half)
    ang_r = row[:, None] * freqs
    ang_c = col[:, None] * freqs
    return tuple(t.astype(dtype) for t in (jnp.cos(ang_r), jnp.sin(ang_r), jnp.cos(ang_c), jnp.sin(ang_c)))


def _rot_half(x, cos, sin):
    x1, x2 = jnp.split(x, 2, axis=-1)
    cos = cos[:, None, :]
    sin = sin[:, None, :]
    return jnp.concatenate([x1 * cos - x2 * sin, x1 * sin + x2 * cos], axis=-1)


def _axial_rope(x, tabs):
    cr, sr, cc, sc = tabs
    xr, xcol = jnp.split(x, 2, axis=-1)
    return jnp.concatenate([_rot_half(xr, cr, sr), _rot_half(xcol, cc, sc)], axis=-1)


def _block_sweep(fn, q):
    bn, s = q.shape[0], q.shape[1]
    nb = s // Q_BLOCK
    qb = jnp.moveaxis(q.reshape((bn, nb, Q_BLOCK) + q.shape[2:]), 1, 0)
    out = jnp.moveaxis(lax.map(fn, qb), 0, 1)
    return out.reshape((bn, s) + out.shape[3:])


def _gqa_attend(q, k, v):
    s = jnp.einsum('bqgrd,bkgd->bgrqk', q, k, preferred_element_type=jnp.float32)
    p = jax.nn.softmax(s, axis=-1).astype(v.dtype)
    return jnp.einsum('bgrqk,bkgd->bqgrd', p, v)


def _mixer_gqa(h, hc, w_in, q_g, k_g, w_out, tabs, need_ctx):
    bn, s, _ = h.shape
    g, r, hd = A_KV_HEADS, A_HEADS // A_KV_HEADS, A_HEAD_DIM
    scale = hd ** -0.5

    def split(u):
        n = u.shape[1]
        q, k, v, z = jnp.split(u, [A_WIDTH, A_WIDTH + A_KV_WIDTH, A_WIDTH + 2 * A_KV_WIDTH], axis=-1)
        q = _rms(q.reshape(bn, n, A_HEADS, hd), q_g)
        k = _rms(k.reshape(bn, n, g, hd), k_g)
        return q, k, v.reshape(bn, n, g, hd), z

    q, k, v, z = split(h @ w_in)
    qc, kc, vc, zc = split(hc @ w_in)
    q = _axial_rope(q, tabs) * scale
    k = _axial_rope(k, tabs)
    k_all = jnp.concatenate([kc, k], axis=1)
    v_all = jnp.concatenate([vc, v], axis=1)

    def blk(qb):
        o = _gqa_attend(qb.reshape(bn, Q_BLOCK, g, r, hd), k_all, v_all)
        return o.reshape(bn, Q_BLOCK, A_WIDTH)

    y = _block_sweep(blk, q)
    out = (y * jax.nn.silu(z)) @ w_out
    out_c = None
    if need_ctx:
        oc = _gqa_attend((qc * scale).reshape(bn, -1, g, r, hd), kc, vc).reshape(bn, -1, A_WIDTH)
        out_c = (oc * jax.nn.silu(zc)) @ w_out
    return out, out_c


def _mixer_diff(h, hc, w_in, lam_p, sub_g, w_out, lam_init, tabs, need_ctx):
    bn, s, _ = h.shape
    nh, hd = B_HEADS, B_HEAD_DIM
    scale = hd ** -0.5
    lam_p = lam_p.astype(jnp.float32)
    lam = (jnp.exp(jnp.sum(lam_p[0] * lam_p[1])) - jnp.exp(jnp.sum(lam_p[2] * lam_p[3])) + lam_init)

    def split(u):
        n = u.shape[1]
        q, k, v, z = jnp.split(u, 4, axis=-1)
        return (q.reshape(bn, n, 2, nh, hd), k.reshape(bn, n, 2, nh, hd),
                v.reshape(bn, n, nh, 2 * hd), z)

    def rope2(t):
        n = t.shape[1]
        return _axial_rope(t.reshape(bn, n, 2 * nh, hd), tabs).reshape(bn, n, 2, nh, hd)

    def diff_attend(qb, k_, v_):
        sc = jnp.einsum('bqmhd,bkmhd->bmhqk', qb, k_, preferred_element_type=jnp.float32)
        p = jax.nn.softmax(sc, axis=-1)
        pd = (p[:, 0] - lam * p[:, 1]).astype(v_.dtype)
        return jnp.einsum('bhqk,bkhe->bqhe', pd, v_)

    def head_out(o, z):
        o = _rms(o, sub_g) * (1.0 - lam_init)
        return (o.reshape(bn, -1, B_WIDTH) * jax.nn.silu(z)) @ w_out

    q, k, v, z = split(h @ w_in)
    qc, kc, vc, zc = split(hc @ w_in)
    q = rope2(q) * scale
    k = rope2(k)
    k_all = jnp.concatenate([kc, k], axis=1)
    v_all = jnp.concatenate([vc, v], axis=1)
    y = _block_sweep(lambda qb: diff_attend(qb, k_all, v_all), q)
    out = head_out(y, z)
    out_c = None
    if need_ctx:
        out_c = head_out(diff_attend(qc * scale, kc, vc), zc)
    return out, out_c


def _conv_centred(u, w, b):
    n = u.shape[1]
    up = jnp.pad(u, ((0, 0), (CONV_LEFT, CONV_W - 1 - CONV_LEFT), (0, 0)))
    acc = b
    for j in range(CONV_W):
        acc = acc + up[:, j:j + n] * w[j]
    return acc


def _blockdiag(u, w, b):
    ub = u.reshape(u.shape[:-1] + (C_BLOCKS, C_BLOCK_DIM))
    return jnp.einsum('bsnd,nde->bsne', ub, w).reshape(u.shape) + b


def _lru_coeffs(u, wa, ba, wx, bx, lam):
    uf = u.astype(jnp.float32)
    r = jax.nn.sigmoid(_blockdiag(uf, wa.astype(jnp.float32), ba.astype(jnp.float32)))
    i = jax.nn.sigmoid(_blockdiag(uf, wx.astype(jnp.float32), bx.astype(jnp.float32)))
    log_a = -LRU_C * r * jax.nn.softplus(-lam.astype(jnp.float32))
    a = jnp.exp(log_a)
    return a, jnp.sqrt(-jnp.expm1(2.0 * log_a)) * (i * uf)


def _linear_scan(a, bterm, h0, reverse):
    def comb(e1, e2):
        a1, b1 = e1
        a2, b2 = e2
        return a1 * a2, a2 * b1 + b2
    cum_a, cum_b = lax.associative_scan(comb, (a, bterm), axis=1, reverse=reverse)
    return cum_a * h0[:, None, :] + cum_b


def _mixer_rglru(h, hc, w_in, conv_w, conv_b, wa, ba, wx, bx, lam, w_out, need_ctx):
    bn = h.shape[0]
    u, z = jnp.split(h @ w_in, 2, axis=-1)
    uc, zc = jnp.split(hc @ w_in, 2, axis=-1)
    u = _conv_centred(u, conv_w, conv_b)
    uc = _conv_centred(uc, conv_w, conv_b)
    zero = jnp.zeros((bn, C_WIDTH), jnp.float32)
    y = None
    yc = None
    for d, rev in enumerate((False, True)):
        ac, bc = _lru_coeffs(uc, wa[d], ba[d], wx[d], bx[d], lam[d])
        hcs = _linear_scan(ac, bc, zero, rev)
        h_end = hcs[:, 0] if rev else hcs[:, -1]
        al, bl = _lru_coeffs(u, wa[d], ba[d], wx[d], bx[d], lam[d])
        hl = _linear_scan(al, bl, h_end, rev)
        y = hl if y is None else y + hl
        yc = hcs if yc is None else yc + hcs
    out = (y.astype(h.dtype) * jax.nn.silu(z)) @ w_out
    out_c = None
    if need_ctx:
        out_c = (yc.astype(h.dtype) * jax.nn.silu(zc)) @ w_out
    return out, out_c


def setup_inputs(seed: int = 0) -> dict:
    key = jax.random.key(seed)
    ks = iter(jax.random.split(key, 32))

    def nrm(shape, s):
        return jax.random.normal(next(ks), shape, jnp.float32) * s

    n_a, n_b, n_c = _n_slots(0), _n_slots(1), _n_slots(2)
    d = D_MODEL
    lam_u = jax.random.uniform(next(ks), (n_c, 2, C_WIDTH), jnp.float32, 0.9, 0.999)
    root = lam_u ** (1.0 / LRU_C)
    r_lam = jnp.log(root) - jnp.log1p(-root)
    return {
        'x': nrm((BATCH, SEQ, d), 1.0),
        'c': nrm((BATCH, d), 1.0),
        'ctx': nrm((BATCH, CTX_LEN, d), 1.0),
        'c_ctx': nrm((d,), 1.0),
        'ada_w': nrm((DEPTH, d, 3 * d), d ** -0.5),
        'ada_b': nrm((DEPTH, 3 * d), 0.02),
        'norm_g': 1.0 + nrm((DEPTH, d), 0.05),
        'norm_f': 1.0 + nrm((d,), 0.05),
        'a_w_in': nrm((n_a, d, A_IN), d ** -0.5),
        'a_q_g': 1.0 + nrm((n_a, A_HEAD_DIM), 0.05),
        'a_k_g': 1.0 + nrm((n_a, A_HEAD_DIM), 0.05),
        'a_w_out': nrm((n_a, A_WIDTH, d), A_WIDTH ** -0.5),
        'b_w_in': nrm((n_b, d, B_IN), d ** -0.5),
        'b_lam': nrm((n_b, 4, B_HEAD_DIM), 0.1),
        'b_sub_g': 1.0 + nrm((n_b, 2 * B_HEAD_DIM), 0.05),
        'b_w_out': nrm((n_b, B_WIDTH, d), B_WIDTH ** -0.5),
        'r_w_in': nrm((n_c, d, 2 * C_WIDTH), d ** -0.5),
        'r_conv_w': nrm((n_c, CONV_W, C_WIDTH), CONV_W ** -0.5),
        'r_conv_b': nrm((n_c, C_WIDTH), 0.02),
        'r_wa': nrm((n_c, 2, C_BLOCKS, C_BLOCK_DIM, C_BLOCK_DIM), C_BLOCK_DIM ** -0.5),
        'r_ba': nrm((n_c, 2, C_WIDTH), 0.02),
        'r_wx': nrm((n_c, 2, C_BLOCKS, C_BLOCK_DIM, C_BLOCK_DIM), C_BLOCK_DIM ** -0.5),
        'r_bx': nrm((n_c, 2, C_WIDTH), 0.02),
        'r_lam': r_lam,
        'r_w_out': nrm((n_c, C_WIDTH, d), C_WIDTH ** -0.5),
    }


def reference(x, c, ctx, c_ctx, ada_w, ada_b, norm_g, norm_f,
              a_w_in, a_q_g, a_k_g, a_w_out,
              b_w_in, b_lam, b_sub_g, b_w_out,
              r_w_in, r_conv_w, r_conv_b, r_wa, r_ba, r_wx, r_bx, r_lam, r_w_out):
    s = x.shape[1]
    rows = s // GRID_W
    tabs = _axial_rope_tables(rows, x.dtype)
    xc = ctx
    for i in range(DEPTH):
        need_ctx = i < DEPTH - 1
        sh, sc, gt = _ada(c, ada_w[i], ada_b[i])
        shc, scc, gtc = _ada(c_ctx, ada_w[i], ada_b[i])
        h = _rms(x, norm_g[i]) * (1.0 + sc[:, None, :]) + sh[:, None, :]
        hc = _rms(xc, norm_g[i]) * (1.0 + scc) + shc
        m, slot = i % N_MIXERS, i // N_MIXERS
        if m == 0:
            y, yc = _mixer_gqa(h, hc, a_w_in[slot], a_q_g[slot], a_k_g[slot], a_w_out[slot], tabs, need_ctx)
        elif m == 1:
            lam_init = 0.8 - 0.6 * math.exp(-0.3 * i)
            y, yc = _mixer_diff(h, hc, b_w_in[slot], b_lam[slot], b_sub_g[slot], b_w_out[slot],
                                lam_init, tabs, need_ctx)
        else:
            y, yc = _mixer_rglru(h, hc, r_w_in[slot], r_conv_w[slot], r_conv_b[slot], r_wa[slot], r_ba[slot],
                                 r_wx[slot], r_bx[slot], r_lam[slot], r_w_out[slot], need_ctx)
        x = x + gt[:, None, :] * y
        if need_ctx:
            xc = xc + gtc * yc
    return _rms(x, norm_f)
```

```cpp
#include <hip/hip_runtime.h>
#include <cstdio>
#include <cstdint>
#include <cmath>

#ifndef PH_MASK
#define PH_MASK 0x7ffff
#endif
#ifndef DUP_MASK
#define DUP_MASK 0
#endif
#ifndef DUP_SUB
#define DUP_SUB 0
#endif
#ifndef DUP_BAR
#define DUP_BAR 0
#endif
#ifndef TAIL_SPLIT
#define TAIL_SPLIT false
#endif
#ifndef MK_PER_PHASE
#define MK_PER_PHASE 0
#endif

constexpr int NB = 4, SEQ = 2048, CTXL = 256, DM = 2048, TT = SEQ + CTXL  , MROWS = NB * TT  ;
constexpr int A_IN = 5120, B_IN = 8192, R_IN = 4096;
constexpr float EPS = 1e-6f;
constexpr int CH = 32, NCH = TT / CH  , NCC = CTXL / CH  ;
constexpr float LAM_INIT1 = 0.35550906759096927f;

typedef unsigned short bf16_t;
typedef short bf16x8 __attribute__((ext_vector_type(8)));
typedef short s16x4 __attribute__((ext_vector_type(4)));
typedef float f32x4 __attribute__((ext_vector_type(4)));
typedef float f32x8 __attribute__((ext_vector_type(8)));
typedef float f32x16 __attribute__((ext_vector_type(16)));
typedef unsigned u32x4 __attribute__((ext_vector_type(4)));
typedef unsigned u32x2 __attribute__((ext_vector_type(2)));
#define LAS __attribute__((address_space(3)))
#define GAS __attribute__((address_space(1)))

__device__ __forceinline__ unsigned pk2(float lo, float hi) { unsigned r; asm("v_cvt_pk_bf16_f32 %0, %1, %2" : "=v"(r) : "v"(lo), "v"(hi)); return r; }
__device__ __forceinline__ unsigned f2bf(float f) { return pk2(f, 0.f) & 0xffffu; }
__device__ __forceinline__ float bflo(unsigned w) { return __uint_as_float(w << 16); }
__device__ __forceinline__ float bfhi(unsigned w) { return __uint_as_float(w & 0xffff0000u); }
__device__ __forceinline__ float bf1(bf16_t v) { return __uint_as_float((unsigned)v << 16); }
__device__ __forceinline__ unsigned cvt_pk_bf16(float lo, float hi) { unsigned r; asm volatile("v_cvt_pk_bf16_f32 %0, %1, %2" : "=v"(r) : "v"(lo), "v"(hi)); return r; }
__device__ __forceinline__ float frcp(float x) { return __builtin_amdgcn_rcpf(x); }
__device__ __forceinline__ float frsq(float x) { return __builtin_amdgcn_rsqf(x); }
__device__ __forceinline__ float fsqrt_(float x) { return __builtin_amdgcn_sqrtf(x); }
__device__ __forceinline__ float sigmoidf_(float x) { return frcp(1.0f + __expf(-x)); }
__device__ __forceinline__ float siluf_(float x) { return x * frcp(1.0f + __expf(-x)); }
template <int M> __device__ __forceinline__ float shx(float v) { return __int_as_float(__builtin_amdgcn_ds_swizzle(__float_as_int(v), (M << 10) | 0x1f)); }
__device__ __forceinline__ float wave_sum(float v) {
    v += shx<1>(v); v += shx<2>(v); v += shx<4>(v); v += shx<8>(v); v += shx<16>(v);
    auto rr = __builtin_amdgcn_permlane32_swap(__float_as_uint(v), __float_as_uint(v), false, false);
    return __uint_as_float(rr[0]) + __uint_as_float(rr[1]);
}

constexpr size_t MiB = 1u << 20;
constexpr size_t WS_CTL = 0, WS_MODS = 1 * MiB, CTL_ZERO_BYTES = 2 * MiB;
constexpr size_t WS_GM = 2 * MiB + 128 * 1024;
constexpr size_t WS_SHW = 2 * MiB + 512 * 1024;
constexpr size_t WS_SSQ = 282 * MiB;
constexpr size_t WS_FSQ = 281 * MiB;
constexpr size_t WS_SHWP = 568 * MiB;
constexpr size_t WS_TAB = 2 * MiB;
constexpr size_t WS_WA_IN = 4 * MiB, WS_WA_OUT = 44 * MiB, WS_WB_IN = 60 * MiB, WS_WB_OUT = 92 * MiB, WS_WR_IN = 100 * MiB, WS_WR_OUT = 116 * MiB, WS_WG = 124 * MiB;
constexpr size_t WS_X = 128 * MiB;
constexpr size_t WS_H = 200 * MiB;
constexpr size_t WS_Y = 236 * MiB;
constexpr size_t WS_AGG = 272 * MiB;
constexpr size_t WS_U = 284 * MiB;
constexpr size_t WS_OD = 428 * MiB;
constexpr size_t WS_UP = 356 * MiB;
constexpr size_t WS_SA = 392 * MiB;
constexpr size_t WS_AG16 = 536 * MiB;
constexpr size_t WS_CARRY = 556 * MiB;
constexpr size_t WS_SLAB = 568 * MiB;
constexpr size_t WS_DUMMY = 632 * MiB;
constexpr size_t WS_END = 536 * MiB;
constexpr int CW_BAR = 4096, CW_SEAM = 16384;

struct Args { const float* in[25]; float* out; unsigned char* ws; int ph_lo, ph_hi; };
typedef const __attribute__((address_space(4))) Args* CArgsP;
enum { I_X = 0, I_C, I_CTX, I_CCTX, I_ADAW, I_ADAB, I_NORMG, I_NORMF, I_AWIN, I_AQG, I_AKG, I_AWOUT, I_BWIN, I_BLAM, I_BSUBG, I_BWOUT,
       I_RWIN, I_RCONVW, I_RCONVB, I_RWA, I_RBA, I_RWX, I_RBX, I_RLAM, I_RWOUT };


__host__ __device__ __forceinline__ int qk_pi(int c) { return (c & 64) | (((c >> 2) & 1) << 5) | (((c >> 3) & 7) << 2) | (c & 3); }
__host__ __device__ __forceinline__ int qk_pi_inv(int e) { return (e & 64) | (((e >> 2) & 7) << 3) | (((e >> 5) & 1) << 2) | (e & 3); }

namespace pg8 {
constexpr int BM = 256, BK = 64, HALF = 128, HTB = HALF * BK * 2, STAGE_BYTES = 8 * HTB, NXCD = 8, WGM = 8;
__host__ __device__ __forceinline__ int lds_byte(int r, int c) { const int st = (r >> 4) * 2 + (c >> 5), rr = r & 15, cc = c & 31, ob = rr * 64 + cc * 2; return st * 1024 + (ob ^ (((ob >> 9) & 1) << 5)); }
__host__ __device__ __forceinline__ void stage_rc(int b, int& R, int& C) { const int st = b / 1024, sb = b % 1024, swz = sb ^ (((sb >> 9) & 1) << 5); R = (st >> 1) * 16 + swz / 64; C = (st & 1) * 32 + (swz % 64) / 2; }
__host__ __device__ __forceinline__ int perm32(int rho) { const int n = rho >> 4, i = rho & 15; return 8 * (i >> 2) + 4 * n + (i & 3); }

struct Unit { int pm, pn, acol, kofs, nt, kind; };

constexpr int GRID = 256;
template <int NM, int NN, int KT, int ROWMODE, int GATES, bool SPLIT> struct Sched {
    static constexpr int nM = NM, nN = NN, nwg = NM * NN, G = GRID, R = nwg / G, T = nwg - R * G;
    static constexpr int F0 = (!SPLIT || T == 0 || R == 0) ? 1 : (G / T >= 8 ? 8 : G / T >= 4 ? 4 : G / T >= 2 ? 2 : 1);
    static constexpr int F = (KT / F0 >= 4) ? F0 : (KT / (F0 / 2 > 0 ? F0 / 2 : 1) >= 4 ? (F0 / 2 > 0 ? F0 / 2 : 1) : 1);
    int c, v;
    __device__ void init(int c_, int v_) { c = c_; v = v_; }
    __device__ bool is_slice(int i) const { return F > 1 && i == R; }
    __device__ bool next(int i, Unit& u) const {
        long L; u.kofs = 0; u.nt = KT;
        if (i < R) L = (long)i * G + c;
        else if (i == R && T > 0) { if (F == 1) { L = (long)R * G + c; if (L >= nwg) return false; } else { if (v >= T * F) return false; const int tt = v / F, sj = v - tt * F; u.nt = KT / F; u.kofs = sj * u.nt * BK; L = (long)R * G + tt; } }
        else return false;
        int wgid = (int)L; { const int q = nwg / NXCD, r = nwg % NXCD, xcd = wgid % NXCD, off = wgid / NXCD; wgid = (xcd < r ? xcd * (q + 1) : r * (q + 1) + (xcd - r) * q) + off; }
        const int nig = WGM * nN, gid = wgid / nig, fm = gid * WGM, gsz = (nM - fm) < WGM ? (nM - fm) : WGM;
        int pm = fm + ((wgid % nig) % gsz); u.pn = (wgid % nig) / gsz;
        if (ROWMODE == 1) pm = 9 * (pm >> 3) + 1 + (pm & 7);
        u.pm = pm; u.acol = GATES ? 256 * (u.pn >> 2) : 0; return true;
    }
};

template <int NN, int KT, int CLO, int CHI> struct SchedM {
    static constexpr int G = GRID, NLAT = 32 * NN, NCX = 4 * (CHI - CLO), TOT = 32 + NLAT + NCX, R = TOT / G, T = TOT - R * G, F = 1;
    int c;
    __device__ void init(int c_, int) { c = c_; }
    __device__ bool is_slice(int) const { return false; }
    __device__ bool next(int i, Unit& u) const {
        const int L = i * G + c; if (L >= TOT) return false; u.kofs = 0; u.nt = KT; u.acol = 0;
        if (L < 32) { u.kind = 0; u.pm = 9 * (L >> 3); u.pn = L & 7; return true; }
        if (L < 32 + NLAT) { u.kind = 1; constexpr int nwg = NLAT; int wgid = L - 32; { constexpr int q = nwg / NXCD; const int xcd = wgid % NXCD, off = wgid / NXCD; wgid = xcd * q + off; }
            constexpr int nig = WGM * NN; const int gid = wgid / nig, fm = gid * WGM; const int pmi = fm + ((wgid % nig) % WGM); u.pn = (wgid % nig) / WGM; u.pm = 9 * (pmi >> 3) + 1 + (pmi & 7); return true; }
        const int r = L - 32 - NLAT; u.kind = 2; u.pm = 9 * (r / (CHI - CLO)); u.pn = CLO + r % (CHI - CLO); return true;
    }
};

__device__ __forceinline__ int opq(int x) { asm volatile("" : "+s"(x)); return x; }
constexpr int RSTD_OFF = 131072;
constexpr int SHWT_OFF = 147456;
constexpr int HSQ_OFF = 139264;
template <int LAYER, int N> struct EpiBf16 {
    unsigned char* ws; CArgsP ap;
    static constexpr int QKT = (LAYER == 1) ? 16 : (LAYER == 2) ? 0 : 10; static constexpr bool RMS = (LAYER != 1);
    template <class SchedT> __device__ __forceinline__ void prep(LAS unsigned char* lds, const SchedT& S, int tid) const {
        const float* ssq = (const float*)(ws + WS_SSQ); Unit u;
        for (int i = 0; i < 8 && S.next(i, u); ++i) if (tid < 256) { const f32x4* p4 = (const f32x4*)(ssq + (size_t)(u.pm * BM + tid) * 32); float s = 0.f;
#pragma unroll
            for (int j = 0; j < 8; ++j) { const f32x4 v = p4[j]; s += (v.x + v.y) + (v.z + v.w); }
            ((LAS float*)(lds + opq(RSTD_OFF)))[i * 256 + tid] = frsq(s * (1.0f / DM) + EPS); }
        else { const int t2 = tid - 256; const int bq = u.pm / 9, mr = (u.pm - 9 * bq) == 0 ? 4 : bq; float sv;
            if constexpr (LAYER <= 1) sv = ((const float*)(ws + WS_SHW))[(size_t)(LAYER * 5 + mr) * 8192 + u.pn * BM + t2];
            else { const float* pp = (const float*)(ws + WS_SHWP) + (size_t)(LAYER - 1) * 32 * 5 * 8192 + (size_t)mr * 8192 + u.pn * BM + t2; sv = 0.f;
                float pv[32];
#pragma unroll
                for (int kb = 0; kb < 32; ++kb) pv[kb] = pp[(size_t)kb * 5 * 8192];
#pragma unroll
                for (int kb = 0; kb < 32; ++kb) sv += pv[kb]; }
            ((LAS float*)(lds + opq(SHWT_OFF)))[i * 256 + t2] = sv; }
    }
    __device__ __forceinline__ void operator()(f32x4 (&acc)[2][2][4][2], const Unit& u, int ui, LAS unsigned char* lds, int wr, int wc, int tl_, unsigned gmask) const {
        unsigned char* w_ = ws; asm volatile("" : "+v"(tl_), "+s"(w_)); const int lane = tl_ & 63, fr = lane & 15, fq = lane >> 4;
        const int bq = u.pm / 9, pr_ = u.pm - 9 * bq, isctx = pr_ == 0;
        bf16_t* O = (bf16_t*)(w_ + WS_U);
        const int rl0 = wr * 64 + fr, row0 = u.pm * BM + rl0, col0 = u.pn * BM + wc * 32 + 8 * fq;
        const LAS float* rt = (const LAS float*)(lds + opq(RSTD_OFF)) + ui * 256 + rl0;
        f32x4 sv[2][2];
#pragma unroll
        for (int bj = 0; bj < 2; ++bj)
#pragma unroll
            for (int n = 0; n < 2; ++n) sv[bj][n] = *(const LAS f32x4*)((const LAS float*)(lds + opq(SHWT_OFF)) + ui * 256 + wc * 32 + 8 * fq + bj * HALF + 4 * n);
        if (QKT == 0 || u.pn >= QKT) {
#pragma unroll
            for (int ai = 0; ai < 2; ++ai)
#pragma unroll
                for (int m = 0; m < 4; ++m) { if (!((gmask >> (ai * 4 + m)) & 1u)) continue; bf16_t* rowp = O + (size_t)(row0 + ai * HALF + m * 16) * N + col0; const float rs = rt[ai * HALF + m * 16];
#pragma unroll
                    for (int bj = 0; bj < 2; ++bj) { const f32x4 v0 = acc[ai][bj][m][0] * rs + sv[bj][0], v1 = acc[ai][bj][m][1] * rs + sv[bj][1];
                        u32x4 w; w.x = cvt_pk_bf16(v0[0], v0[1]); w.y = cvt_pk_bf16(v0[2], v0[3]); w.z = cvt_pk_bf16(v1[0], v1[1]); w.w = cvt_pk_bf16(v1[2], v1[3]);
                        *(u32x4*)(rowp + bj * HALF) = w; } }
            return;
        }
        LAS float* hs = (LAS float*)(lds + opq(HSQ_OFF));
        if constexpr (RMS) {
#pragma unroll
            for (int ai = 0; ai < 2; ++ai)
#pragma unroll
                for (int m = 0; m < 4; ++m) { const int rl = rl0 + ai * HALF + m * 16; const float rs = rt[ai * HALF + m * 16];
#pragma unroll
                    for (int bj = 0; bj < 2; ++bj) { const f32x4 v0 = acc[ai][bj][m][0] * rs + sv[bj][0], v1 = acc[ai][bj][m][1] * rs + sv[bj][1];
                        float q = ((v0[0] * v0[0] + v0[1] * v0[1]) + (v0[2] * v0[2] + v0[3] * v0[3])) + ((v1[0] * v1[0] + v1[1] * v1[1]) + (v1[2] * v1[2] + v1[3] * v1[3]));
                        q += shx<16>(q); { auto rr = __builtin_amdgcn_permlane32_swap(__float_as_uint(q), __float_as_uint(q), false, false); q = __uint_as_float(rr[0]) + __uint_as_float(rr[1]); }
                        if (fq == 0) hs[rl * 8 + bj * 4 + wc] = q; } }
            asm volatile("s_waitcnt lgkmcnt(0)" ::: "memory"); __builtin_amdgcn_s_barrier(); asm volatile("" ::: "memory");
        }
        const int i16 = 4 * (wc & 1) + fq, hf = wc >> 1;
        f32x4 g0 = {1.f, 1.f, 1.f, 1.f}, g1 = g0;
        if constexpr (RMS) { const float* gg = ((u.pn < 8) ? ap->in[I_AQG] : ap->in[I_AKG]) + (LAYER == 3 ? 128 : 0) + 64 * hf + 4 * i16; g0 = *(const f32x4*)gg; g1 = *(const f32x4*)(gg + 32); }
        const float* tc = (const float*)(w_ + WS_TAB) + 4 * i16; const float* ts = tc + 96 * 32;
#pragma unroll
        for (int ai = 0; ai < 2; ++ai)
#pragma unroll
            for (int m = 0; m < 4; ++m) { if (!((gmask >> (ai * 4 + m)) & 1u)) continue; const int rl = rl0 + ai * HALF + m * 16; const float rs = rt[ai * HALF + m * 16];
                bf16_t* rowp = O + (size_t)(u.pm * BM + rl) * N + col0;
                f32x4 cs = {1.f, 1.f, 1.f, 1.f}, sn = {0.f, 0.f, 0.f, 0.f};
                if (!isctx) { const int tl = (pr_ - 1) * 256 + rl; const int pos = hf ? 32 + (tl & 63) : (tl >> 6); cs = *(const f32x4*)(tc + pos * 32); sn = *(const f32x4*)(ts + pos * 32); }
#pragma unroll
                for (int bj = 0; bj < 2; ++bj) { f32x4 x1 = acc[ai][bj][m][0] * rs + sv[bj][0], x2 = acc[ai][bj][m][1] * rs + sv[bj][1];
                    if constexpr (RMS) { const f32x4 pq = *(const LAS f32x4*)(hs + rl * 8 + bj * 4); const float rh = frsq(((pq[0] + pq[1]) + (pq[2] + pq[3])) * (1.0f / 128.0f) + EPS); x1 = x1 * rh * g0; x2 = x2 * rh * g1; }
                    const f32x4 y1 = x1 * cs - x2 * sn, y2 = x1 * sn + x2 * cs;
                    u32x4 w; w.x = cvt_pk_bf16(y1[0], y1[1]); w.y = cvt_pk_bf16(y1[2], y1[3]); w.z = cvt_pk_bf16(y2[0], y2[1]); w.w = cvt_pk_bf16(y2[2], y2[3]);
                    *(u32x4*)(rowp + bj * HALF) = w; } }
    }
};
template <int LAYER, bool DUP> struct EpiResid {
    unsigned char* ws; CArgsP ap;
    static constexpr bool NEXT = LAYER < 3;
    template <class SchedT> __device__ __forceinline__ void prep(LAS unsigned char*, const SchedT&, int) const {}
    __device__ __forceinline__ void operator()(f32x4 (&acc)[2][2][4][2], const Unit& u, int, LAS unsigned char* lds, int wr, int wc, int tl_, unsigned gmask) const {
        unsigned char* w_ = ws; asm volatile("" : "+v"(tl_), "+s"(w_)); const int lane = tl_ & 63, fr = lane & 15, fq = lane >> 4;
        const int bq = u.pm / 9, pr_ = u.pm - 9 * bq, isctx = pr_ == 0, mr = isctx ? 4 : bq;
        if constexpr (LAYER == 3 && !DUP) {
            const float* gt = (const float*)(w_ + WS_MODS) + (size_t)(LAYER * 5 + mr) * 6144 + 4096;
            const bf16_t* xbin = (const bf16_t*)(w_ + WS_X) + (size_t)u.pm * BM * DM;
            const int rl0 = wr * 64 + fr, col0 = u.pn * BM + wc * 32 + 8 * fq, lrow0 = bq * SEQ + (pr_ - 1) * 256;
            float* fsq = (float*)(w_ + WS_FSQ);
            f32x4 gv[2][2];
#pragma unroll
            for (int bj = 0; bj < 2; ++bj)
#pragma unroll
                for (int n = 0; n < 2; ++n) gv[bj][n] = *(const f32x4*)(gt + col0 + bj * HALF + 4 * n);
#pragma unroll
            for (int ai = 0; ai < 2; ++ai)
#pragma unroll
                for (int m = 0; m < 4; ++m) { const int rl = rl0 + ai * HALF + m * 16; const unsigned ro = (unsigned)(rl * DM + col0) * 4u; float sq = 0.f;
#pragma unroll
                    for (int bj = 0; bj < 2; ++bj) { const u32x4 bw = *(const u32x4*)((const char*)xbin + (ro >> 1) + bj * HALF * 2);
                        const f32x4 bs[2] = {(f32x4){bflo(bw.x), bfhi(bw.x), bflo(bw.y), bfhi(bw.y)}, (f32x4){bflo(bw.z), bfhi(bw.z), bflo(bw.w), bfhi(bw.w)}};
#pragma unroll
                        for (int n = 0; n < 2; ++n) { const f32x4 xn = bs[n] + gv[bj][n] * acc[ai][bj][m][n]; acc[ai][bj][m][n] = xn;
                            sq += (xn[0] * xn[0] + xn[1] * xn[1]) + (xn[2] * xn[2] + xn[3] * xn[3]); } }
                    sq += shx<16>(sq); { auto rr = __builtin_amdgcn_permlane32_swap(__float_as_uint(sq), __float_as_uint(sq), false, false); sq = __uint_as_float(rr[0]) + __uint_as_float(rr[1]); }
                    if (fq == 0) __hip_atomic_store(fsq + (size_t)(lrow0 + rl) * 32 + u.pn * 4 + wc, sq, __ATOMIC_RELAXED, __HIP_MEMORY_SCOPE_AGENT);
                    if (m & 1) asm volatile("" ::: "memory"); }
            asm volatile("s_waitcnt vmcnt(0)" ::: "memory"); __builtin_amdgcn_s_barrier(); asm volatile("" ::: "memory");
            const int tid = (wr * 4 + wc) * 64 + lane; const int panel = bq * 8 + pr_ - 1;
            if (tid == 0) { unsigned* cw = (unsigned*)(w_ + WS_CTL) + CW_SEAM + panel * 16;
                __hip_atomic_fetch_add(cw, 1u, __ATOMIC_RELAXED, __HIP_MEMORY_SCOPE_AGENT);
                unsigned sp = 0; while (__hip_atomic_load(cw, __ATOMIC_RELAXED, __HIP_MEMORY_SCOPE_AGENT) < 8u) { __builtin_amdgcn_s_sleep(1); if (++sp > (1u << 22)) break; }
                __builtin_amdgcn_fence(__ATOMIC_ACQUIRE, "agent"); asm volatile("s_waitcnt vmcnt(0)" ::: "memory"); }
            asm volatile("" ::: "memory"); __builtin_amdgcn_s_barrier(); asm volatile("" ::: "memory");
            LAS float* rt = (LAS float*)(lds + opq(HSQ_OFF));
            if (tid < 256) { const f32x4* p4 = (const f32x4*)(fsq + (size_t)(lrow0 + tid) * 32); float sa = 0.f;
#pragma unroll
                for (int j = 0; j < 8; ++j) { const f32x4 v = p4[j]; sa += (v.x + v.y) + (v.z + v.w); }
                rt[tid] = frsq(sa * (1.0f / DM) + EPS); }
            asm volatile("s_waitcnt lgkmcnt(0)" ::: "memory"); __builtin_amdgcn_s_barrier(); asm volatile("" ::: "memory");
            const float* nf = ap->in[I_NORMF] + col0; float* outp = ap->out + (size_t)lrow0 * DM;
#pragma unroll
            for (int bj = 0; bj < 2; ++bj)
#pragma unroll
                for (int n = 0; n < 2; ++n) gv[bj][n] = *(const f32x4*)(nf + bj * HALF + 4 * n);
#pragma unroll
            for (int ai = 0; ai < 2; ++ai)
#pragma unroll
                for (int m = 0; m < 4; ++m) { const int rl = rl0 + ai * HALF + m * 16; const float rs = rt[rl]; const unsigned ro = (unsigned)(rl * DM + col0) * 4u;
#pragma unroll
                    for (int bj = 0; bj < 2; ++bj)
#pragma unroll
                        for (int n = 0; n < 2; ++n) *(f32x4*)((char*)outp + ro + (bj * HALF + 4 * n) * 4) = acc[ai][bj][m][n] * rs * gv[bj][n]; }
            return;
        }
        const float* gt = (const float*)(w_ + WS_MODS) + (size_t)(LAYER * 5 + mr) * 6144 + 4096;
        const float* gmN = (const float*)(w_ + WS_GM) + (size_t)((LAYER + 1) * 5 + mr) * DM;
        const float* basep = (LAYER == 0) ? (isctx ? ap->in[I_CTX] + (size_t)(bq * CTXL) * DM : ap->in[I_X] + (size_t)(bq * SEQ + (pr_ - 1) * 256) * DM) : nullptr;
        const bf16_t* xbin = (const bf16_t*)(w_ + WS_X) + (size_t)u.pm * BM * DM;
        bf16_t* outp = (bf16_t*)(w_ + (DUP ? WS_DUMMY : WS_X)) + (size_t)u.pm * BM * DM; bf16_t* hp = (bf16_t*)(w_ + (DUP ? WS_DUMMY + 72 * MiB : WS_H)) + (size_t)u.pm * BM * DM;
        float* ssq = (float*)(w_ + (DUP ? WS_DUMMY + 108 * MiB : WS_SSQ));
        const int rl0 = wr * 64 + fr, col0 = u.pn * BM + wc * 32 + 8 * fq;
        f32x4 gv[2][2], mv[2][2];
#pragma unroll
        for (int bj = 0; bj < 2; ++bj)
#pragma unroll
            for (int n = 0; n < 2; ++n) { gv[bj][n] = *(const f32x4*)(gt + col0 + bj * HALF + 4 * n); if (NEXT) mv[bj][n] = *(const f32x4*)(gmN + col0 + bj * HALF + 4 * n); }
#pragma unroll
        for (int ai = 0; ai < 2; ++ai)
#pragma unroll
            for (int m = 0; m < 4; ++m) { if (!((gmask >> (ai * 4 + m)) & 1u)) continue; const int rl = rl0 + ai * HALF + m * 16; const unsigned ro = (unsigned)(rl * DM + col0) * 4u; float sq = 0.f;
#pragma unroll
                for (int bj = 0; bj < 2; ++bj) { f32x4 xn[2], bs[2];
                    if constexpr (LAYER == 0) { bs[0] = *(const f32x4*)((const char*)basep + ro + bj * HALF * 4); bs[1] = *(const f32x4*)((const char*)basep + ro + bj * HALF * 4 + 16); }
                    else { const u32x4 bw = *(const u32x4*)((const char*)xbin + (ro >> 1) + bj * HALF * 2); bs[0] = (f32x4){bflo(bw.x), bfhi(bw.x), bflo(bw.y), bfhi(bw.y)}; bs[1] = (f32x4){bflo(bw.z), bfhi(bw.z), bflo(bw.w), bfhi(bw.w)}; }
#pragma unroll
                    for (int n = 0; n < 2; ++n) { xn[n] = bs[n] + gv[bj][n] * acc[ai][bj][m][n];
                        if (NEXT) sq += (xn[n][0] * xn[n][0] + xn[n][1] * xn[n][1]) + (xn[n][2] * xn[n][2] + xn[n][3] * xn[n][3]); }
                    { u32x4 xw; xw.x = cvt_pk_bf16(xn[0][0], xn[0][1]); xw.y = cvt_pk_bf16(xn[0][2], xn[0][3]); xw.z = cvt_pk_bf16(xn[1][0], xn[1][1]); xw.w = cvt_pk_bf16(xn[1][2], xn[1][3]);
                        *(u32x4*)((char*)outp + (ro >> 1) + bj * HALF * 2) = xw; }
                    if (NEXT) { const f32x4 h0 = xn[0] * mv[bj][0], h1 = xn[1] * mv[bj][1]; u32x4 w; w.x = cvt_pk_bf16(h0[0], h0[1]); w.y = cvt_pk_bf16(h0[2], h0[3]); w.z = cvt_pk_bf16(h1[0], h1[1]); w.w = cvt_pk_bf16(h1[2], h1[3]);
                        *(u32x4*)((char*)hp + (ro >> 1) + bj * HALF * 2) = w; } }
                if (NEXT) { sq += shx<16>(sq); { auto rr = __builtin_amdgcn_permlane32_swap(__float_as_uint(sq), __float_as_uint(sq), false, false); sq = __uint_as_float(rr[0]) + __uint_as_float(rr[1]); }
                    if (fq == 0) ssq[(size_t)(u.pm * BM + rl) * 32 + u.pn * 4 + wc] = sq; }
                if (m & 1) asm volatile("" ::: "memory"); }
    }
};
template <int CTRL> __device__ __forceinline__ float dpp_f(float oldv, float src) { return __int_as_float(__builtin_amdgcn_update_dpp(__float_as_int(oldv), __float_as_int(src), CTRL, 0xf, 0xf, false)); }
struct EpiGates {
    unsigned char* ws; CArgsP ap;
    template <class SchedT> __device__ __forceinline__ void prep(LAS unsigned char*, const SchedT&, int) const {}
    __device__ __forceinline__ void operator()(f32x4 (&acc)[2][2][4][2], const Unit& u, int, LAS unsigned char*, int wr, int wc, int tl_, unsigned gmask) const {
        unsigned char* w_ = ws; asm volatile("" : "+v"(tl_), "+s"(w_)); const int lane = tl_ & 63, fr = lane & 15, fq = lane >> 4;
        const bf16_t* UP = (const bf16_t*)(w_ + WS_UP); const float* ba = ap->in[I_RBA]; const float* bx = ap->in[I_RBX]; const float* c8 = (const float*)(w_ + WS_TAB + 65536);
        unsigned* AB = (unsigned*)(w_ + WS_SA); float* AGA = (float*)(w_ + WS_AG16); float* AGB = AGA + (size_t)576 * 2 * DM;
        const int nblk = u.pn >> 2, dir = (u.pn >> 1) & 1, jt = u.pn & 1;
        const int row0 = u.pm * BM + wr * 64 + fr, chb = nblk * 256 + jt * 128 + 16 * wc + 4 * fq;
#pragma unroll
        for (int bj = 0; bj < 2; ++bj) { const int ch = chb + 64 * bj;
            const f32x4 bav = *(const f32x4*)(ba + dir * DM + ch), bxv = *(const f32x4*)(bx + dir * DM + ch), cv = *(const f32x4*)(c8 + dir * DM + ch);
#pragma unroll
            for (int ai = 0; ai < 2; ++ai)
#pragma unroll
                for (int m = 0; m < 4; ++m) { if (!((gmask >> (ai * 4 + m)) & 1u)) continue; const int row = row0 + ai * HALF + m * 16;
                    const u32x2 upw = *(const u32x2*)((const char*)UP + (unsigned)(row * DM + ch) * 2u);
                    const float up[4] = {bflo(upw.x), bfhi(upw.x), bflo(upw.y), bfhi(upw.y)};
                    const f32x4 pr = acc[ai][bj][m][0] + bav, pi = acc[ai][bj][m][1] + bxv; u32x4 w; f32x4 A, Bv;
#pragma unroll
                    for (int j = 0; j < 4; ++j) { const float r = sigmoidf_(pr[j]), ig = sigmoidf_(pi[j]); const float la = -r * cv[j]; const float a = __expf(la);
                        const float om = fmaf(-a, a, 1.0f);
                        w[j] = cvt_pk_bf16(la, fsqrt_(om) * (ig * up[j]));
                        A[j] = __expf(bflo(w[j])); Bv[j] = bfhi(w[j]); }
                    *(u32x4*)((char*)AB + (unsigned)((row * 2 + dir) * DM + ch) * 4u) = w;
#define GSTEP(CT) _Pragma("unroll") for (int j = 0; j < 4; ++j) { const float ap = dpp_f<CT>(1.0f, A[j]), bp = dpp_f<CT>(0.0f, Bv[j]); Bv[j] = fmaf(A[j], bp, Bv[j]); A[j] = A[j] * ap; }
                    if (dir == 0) { GSTEP(0x111) GSTEP(0x112) GSTEP(0x114) GSTEP(0x118) } else { GSTEP(0x101) GSTEP(0x102) GSTEP(0x104) GSTEP(0x108) }
#undef GSTEP
                    if (fr == (dir ? 0 : 15)) { const unsigned ao = (unsigned)((((u.pm * 16 + ai * 8 + wr * 4 + m) * 2 + dir) * DM + ch) * 4u); *(f32x4*)((char*)AGA + ao) = A; *(f32x4*)((char*)AGB + ao) = Bv; }
                    asm volatile("" ::: "memory"); __builtin_amdgcn_sched_barrier(0); } }
    }
};

struct NoEpi { unsigned char* ws; template <class SchedT> __device__ __forceinline__ void prep(LAS unsigned char*, const SchedT&, int) const {}
    __device__ __forceinline__ void operator()(f32x4 (&)[2][2][4][2], const Unit&, int, LAS unsigned char*, int, int, int, unsigned) const {} };
template <class Epi, class SchedT, int KT, int BANK, size_t OA, size_t OB, class Epi0 = NoEpi, size_t OA0 = 0, size_t OB0 = 0>
__device__ __forceinline__ void gemm_phase(LAS unsigned char* lds, const int tid, const SchedT& S, const Epi& E, const Epi0& E0 = Epi0{}) {
    constexpr bool MERGED = !__is_same(Epi0, NoEpi);
    constexpr bool SP2 = true, ALIGN_EPI = true;
    const int wid = __builtin_amdgcn_readfirstlane(tid >> 6), lane = tid & 63, wr = wid >> 2, wc = wid & 3, fr = lane & 15, fq = lane >> 4;
    constexpr int K = KT * BK, lda = DM;
    unsigned voffA[2], voffB[2];
#pragma unroll
    for (int i = 0; i < 2; ++i) { int R, C; stage_rc(tid * 16 + i * 8192, R, C); const int Rb = (R & ~31) + perm32(R & 31);
        voffA[i] = (unsigned)(R * lda + C) * 2u; voffB[i] = (unsigned)(Rb * K + C) * 2u; }
    constexpr unsigned kstep = (unsigned)(BK * 2);
    constexpr unsigned hstepA = (unsigned)HALF * lda * 2, hstepB = (unsigned)HALF * K * 2;
    constexpr unsigned tstepA = 2 * hstepA, tstepB = 2 * hstepB;
    const unsigned ldsw = (unsigned)wid * 1024u;
    const int aoff = lds_byte(wr * 64 + fr, fq * 8), boff = lds_byte(wc * 32 + fr, fq * 8);
#define PG8_SA(b, h) (((b) * 2 + (h)) * HTB)
#define PG8_SB(b, h) ((4 + (b) * 2 + (h)) * HTB)
#define PG8_STAGE(bufoff, goff, voff) do { _Pragma("unroll") for (int _i = 0; _i < 2; ++_i) \
        __builtin_amdgcn_global_load_lds((const unsigned*)((const char*)E.ws + (unsigned)((goff) + (voff)[_i])), (LAS unsigned*)(lds + (bufoff) + ldsw + _i * 8192), 16, 0, 0); } while (0)
#define PG8_LDA(dst, b, h) do { _Pragma("unroll") for (int m = 0; m < 4; ++m) _Pragma("unroll") for (int k = 0; k < 2; ++k) dst[m][k] = *(const LAS bf16x8*)(lds + PG8_SA(b, h) + aoff + m * 2048 + k * 1024); } while (0)
#define PG8_LDB(dst, b, h) do { _Pragma("unroll") for (int n = 0; n < 2; ++n) _Pragma("unroll") for (int k = 0; k < 2; ++k) dst[n][k] = *(const LAS bf16x8*)(lds + PG8_SB(b, h) + boff + n * 2048 + k * 1024); } while (0)
#define PG8_MMA(ai, bj, At, Bt) do { __builtin_amdgcn_s_setprio(1); _Pragma("unroll") for (int m = 0; m < 4; ++m) _Pragma("unroll") for (int n = 0; n < 2; ++n) _Pragma("unroll") for (int k = 0; k < 2; ++k) \
        acc[ai][bj][m][n] = __builtin_amdgcn_mfma_f32_16x16x32_bf16(Bt[n][k], At[m][k], acc[ai][bj][m][n], 0, 0, 0); __builtin_amdgcn_s_setprio(0); } while (0)
#define PG8_WAIT_V(n) asm volatile("s_waitcnt vmcnt(" #n ")" ::: "memory")
#define PG8_WAIT_L(n) asm volatile("s_waitcnt lgkmcnt(" #n ")" ::: "memory")
#define PG8_BAR __builtin_amdgcn_s_barrier()
#define PG8_SCHED __builtin_amdgcn_sched_barrier(0)
    Unit cur, nxt; int ui = 0;
    if (!S.next(0, cur)) return;
    E.prep(lds, S, tid); __syncthreads();
    f32x4 acc[2][2][4][2];
#pragma unroll
    for (int a = 0; a < 2; ++a)
#pragma unroll
        for (int b = 0; b < 2; ++b)
#pragma unroll
            for (int m = 0; m < 4; ++m)
#pragma unroll
                for (int n = 0; n < 2; ++n) acc[a][b][m][n] = (f32x4){0.f, 0.f, 0.f, 0.f};
    bf16x8 At[4][2], B0[2][2], B1[2][2];
#define PG8_UA(u) ((unsigned)((MERGED && (u).kind == 0) ? OA0 : OA) + (unsigned)(u).pm * tstepA + (unsigned)((u).acol + (u).kofs) * 2u)
#define PG8_UB(u) ((unsigned)((MERGED && (u).kind == 0) ? OB0 : OB) + (unsigned)(u).pn * tstepB + (unsigned)(u).kofs * 2u)
    unsigned cA = PG8_UA(cur), cB = PG8_UB(cur);
    {
        PG8_STAGE(PG8_SB(0, 0), cB, voffB); PG8_STAGE(PG8_SB(0, 1), cB + hstepB, voffB); PG8_STAGE(PG8_SA(0, 0), cA, voffA); PG8_STAGE(PG8_SA(0, 1), cA + hstepA, voffA);
        if (wr == 1) PG8_BAR;
        PG8_WAIT_V(2); PG8_BAR;
        PG8_STAGE(PG8_SB(1, 0), cB + kstep, voffB); PG8_STAGE(PG8_SA(1, 0), cA + kstep, voffA); PG8_STAGE(PG8_SB(1, 1), cB + hstepB + kstep, voffB);
        PG8_WAIT_V(6); PG8_BAR;
    }
    for (;;) {
        const bool has_next = S.next(ui + 1, nxt);
        const unsigned nA = has_next ? PG8_UA(nxt) : cA, nB = has_next ? PG8_UB(nxt) : cB;
        const int nt = cur.nt;
        for (int t = 0; t < nt; t += 2) {
            const bool last = (t == nt - 2);
            if constexpr (MERGED) if (last && has_next && nxt.kind == 2) {
                unsigned char* w0_ = E.ws; asm volatile("" : "+s"(w0_));
                if (wid == 0) { unsigned* cw = (unsigned*)(w0_ + WS_CTL) + CW_SEAM + 1024 + BANK * 64 + (nxt.pm / 9) * 16; unsigned sp_ = 0;
                    while ((unsigned)__builtin_amdgcn_readfirstlane((int)__hip_atomic_load(cw, __ATOMIC_RELAXED, __HIP_MEMORY_SCOPE_AGENT)) < 8u) { __builtin_amdgcn_s_sleep(2); if (++sp_ > (1u << 22)) break; }
                    __builtin_amdgcn_fence(__ATOMIC_ACQUIRE, "agent"); asm volatile("s_waitcnt vmcnt(0)" ::: "memory"); }
                asm volatile("" ::: "memory"); PG8_BAR; asm volatile("" ::: "memory");
                if (tid < 256) { const f32x4* p4 = (const f32x4*)((const float*)(w0_ + WS_SSQ) + (size_t)(nxt.pm * BM + tid) * 32); float s_ = 0.f;
#pragma unroll
                    for (int j = 0; j < 8; ++j) { const f32x4 v_ = p4[j]; s_ += (v_.x + v_.y) + (v_.z + v_.w); }
                    ((LAS float*)(lds + opq(RSTD_OFF)))[(ui + 1) * 256 + tid] = frsq(s_ * (1.0f / DM) + EPS); }
            }
            const unsigned a1 = cA + (unsigned)(t + 1) * kstep;
            const unsigned a2 = last ? nA : cA + (unsigned)(t + 2) * kstep, b2 = last ? nB : cB + (unsigned)(t + 2) * kstep;
            const unsigned a3 = a2 + kstep, b3 = b2 + kstep;
            PG8_LDB(B0, 0, 0); PG8_LDB(B1, 0, 1); PG8_SCHED; PG8_LDA(At, 0, 0); PG8_STAGE(PG8_SA(1, 1), a1 + hstepA, voffA);
            PG8_WAIT_V(8); PG8_WAIT_L(0); PG8_BAR; PG8_MMA(0, 0, At, B0); PG8_MMA(0, 1, At, B1); PG8_BAR; PG8_SCHED;
            PG8_LDA(At, 0, 1); PG8_STAGE(PG8_SB(0, 0), b2, voffB); PG8_STAGE(PG8_SB(0, 1), b2 + hstepB, voffB); PG8_STAGE(PG8_SA(0, 0), a2, voffA);
            PG8_WAIT_V(8); PG8_WAIT_L(0); PG8_BAR; PG8_MMA(1, 0, At, B0); PG8_MMA(1, 1, At, B1); PG8_BAR; PG8_SCHED;
            PG8_LDB(B0, 1, 0); PG8_LDB(B1, 1, 1); PG8_SCHED; PG8_LDA(At, 1, 0); PG8_STAGE(PG8_SA(0, 1), a2 + hstepA, voffA);
            PG8_WAIT_V(8); PG8_WAIT_L(0); PG8_BAR; PG8_MMA(0, 0, At, B0); PG8_MMA(0, 1, At, B1); PG8_BAR; PG8_SCHED;
            PG8_LDA(At, 1, 1); PG8_STAGE(PG8_SB(1, 0), b3, voffB); PG8_STAGE(PG8_SB(1, 1), b3 + hstepB, voffB); PG8_STAGE(PG8_SA(1, 0), a3, voffA);
            PG8_WAIT_V(8); PG8_WAIT_L(0); PG8_BAR; PG8_MMA(1, 0, At, B0); PG8_MMA(1, 1, At, B1); PG8_BAR; PG8_SCHED;
        }
        if constexpr (ALIGN_EPI) { if (wr == 0) PG8_BAR; }
        if (MERGED && cur.kind == 0) {
            E0(acc, cur, ui, lds, wr, wc, tid, 0xffu);
            asm volatile("s_waitcnt vmcnt(0)" ::: "memory"); PG8_BAR; asm volatile("" ::: "memory");
            if (tid == 0) { unsigned char* w0_ = E.ws; asm volatile("" : "+s"(w0_)); unsigned* cw = (unsigned*)(w0_ + WS_CTL) + CW_SEAM + 1024 + BANK * 64 + (cur.pm / 9) * 16;
                __builtin_amdgcn_fence(__ATOMIC_RELEASE, "agent"); asm volatile("s_waitcnt vmcnt(0)" ::: "memory");
                __hip_atomic_fetch_add(cw, 1u, __ATOMIC_RELAXED, __HIP_MEMORY_SCOPE_AGENT); }
        } else
        if (!S.is_slice(ui)) E(acc, cur, ui, lds, wr, wc, tid, 0xffu);
        if (!has_next) break;
#pragma unroll
        for (int a = 0; a < 2; ++a)
#pragma unroll
            for (int b = 0; b < 2; ++b)
#pragma unroll
                for (int m = 0; m < 4; ++m)
#pragma unroll
                    for (int n = 0; n < 2; ++n) acc[a][b][m][n] = (f32x4){0.f, 0.f, 0.f, 0.f};
        cur = nxt; cA = nA; cB = nB; ++ui;
        if constexpr (ALIGN_EPI) { if (wr == 1) PG8_BAR; }
    }
    PG8_WAIT_V(0);
    if constexpr (!ALIGN_EPI) { if (wr == 0) PG8_BAR; }
    PG8_BAR;
    if constexpr (SchedT::F > 1) if (S.is_slice(ui)) {
        unsigned char* w_ = E.ws; asm volatile("" : "+s"(w_)); float* slab = (float*)(w_ + WS_SLAB); unsigned* cnt = (unsigned*)(w_ + WS_CTL) + CW_SEAM + BANK * 4096;
        constexpr int F = SchedT::F; const int tt = S.v / F, sj = S.v - tt * F; float* my = slab + ((size_t)(tt * F + sj) * 32) * 2048;
#pragma unroll
        for (int a = 0; a < 2; ++a)
#pragma unroll
            for (int b = 0; b < 2; ++b)
#pragma unroll
                for (int m = 0; m < 4; ++m)
#pragma unroll
                    for (int n = 0; n < 2; ++n) { float* sp_ = my + (size_t)((((a * 2 + b) * 4 + m) * 2 + n) * 512 + tid) * 4;
                        asm volatile("global_store_dwordx4 %0, %1, off sc1\n\ts_nop 1" :: "v"(sp_), "v"(acc[a][b][m][n]) : "memory"); }
        asm volatile("s_waitcnt vmcnt(0)" ::: "memory"); __syncthreads();
        if (tid == 0) { unsigned* cw = cnt + tt * 16;
            __hip_atomic_fetch_add(cw, 1u, __ATOMIC_RELAXED, __HIP_MEMORY_SCOPE_AGENT);
            unsigned sp = 0; while (__hip_atomic_load(cw, __ATOMIC_RELAXED, __HIP_MEMORY_SCOPE_AGENT) < (unsigned)F) { __builtin_amdgcn_s_sleep(1); if (++sp > (1u << 22)) break; }
            __builtin_amdgcn_fence(__ATOMIC_ACQUIRE, "agent"); asm volatile("s_waitcnt vmcnt(0)" ::: "memory"); }
        __syncthreads();
        constexpr int per = 8 / F; const unsigned gmask = ((1u << per) - 1u) << (sj * per);
        const float* t0 = slab + ((size_t)(tt * F) * 32) * 2048;
#pragma unroll
        for (int a = 0; a < 2; ++a)
#pragma unroll
            for (int m = 0; m < 4; ++m) if ((gmask >> (a * 4 + m)) & 1u) {
#pragma unroll
                for (int b = 0; b < 2; ++b)
#pragma unroll
                    for (int n = 0; n < 2; ++n) { const float* fp = t0 + (size_t)((((a * 2 + b) * 4 + m) * 2 + n) * 512 + tid) * 4; f32x4 sm = *(const f32x4*)fp;
#pragma unroll
                        for (int sl = 1; sl < F; ++sl) sm += *(const f32x4*)(fp + (size_t)sl * 32 * 2048);
                        acc[a][b][m][n] = sm; } }
        E(acc, cur, ui, lds, wr, wc, tid, gmask);
        asm volatile("s_waitcnt vmcnt(0)" ::: "memory"); __syncthreads();
    }
#undef PG8_UA
#undef PG8_UB
#undef PG8_SA
#undef PG8_SB
#undef PG8_STAGE
#undef PG8_LDA
#undef PG8_LDB
#undef PG8_MMA
#undef PG8_WAIT_V
#undef PG8_WAIT_L
#undef PG8_BAR
#undef PG8_SCHED
}
}

namespace att {
constexpr int D = 128, NW = 8, QBLK = 32, KVBLK = 64;
constexpr float SCALE = 0.088388347648318440f;
constexpr float THR = 8.f;
constexpr int SHM_V = KVBLK * D * 2, SHM_K = KVBLK * D * 2, SHM_ATTN = 3 * SHM_V + 3 * SHM_K + NW * 64 * 4;
#define KSWZ(row, colB) ((row) * 256 + ((colB) ^ (((row) & 7) << 4)))
#define SBAR() __builtin_amdgcn_sched_barrier(0)
__device__ __forceinline__ int crow(int r, int hi) { return (r & 3) + 8 * (r >> 2) + 4 * hi; }
__device__ __forceinline__ unsigned cvtpk(float lo, float hi) { unsigned r; asm volatile("v_cvt_pk_bf16_f32 %0, %1, %2" : "=v"(r) : "v"(lo), "v"(hi)); return r; }
__device__ __forceinline__ bf16x8 ld8(const bf16_t* p) { return *reinterpret_cast<const bf16x8*>(p); }

__device__ __forceinline__ void partialSM(f32x16& p0, f32x16& p1, float& m_reg, float& mn, float& alpha) {
  constexpr float C = SCALE * 1.4426950408889634f;
  float pmax = p0[0]; for (int r = 1; r < 16; ++r) pmax = fmaxf(pmax, p0[r]); for (int r = 0; r < 16; ++r) pmax = fmaxf(pmax, p1[r]);
  { auto rr = __builtin_amdgcn_permlane32_swap(__float_as_uint(pmax), __float_as_uint(pmax), false, false);
    pmax = fmaxf(__uint_as_float(rr[0]), __uint_as_float(rr[1])); }
  if (__builtin_expect(__all(pmax - m_reg <= THR / SCALE), 1)) { mn = m_reg; alpha = 1.f; }
  else { mn = fmaxf(m_reg, pmax); alpha = __builtin_amdgcn_exp2f((m_reg - mn) * C); m_reg = mn; }
  float mnC = -mn * C;
  for (int r = 0; r < 16; ++r) p0[r] = fmaf(p0[r], C, mnC); for (int r = 0; r < 16; ++r) p1[r] = fmaf(p1[r], C, mnC);
  for (int r = 0; r < 16; ++r) p0[r] = __builtin_amdgcn_exp2f(p0[r]);
}
__device__ __forceinline__ void finishSM(f32x16& p0, f32x16& p1, float alpha, float& l_reg, bf16x8& pa0, bf16x8& pa1, bf16x8& pa2, bf16x8& pa3) {
  for (int r = 0; r < 16; ++r) p1[r] = __builtin_amdgcn_exp2f(p1[r]);
  float ps = 0; for (int r = 0; r < 16; ++r) ps += p0[r]; for (int r = 0; r < 16; ++r) ps += p1[r];
  { auto rr = __builtin_amdgcn_permlane32_swap(__float_as_uint(ps), __float_as_uint(ps), false, false);
    ps = __uint_as_float(rr[0]) + __uint_as_float(rr[1]); }
  l_reg = l_reg * alpha + ps;
#define PK4(P, BASE, OUT) do { unsigned a0 = cvtpk(P[BASE + 0], P[BASE + 1]), a1 = cvtpk(P[BASE + 2], P[BASE + 3]);   \
    unsigned b0 = cvtpk(P[BASE + 4], P[BASE + 5]), b1 = cvtpk(P[BASE + 6], P[BASE + 7]);                              \
    auto r0 = __builtin_amdgcn_permlane32_swap(a0, b0, false, false); auto r1 = __builtin_amdgcn_permlane32_swap(a1, b1, false, false); \
    u32x4 w = {r0[0], r1[0], r0[1], r1[1]}; OUT = *reinterpret_cast<bf16x8*>(&w); } while (0)
  PK4(p0, 0, pa0); PK4(p0, 8, pa1); PK4(p1, 0, pa2); PK4(p1, 8, pa3);
#undef PK4
}
__device__ __forceinline__ void qkt(f32x16& p0, f32x16& p1, const bf16_t* Ks, const bf16x8* qr, int r32, int hi) {
  p0 = f32x16{}; p1 = f32x16{};
  for (int d0 = 0; d0 < 8; ++d0) { int cb = (d0 * 16 + hi * 8) * 2;
    bf16x8 b0 = *reinterpret_cast<const bf16x8*>((const char*)Ks + KSWZ(r32, cb));
    bf16x8 b1 = *reinterpret_cast<const bf16x8*>((const char*)Ks + KSWZ(32 + r32, cb));
    p0 = __builtin_amdgcn_mfma_f32_32x32x16_bf16(b0, qr[d0], p0, 0, 0, 0);
    p1 = __builtin_amdgcn_mfma_f32_32x32x16_bf16(b1, qr[d0], p1, 0, 0, 0); }
}
__device__ __forceinline__ int v_st(int k, int c) { const int kk = (k & ~0xC) | ((k & 4) << 1) | ((k & 8) >> 1); return ((kk >> 3) * 4 + (c >> 5)) * 512 + ((kk & 7) * 32 + (c & 31)) * 2; }
__device__ __forceinline__ int v_rd_base(int lane) { return ((lane & 3) << 3) | (((lane >> 2) & 3) << 6) | (((lane >> 4) & 1) << 5) | (((lane >> 5) & 1) << 8); }
constexpr int v_rd_off(int d0, int ks, int half) { return d0 * 512 + ks * 4096 + half * 2048; }
template <int OFF> __device__ __forceinline__ s16x4 tr_read(int vb) {
  s16x4 r; asm volatile("ds_read_b64_tr_b16 %0, %1 offset:%2" : "=&v"(r) : "v"(vb), "i"(OFF) : "memory"); return r;
}
template <int D0> __device__ __forceinline__ void pv_one(f32x16& od, int vb, bf16x8 pa0, bf16x8 pa1, bf16x8 pa2, bf16x8 pa3) {
  const s16x4 l0 = tr_read<v_rd_off(D0, 0, 0)>(vb), h0 = tr_read<v_rd_off(D0, 0, 1)>(vb), l1 = tr_read<v_rd_off(D0, 1, 0)>(vb), h1 = tr_read<v_rd_off(D0, 1, 1)>(vb);
  const s16x4 l2 = tr_read<v_rd_off(D0, 2, 0)>(vb), h2 = tr_read<v_rd_off(D0, 2, 1)>(vb), l3 = tr_read<v_rd_off(D0, 3, 0)>(vb), h3 = tr_read<v_rd_off(D0, 3, 1)>(vb);
  asm volatile("s_waitcnt lgkmcnt(0)" ::: "memory"); SBAR();
#define PK(L, H) (bf16x8){L[0], L[1], L[2], L[3], H[0], H[1], H[2], H[3]}
  od = __builtin_amdgcn_mfma_f32_32x32x16_bf16(pa0, PK(l0, h0), od, 0, 0, 0);
  od = __builtin_amdgcn_mfma_f32_32x32x16_bf16(pa1, PK(l1, h1), od, 0, 0, 0);
  od = __builtin_amdgcn_mfma_f32_32x32x16_bf16(pa2, PK(l2, h2), od, 0, 0, 0);
  od = __builtin_amdgcn_mfma_f32_32x32x16_bf16(pa3, PK(l3, h3), od, 0, 0, 0);
#undef PK
}
__device__ __forceinline__ void pv_d0(f32x16* o, int vb, bf16x8 pa0, bf16x8 pa1, bf16x8 pa2, bf16x8 pa3) {
  pv_one<0>(o[0], vb, pa0, pa1, pa2, pa3); pv_one<1>(o[1], vb, pa0, pa1, pa2, pa3); pv_one<2>(o[2], vb, pa0, pa1, pa2, pa3); pv_one<3>(o[3], vb, pa0, pa1, pa2, pa3);
}
template <int LD, int ldo, bool GATED>
__device__ __forceinline__ void attn_unit(const bf16_t* __restrict__ Qb, const bf16_t* __restrict__ Kh, const bf16_t* __restrict__ Vh,
                                          bf16_t* __restrict__ Ob, const bf16_t* __restrict__ Zb, int seq, char* lds, const int tid) {
  constexpr int SDEPTH = 2;
  const int wid = tid >> 6, lane = tid & 63, r32 = lane & 31, hi = lane >> 5;
  char* V_lds = lds; char* K_lds = lds + 3 * SHM_V;
  float* ws = (float*)(lds + 3 * SHM_V + 3 * SHM_K) + wid * 64; float* li_l = ws; float* al_l = ws + 32;
  float m_reg = -1e30f, l_reg = 0; f32x16 o[4] = {}; bf16x8 qr[8];
  { const unsigned qoff = (unsigned)((wid * QBLK + r32) * LD + hi * 8) * 2u;
#pragma unroll
    for (int d0 = 0; d0 < 8; ++d0) qr[d0] = *(const bf16x8*)((const char*)Qb + qoff + d0 * 32); }
  const int sr = tid >> 4, sc = (tid & 15) * 8, vst0 = v_st(sr, sc), vst1 = v_st(32 + sr, sc);
  const int vb0 = (int)(uintptr_t)V_lds + v_rd_base(lane);
  struct { bf16x8 vs0, vs1, ks0, ks1; } sr_[SDEPTH];
  const unsigned soff0 = (unsigned)(sr * LD + sc) * 2u, soff1 = (unsigned)((32 + sr) * LD + sc) * 2u;
#define SLOAD(i, k0) do { const char* vt_ = (const char*)Vh + (size_t)(k0) * (LD * 2); const char* kt_ = (const char*)Kh + (size_t)(k0) * (LD * 2); \
    sr_[i].vs0 = *(const bf16x8*)(vt_ + soff0); sr_[i].vs1 = *(const bf16x8*)(vt_ + soff1); sr_[i].ks0 = *(const bf16x8*)(kt_ + soff0); sr_[i].ks1 = *(const bf16x8*)(kt_ + soff1); } while (0)
#define SWRITE(so, i) do { *(bf16x8*)(V_lds + (so) + vst0) = sr_[i].vs0;          \
    *(bf16x8*)(V_lds + (so) + vst1) = sr_[i].vs1; int kc = sc * 2;               \
    *(bf16x8*)(K_lds + (so) + KSWZ(sr, kc)) = sr_[i].ks0;                       \
    *(bf16x8*)(K_lds + (so) + KSWZ(32 + sr, kc)) = sr_[i].ks1; } while (0)
#define SWAIT() do { asm volatile("s_waitcnt vmcnt(4)" ::: "memory"); } while (0)
#define RESC(a) do { if (__any((a) < 1.f)) { if (hi == 0) al_l[r32] = (a); asm volatile("s_waitcnt lgkmcnt(0)" ::: "memory"); \
    for (int d = 0; d < 4; ++d) for (int r = 0; r < 16; ++r) o[d][r] *= al_l[crow(r, hi)]; } } while (0)
#define ROT() do { const int t_ = sp; sp = sc_; sc_ = sn; sn = t_; } while (0)
  f32x16 pA0, pA1, pB0, pB1; float mnA, mnB, alA, alB; bf16x8 pa0, pa1, pa2, pa3; const int NT = seq / KVBLK;
  constexpr int SE = 0, SO = SDEPTH - 1;
  int sp = 0, sc_ = SHM_V, sn = 2 * SHM_V;
  SLOAD(SE, 0); asm volatile("s_waitcnt vmcnt(0)" ::: "memory"); SWRITE(0, SE); __syncthreads();
  qkt(pA0, pA1, (const bf16_t*)K_lds, qr, r32, hi); partialSM(pA0, pA1, m_reg, mnA, alA);
  SLOAD(SO, KVBLK); if (2 < NT) SLOAD(SE, 2 * KVBLK);
  SWAIT(); SWRITE(SHM_V, SO);
  for (int j = 1; j + 1 < NT; j += 2) {
    __syncthreads();
    SBAR(); qkt(pB0, pB1, (const bf16_t*)(K_lds + sc_), qr, r32, hi);
    finishSM(pA0, pA1, alA, l_reg, pa0, pa1, pa2, pa3); SBAR();
    SLOAD(SO, (j + SDEPTH) * KVBLK); SBAR();
    pv_d0(o, vb0 + sp, pa0, pa1, pa2, pa3); partialSM(pB0, pB1, m_reg, mnB, alB);
    SWAIT(); SWRITE(sn, SE);
    RESC(alB); ROT();
    __syncthreads();
    SBAR(); qkt(pA0, pA1, (const bf16_t*)(K_lds + sc_), qr, r32, hi);
    finishSM(pB0, pB1, alB, l_reg, pa0, pa1, pa2, pa3); SBAR();
    if (j + 3 < NT) SLOAD(SE, (j + 1 + SDEPTH) * KVBLK); SBAR();
    pv_d0(o, vb0 + sp, pa0, pa1, pa2, pa3); partialSM(pA0, pA1, m_reg, mnA, alA);
    SWAIT(); SWRITE(sn, SO);
    RESC(alA); ROT();
  }
  __syncthreads();
  SBAR(); qkt(pB0, pB1, (const bf16_t*)(K_lds + sc_), qr, r32, hi);
  finishSM(pA0, pA1, alA, l_reg, pa0, pa1, pa2, pa3); SBAR();
  pv_d0(o, vb0 + sp, pa0, pa1, pa2, pa3); partialSM(pB0, pB1, m_reg, mnB, alB);
  RESC(alB);
  finishSM(pB0, pB1, alB, l_reg, pa0, pa1, pa2, pa3); SBAR();
  pv_d0(o, vb0 + sc_, pa0, pa1, pa2, pa3);
  if (hi == 0) li_l[r32] = l_reg; asm volatile("s_waitcnt lgkmcnt(0)" ::: "memory");
  float rli[16];
#pragma unroll
  for (int r = 0; r < 16; ++r) rli[r] = __builtin_amdgcn_rcpf(li_l[crow(r, hi)]);
  __syncthreads();
  { bf16_t* stg = (bf16_t*)lds + wid * 4096;
#pragma unroll
    for (int r = 0; r < 16; ++r) { const int orow = crow(r, hi);
#pragma unroll
      for (int d0 = 0; d0 < 4; ++d0) stg[orow * 128 + d0 * 32 + r32] = (bf16_t)f2bf(o[d0][r] * rli[r]); }
    asm volatile("s_waitcnt lgkmcnt(0)" ::: "memory");
#pragma unroll 2
    for (int i = 0; i < 8; ++i) { const int row = i * 4 + (lane >> 4), ch = lane & 15; u32x4 v = *(const u32x4*)(stg + row * 128 + ch * 8);
      if constexpr (GATED) { const u32x4 z = *(const u32x4*)((const char*)Zb + (unsigned)((wid * QBLK + row) * LD + ch * 8) * 2u);
        v.x = pk2(bflo(v.x) * siluf_(bflo(z.x)), bfhi(v.x) * siluf_(bfhi(z.x))); v.y = pk2(bflo(v.y) * siluf_(bflo(z.y)), bfhi(v.y) * siluf_(bfhi(z.y)));
        v.z = pk2(bflo(v.z) * siluf_(bflo(z.z)), bfhi(v.z) * siluf_(bfhi(z.z))); v.w = pk2(bflo(v.w) * siluf_(bflo(z.w)), bfhi(v.w) * siluf_(bfhi(z.w))); }
      *(u32x4*)((char*)Ob + (unsigned)((wid * QBLK + row) * ldo + ch * 8) * 2u) = v; }
    asm volatile("s_waitcnt lgkmcnt(0)" ::: "memory"); }
  __syncthreads();
#undef SLOAD
#undef SWRITE
#undef SWAIT
#undef RESC
#undef ROT
}
#undef KSWZ
#undef SBAR
}

constexpr int RING_BYTES = 131072, ATT_OST_OFF = 69632  , LDSCTL_OFF = 155648, MISC_OFF = LDSCTL_OFF + 320, LDS_BYTES = 163840;
static_assert(att::SHM_ATTN <= RING_BYTES && MISC_OFF + 128 <= LDS_BYTES, "LDS map");
constexpr int NWAVES = 8;

typedef GAS unsigned gu32;
#define RLX_AGENT __ATOMIC_RELAXED, __HIP_MEMORY_SCOPE_AGENT
#define LDS_WAIT() asm volatile("s_waitcnt lgkmcnt(0)" ::: "memory")
#define VM_WAIT() asm volatile("s_waitcnt vmcnt(0)" ::: "memory")

#define XB_TMO      128
#define XB_XCNT(j)  (256  + 64 * (j))
#define XB_XSUB(j)  (1280 + 64 * (j))
#define XB_XGEN(j)  (2304 + 64 * (j))
#define XB_TOP      3328
#define XB_TOPGEN   3392
#define XCD_BAR_WORDS 3456
#define XB_SPIN_CAP (1u << 18)
__device__ __forceinline__ unsigned xb_ld(unsigned* p)              { return __hip_atomic_load(p, __ATOMIC_RELAXED, __HIP_MEMORY_SCOPE_AGENT); }
__device__ __forceinline__ unsigned xb_add(unsigned* p, unsigned v) { return __hip_atomic_fetch_add(p, v, __ATOMIC_RELAXED, __HIP_MEMORY_SCOPE_AGENT); }
__device__ __forceinline__ int lane_id_opaque() { int lo_, r_; asm volatile("v_mbcnt_lo_u32_b32 %0, -1, 0" : "=v"(lo_)); asm volatile("v_mbcnt_hi_u32_b32 %0, -1, %1" : "=v"(r_) : "v"(lo_)); return r_; }
__device__ __forceinline__ unsigned hw_slot() { return (unsigned)__builtin_amdgcn_s_getreg((5 << 11) | 4) & 63u; }
__device__ __forceinline__ unsigned xb_xcc_id() { return (unsigned)__builtin_amdgcn_s_getreg((3 << 11) | 20) & 0xFu; }
#define XB_SPIN(cond, bar) do { unsigned _sp = 0; while (cond) { __builtin_amdgcn_s_sleep(1); \
    if ((++_sp & 255u) == 0u) { if (xb_ld(&(bar)[XB_TMO])) break; if (_sp > XB_SPIN_CAP) { atomicAdd(&(bar)[XB_TMO], 1u); break; } } } } while (0)
struct XcdBarrier { unsigned* bar; unsigned x; volatile LAS unsigned* st; };
__device__ __forceinline__ XcdBarrier xcd_barrier_post(unsigned* bar, volatile LAS unsigned* st, bool is_t0) {
    XcdBarrier b; b.bar = bar; b.x = xb_xcc_id(); b.st = st;
    if (is_t0) (void)xb_add(&bar[XB_XCNT(b.x)], 1u);
    return b;
}
__device__ __forceinline__ void xcd_barrier_complete(unsigned* bar, unsigned x, unsigned& nloc, unsigned& nx) {
    const unsigned G = 256u;
    unsigned sum, cnt, mine, sp = 0u;
    for (;;) {
        sum = 0u; cnt = 0u; mine = 0u;
#pragma unroll
        for (unsigned j = 0; j < 16; ++j) { const unsigned c = xb_ld(&bar[XB_XCNT(j)]); sum += c; cnt += (c > 0u) ? 1u : 0u; mine = (j == x) ? c : mine; }
        if (sum == G) break;
        __builtin_amdgcn_s_sleep(1);
        if ((++sp & 255u) == 0u) { if (xb_ld(&bar[XB_TMO])) break; if (sp > XB_SPIN_CAP) { atomicAdd(&bar[XB_TMO], 1u); break; } }
    }
    nloc = mine > 0u ? mine : 1u; nx = cnt > 0u ? cnt : 1u;
}
__device__ __forceinline__ void xcd_barrier(const XcdBarrier& b, int wave_s) {
    asm volatile("s_waitcnt vmcnt(0)" ::: "memory");
    __syncthreads();
    if (wave_s == 0 && lane_id_opaque() == 0) {
        unsigned* bar = b.bar;
        __builtin_amdgcn_s_waitcnt(0);
        unsigned nloc = b.st[0], nx = b.st[1];
        if (nloc == 0u) { xcd_barrier_complete(bar, b.x, nloc, nx); b.st[0] = nloc; b.st[1] = nx; }
        const unsigned old = xb_add(&bar[XB_XSUB(b.x)], 1u);
        const unsigned gen = old / nloc;
        if (old + 1u == (gen + 1u) * nloc) {
            __builtin_amdgcn_fence(__ATOMIC_RELEASE, "agent");
            asm volatile("s_waitcnt vmcnt(0)" ::: "memory");
            const unsigned og = xb_add(&bar[XB_TOP], 1u);
            const unsigned tg = og / nx;
            if (og + 1u == (tg + 1u) * nx) xb_add(&bar[XB_TOPGEN], 1u);
            else XB_SPIN(xb_ld(&bar[XB_TOPGEN]) == tg, bar);
            __builtin_amdgcn_fence(__ATOMIC_ACQUIRE, "agent");
            xb_add(&bar[XB_XGEN(b.x)], 1u);
            asm volatile("s_waitcnt vmcnt(0)" ::: "memory");
        } else {
            XB_SPIN(xb_ld(&bar[XB_XGEN(b.x)]) == gen, bar);
            __builtin_amdgcn_fence(__ATOMIC_ACQUIRE, "agent");
            asm volatile("s_waitcnt vmcnt(0)" ::: "memory");
        }
    }
    __syncthreads();
}

__device__ __forceinline__ int p0_dst_row(int ns, int qkcols) {
    if (qkcols > 0) return (ns < qkcols) ? ((ns & ~127) | qk_pi_inv(ns & 127)) : ns;
    if (qkcols < 0) { const int code = -qkcols - 1, gate = code >> 4, dir = (code >> 3) & 1, nblk = code & 7, e = ns & 127;
        const int c = (((e >> 6) & 1) << 7) | (((e >> 4) & 3) << 5) | (((e >> 2) & 3) << 3) | (gate << 2) | (e & 3); return (nblk * 4 + dir * 2 + (ns >> 7)) * 256 + c; }
    return ns;
}
__device__ __forceinline__ void p0_transpose_item(const float* __restrict__ W, int K, int N, bf16_t* __restrict__ WT, LAS bf16_t* scr, int item, int lane, int qkcols, const float* shl = nullptr, float* shwp = nullptr) {
    const int nblk = N / 64, kb = item / nblk, nb = item % nblk, k0 = 64 * kb, n0 = 64 * nb;
    const int n4 = (lane & 15) * 4, kr = lane >> 4;
    f32x4 v[16];
#pragma unroll
    for (int i = 0; i < 16; ++i) v[i] = *(const f32x4*)(W + (size_t)(k0 + 4 * i + kr) * N + n0 + n4);
    float shv[5];
    if (shl) {
#pragma unroll
        for (int r = 0; r < 5; ++r) shv[r] = shl[(size_t)r * 6144 + k0 + lane]; }
#pragma unroll
    for (int i = 0; i < 16; ++i) { const int k = 4 * i + kr;
        scr[(n4 + 0) * 72 + k] = (bf16_t)f2bf(v[i].x); scr[(n4 + 1) * 72 + k] = (bf16_t)f2bf(v[i].y); scr[(n4 + 2) * 72 + k] = (bf16_t)f2bf(v[i].z); scr[(n4 + 3) * 72 + k] = (bf16_t)f2bf(v[i].w); }
    LAS float* shs = (LAS float*)(scr + 64 * 72);
    if (shl) {
#pragma unroll
        for (int r = 0; r < 5; ++r) shs[r * 64 + lane] = shv[r]; }
    LDS_WAIT(); asm volatile("" ::: "memory");
#pragma unroll
    for (int i = 0; i < 8; ++i) { const int n = 8 * i + (lane >> 3), kc = (lane & 7) * 8;
        const u32x4 o = *(const LAS u32x4*)(scr + n * 72 + kc);
        const int ns = n0 + n, nd = p0_dst_row(ns, qkcols);
        *(u32x4*)(WT + (size_t)nd * K + k0 + kc) = o; }
    if (shl) { float a0 = 0.f, a1 = 0.f, a2 = 0.f, a3 = 0.f, a4 = 0.f;
#pragma unroll 1
        for (int c = 0; c < 8; ++c) { const u32x4 w = *(const LAS u32x4*)(scr + lane * 72 + c * 8);
            const float wf[8] = {bflo(w.x), bfhi(w.x), bflo(w.y), bfhi(w.y), bflo(w.z), bfhi(w.z), bflo(w.w), bfhi(w.w)};
#pragma unroll
            for (int h = 0; h < 2; ++h) { const f32x4 s0 = *(const LAS f32x4*)(shs + c * 8 + h * 4), s1 = *(const LAS f32x4*)(shs + 64 + c * 8 + h * 4), s2 = *(const LAS f32x4*)(shs + 128 + c * 8 + h * 4),
                                 s3 = *(const LAS f32x4*)(shs + 192 + c * 8 + h * 4), s4 = *(const LAS f32x4*)(shs + 256 + c * 8 + h * 4);
#pragma unroll
                for (int e = 0; e < 4; ++e) { const float x = wf[h * 4 + e]; a0 += x * s0[e]; a1 += x * s1[e]; a2 += x * s2[e]; a3 += x * s3[e]; a4 += x * s4[e]; } } }
        const int nd = p0_dst_row(n0 + lane, qkcols); float* o = shwp + (size_t)kb * 5 * 8192 + nd;
        o[0] = a0; o[8192] = a1; o[2 * 8192] = a2; o[3 * 8192] = a3; o[4 * 8192] = a4; }
    LDS_WAIT(); asm volatile("" ::: "memory");
}
__device__ __forceinline__ void conv_job(const float* W, int N, bf16_t* WT, int qkcols, int shw_layer, unsigned char* ws, LAS unsigned char* ldsl, int wave, int lane, int widx, int nw) {
    LAS bf16_t* scr = (LAS bf16_t*)(ldsl + wave * 16384);
    const float* shl = shw_layer > 0 ? (const float*)(ws + WS_MODS) + (size_t)shw_layer * 5 * 6144 : nullptr;
    float* shwp = shw_layer > 0 ? (float*)(ws + WS_SHWP) + (size_t)(shw_layer - 1) * 32 * 5 * 8192 : nullptr;
    const int items = (DM / 64) * (N / 64);
    for (int it = widx; it < items; it += nw) { int l2 = lane; asm volatile("" : "+v"(l2));
        p0_transpose_item(W, DM, N, WT, scr, it, l2, qkcols, shl, shwp); }
}
__device__ __forceinline__ void sincos_d(float angf, float& s, float& c) {
    const double a = (double)angf; const double kq = rint(a * 0.63661977236758134308); const double r = a - kq * 1.57079632679489661923; const double r2 = r * r;
    const double sp = r * (1.0 + r2 * (-1.0 / 6 + r2 * (1.0 / 120 + r2 * (-1.0 / 5040 + r2 * (1.0 / 362880 + r2 * (-1.0 / 39916800 + r2 * (1.0 / 6227020800.0)))))));
    const double cp = 1.0 + r2 * (-0.5 + r2 * (1.0 / 24 + r2 * (-1.0 / 720 + r2 * (1.0 / 40320 + r2 * (-1.0 / 3628800 + r2 * (1.0 / 479001600.0))))));
    const int q = ((int)kq) & 3;
    const double ss = (q == 0) ? sp : (q == 1) ? cp : (q == 2) ? -sp : -cp;
    const double cc = (q == 0) ? cp : (q == 1) ? -sp : (q == 2) ? -cp : sp;
    s = (float)ss; c = (float)cc;
}

__device__ __forceinline__ void ada_fill_sil(CArgsP ap, LAS float* sil, int tid) {
    for (int i = tid; i < 5 * DM; i += NWAVES * 64) { const int r = i / DM, k = i - r * DM; const float v = (r < 4) ? ap->in[I_C][r * DM + k] : ap->in[I_CCTX][k]; sil[i] = siluf_(v); }
}
__device__ __forceinline__ void ada_item(CArgsP ap, unsigned char* ws, const LAS float* sil, int l, int kc, int ng, int lane) {
    const int nq = ng * 64 + lane;
    const float* wp = ap->in[I_ADAW] + ((size_t)l * DM + kc * 128) * 6144 + nq * 4;
    f32x4 a0 = {0, 0, 0, 0}, a1 = a0, a2 = a0, a3 = a0, a4 = a0;
#pragma unroll 8
    for (int k = 0; k < 128; ++k) { const f32x4 w = *(const f32x4*)(wp + (size_t)k * 6144); const int kk = kc * 128 + k;
        a0 += w * sil[kk]; a1 += w * sil[DM + kk]; a2 += w * sil[2 * DM + kk]; a3 += w * sil[3 * DM + kk]; a4 += w * sil[4 * DM + kk]; }
    if (kc == 0) { const f32x4 bv = *(const f32x4*)(ap->in[I_ADAB] + l * 6144 + nq * 4); a0 += bv; a1 += bv; a2 += bv; a3 += bv; a4 += bv; }
    float* mp = (float*)(ws + WS_AGG) + ((size_t)(kc * 4 + l) * 5) * 6144 + nq * 4;
    *(f32x4*)(mp) = a0; *(f32x4*)(mp + 6144) = a1; *(f32x4*)(mp + 2 * 6144) = a2; *(f32x4*)(mp + 3 * 6144) = a3; *(f32x4*)(mp + 4 * 6144) = a4;
}
__device__ __forceinline__ void ada_layer(CArgsP ap, unsigned char* ws, const LAS float* sil, int l, int lane, int widx, int nw) {
    for (int it = widx; it < 384; it += nw) ada_item(ap, ws, sil, l, it / 24, it % 24, lane);
}
__device__ __forceinline__ void mods_reduce(CArgsP ap, unsigned char* ws, int l, int gt_, int NGT) {
    const float* part = (const float*)(ws + WS_AGG) + (size_t)l * 5 * 6144; float* mods = (float*)(ws + WS_MODS) + (size_t)l * 5 * 6144; float* GM = (float*)(ws + WS_GM) + (size_t)l * 5 * DM;
    for (int it = gt_; it < 5 * 6144 / 4; it += NGT) { f32x4 acc = {0.f, 0.f, 0.f, 0.f};
#pragma unroll
        for (int kc = 0; kc < 16; ++kc) acc += *(const f32x4*)(part + (size_t)kc * 4 * 5 * 6144 + (size_t)it * 4);
        *(f32x4*)(mods + (size_t)it * 4) = acc;
        const int r = (it * 4) / 6144, c = it * 4 - r * 6144;
        if (l >= 1 && c >= DM && c < 2 * DM) { const f32x4 g = *(const f32x4*)(ap->in[I_NORMG] + l * DM + (c - DM)); *(f32x4*)(GM + (size_t)r * DM + (c - DM)) = g * (acc + 1.0f); } }
}

__device__ __forceinline__ void fresh_ids(LAS unsigned char* ldsl, int& bx, int& wave, int& lane) {
    bx = __builtin_amdgcn_readfirstlane((int)((volatile LAS unsigned*)(ldsl + MISC_OFF))[12]); wave = __builtin_amdgcn_readfirstlane((int)((volatile LAS unsigned*)(ldsl + LDSCTL_OFF))[hw_slot()]); lane = lane_id_opaque();
    asm volatile("" : "+s"(bx), "+s"(wave), "+v"(lane));
}

enum { K_PRO, K_MODRED, K_PRE0, K_GEMM_BF16, K_GEMM_RES, K_GEMM_GATES, K_QKPOST, K_ATT_A, K_ATT_B, K_COMBINE, K_CONV, K_SCAN_AGG, K_SCAN_APPLY, K_FINAL };
template <int KIND, int layer, int PH, bool DUPRUN = false>
__device__ __forceinline__ void run_phase(char* ldsg, int wave_s) {
    LAS unsigned char* ldsl = (LAS unsigned char*)ldsg;
    CArgsP ap = (CArgsP)__builtin_amdgcn_kernarg_segment_ptr();
    asm volatile("" : "+s"(ap));
    int G = pg8::GRID, bx = __builtin_amdgcn_readfirstlane((int)((volatile LAS unsigned*)(ldsl + MISC_OFF))[12]), wave = wave_s;
    asm volatile("" : "+s"(G)); asm volatile("" : "+s"(bx)); asm volatile("" : "+s"(wave));
    int tid = wave * 64 + lane_id_opaque();
    asm volatile("" : "+v"(tid));
    const int lane = tid & 63;
    const int vcu = (G % 8 == 0) ? (bx % 8) * (G / 8) + bx / 8 : bx;
    const int gw = vcu * NWAVES + wave, NGW = G * NWAVES;
    const int gt_ = vcu * NWAVES * 64 + tid, NGT = G * NWAVES * 64;
    unsigned char* ws = ap->ws;
    float* mods = (float*)(ws + WS_MODS);
    float* tabc = (float*)(ws + WS_TAB); float* tabs = tabc + 96 * 32; float* c8t = (float*)(ws + WS_TAB + 65536);
    bf16_t* WA_IN = (bf16_t*)(ws + WS_WA_IN); bf16_t* WA_OUT = (bf16_t*)(ws + WS_WA_OUT); bf16_t* WB_IN = (bf16_t*)(ws + WS_WB_IN); bf16_t* WB_OUT = (bf16_t*)(ws + WS_WB_OUT);
    bf16_t* WR_IN = (bf16_t*)(ws + WS_WR_IN); bf16_t* WR_OUT = (bf16_t*)(ws + WS_WR_OUT); bf16_t* WG = (bf16_t*)(ws + WS_WG);
    float* X = (float*)(ws + WS_X); bf16_t* H = (bf16_t*)(ws + WS_H); bf16_t* Y = (bf16_t*)(ws + WS_Y); bf16_t* U = (bf16_t*)(ws + WS_U); bf16_t* OD = (bf16_t*)(ws + WS_OD);
    unsigned* SAB = (unsigned*)(ws + WS_SA); float* AGG = (float*)(ws + WS_AGG);
    bf16_t* UP = (bf16_t*)(ws + WS_UP); float* GM = (float*)(ws + WS_GM); float* SHW = (float*)(ws + WS_SHW); float* SSQ = (float*)(ws + WS_SSQ);
    (void)GM; (void)SHW; (void)SSQ; (void)mods; (void)tabc; (void)tabs; (void)c8t; (void)WA_IN; (void)WA_OUT; (void)WB_IN; (void)WB_OUT; (void)WR_IN; (void)WR_OUT; (void)WG; (void)X; (void)H; (void)Y; (void)U; (void)OD; (void)SAB; (void)AGG; (void)UP;
    (void)gw; (void)NGW; (void)gt_; (void)NGT; (void)lane; (void)ldsl;

    if constexpr (KIND == K_PRO) {
        for (int rep_a = 0; rep_a < (DUP_SUB == 1 ? 2 : 1); ++rep_a)
        {
            LAS float* sil = (LAS float*)ldsl;
            ada_fill_sil(ap, sil, tid); __syncthreads();
            if (wave < 3) { const int it = bx + 256 * wave; ada_item(ap, ws, sil, it / 384, (it % 384) / 24, it % 24, lane); }
            __syncthreads();
        }
        for (int rep_b = 0; rep_b < (DUP_SUB == 2 ? 2 : 1); ++rep_b) {
            LAS bf16_t* scr = (LAS bf16_t*)(ldsl + wave * 16384);
            constexpr int I_AIN = (DM / 64) * (A_IN / 64), I_SQ = (DM / 64) * (DM / 64), I_BIN = (DM / 64) * (B_IN / 64);
            constexpr int NITEMS = I_AIN + I_SQ + I_BIN;
            for (int it = gw; it < NITEMS; it += NGW) {
                int r = it;
                if (r < I_AIN) { p0_transpose_item(ap->in[I_AWIN], DM, A_IN, WA_IN, scr, r, lane, 2560); continue; } r -= I_AIN;
                if (r < I_SQ) { p0_transpose_item(ap->in[I_AWOUT], DM, DM, WA_OUT, scr, r, lane, 0); continue; } r -= I_SQ;
                p0_transpose_item(ap->in[I_BWIN], DM, B_IN, WB_IN, scr, r, lane, 4096);
            }
        }
        for (int it = gt_; it < 96 * 32; it += NGT) { const int pos = it >> 5, j = it & 31; const float freq = powf(10000.0f, -(float)j / 32.0f); const float p = (float)(pos < 32 ? pos : pos - 32);
            float s, c; sincos_d(p * freq, s, c); tabc[it] = c; tabs[it] = s; }
        for (int it = gt_; it < 2 * DM; it += NGT) { const float lam = ap->in[I_RLAM][it]; const float z = -lam; const float sp = fmaxf(z, 0.f) + log1pf(__expf(-fabsf(z))); c8t[it] = 8.0f * sp; }
    }
    else if constexpr (KIND == K_MODRED) {
        mods_reduce(ap, ws, 0, gt_, NGT); mods_reduce(ap, ws, 1, gt_, NGT);
    }
    else if constexpr (KIND == K_PRE0) {
        { const float* gsrc = ap->in[I_NORMG];
          for (int row = gw; row < MROWS; row += NGW) {
            const int b = row / TT, t = row - b * TT; const float* mrow = mods + (size_t)(t < CTXL ? 4 : b) * 6144;
            const float* xsrc = (t < CTXL) ? ap->in[I_CTX] + (size_t)(b * CTXL + t) * DM : ap->in[I_X] + (size_t)(b * SEQ + t - CTXL) * DM;
            const f32x4* xr = (const f32x4*)xsrc + lane; f32x4 v[8]; float s = 0.f;
#pragma unroll
            for (int j = 0; j < 8; ++j) { v[j] = xr[64 * j]; s += (v[j].x * v[j].x + v[j].y * v[j].y) + (v[j].z * v[j].z + v[j].w * v[j].w); }
            s = wave_sum(s);
            if (lane < 32) SSQ[(size_t)row * 32 + lane] = (lane == 0) ? s : 0.f;
            u32x2* o8 = (u32x2*)(H + (size_t)row * DM) + lane;
#pragma unroll
            for (int j = 0; j < 8; ++j) { const int c = 4 * lane + 256 * j; const f32x4 g = *(const f32x4*)(gsrc + c), sc = *(const f32x4*)(mrow + DM + c);
                const f32x4 y = v[j] * g * (sc + 1.0f); u32x2 w; w.x = pk2(y.x, y.y); w.y = pk2(y.z, y.w); o8[64 * j] = w; }
          } }
        for (int l = 0; l < 2; ++l) {
            LAS float* shl = (LAS float*)ldsl;
            __syncthreads();
            for (int i = tid; i < 5 * DM; i += NWAVES * 64) { const int r = i >> 11, k = i & (DM - 1); shl[i] = mods[(size_t)(l * 5 + r) * 6144 + k]; }
            __syncthreads();
            const bf16_t* Wt = (l == 0) ? WA_IN : (l == 3) ? WA_IN + (size_t)A_IN * DM : (l == 1) ? WB_IN : WR_IN; const int N = (l == 1) ? B_IN : (l == 2) ? R_IN : A_IN;
            for (int n = gw; n < N; n += NGW) { float a0 = 0.f, a1 = 0.f, a2 = 0.f, a3 = 0.f, a4 = 0.f;
#pragma unroll
                for (int j = 0; j < 4; ++j) { const int k0 = j * 512 + lane * 8; const u32x4 w = *(const u32x4*)(Wt + (size_t)n * DM + k0);
                    const float wf[8] = {bflo(w.x), bfhi(w.x), bflo(w.y), bfhi(w.y), bflo(w.z), bfhi(w.z), bflo(w.w), bfhi(w.w)};
#pragma unroll
                    for (int e = 0; e < 8; ++e) { a0 += wf[e] * shl[k0 + e]; a1 += wf[e] * shl[DM + k0 + e]; a2 += wf[e] * shl[2 * DM + k0 + e]; a3 += wf[e] * shl[3 * DM + k0 + e]; a4 += wf[e] * shl[4 * DM + k0 + e]; } }
                a0 = wave_sum(a0); a1 = wave_sum(a1); a2 = wave_sum(a2); a3 = wave_sum(a3); a4 = wave_sum(a4);
                if (lane == 0) { float* o = SHW + (size_t)l * 5 * 8192 + n; o[0] = a0; o[8192] = a1; o[2 * 8192] = a2; o[3 * 8192] = a3; o[4 * 8192] = a4; } }
        }
    }
    else if constexpr (KIND == K_GEMM_BF16) {
        constexpr size_t OB = (layer == 0) ? WS_WA_IN : (layer == 3) ? WS_WA_IN + (size_t)A_IN * DM * 2 : (layer == 1) ? WS_WB_IN : WS_WR_IN;
        constexpr int N = (layer == 1) ? B_IN : (layer == 2) ? R_IN : A_IN;
        pg8::EpiBf16<layer, N> E{ws, ap};
        if constexpr (layer == 0) {
            typedef pg8::Sched<MROWS / 256, N / 256, DM / 64, 0, 0, TAIL_SPLIT> SchedT; SchedT S; S.init(bx, vcu);
            pg8::gemm_phase<pg8::EpiBf16<layer, N>, SchedT, DM / 64, PH, WS_H, OB>(ldsl, tid, S, E);
            if constexpr (!DUPRUN && SchedT::F == 1 && SchedT::T > 0) { int bx, wave, lane; fresh_ids(ldsl, bx, wave, lane); const int tid = wave * 64 + lane; if (bx >= SchedT::T) {
                CArgsP ap2 = (CArgsP)__builtin_amdgcn_kernarg_segment_ptr(); asm volatile("" : "+s"(ap2)); const CArgsP ap = ap2; unsigned char* const ws = ap2->ws;
                const int widx = (bx - SchedT::T) * NWAVES + wave, nw = (pg8::GRID - SchedT::T) * NWAVES;
                LAS float* sil = (LAS float*)ldsl; ada_fill_sil(ap, sil, tid); __syncthreads(); ada_layer(ap, ws, sil, 2, lane, widx, nw); ada_layer(ap, ws, sil, 3, lane, widx, nw); } }
        } else {
            constexpr int CLO = (layer == 3) ? 8 : 0, CHI = (layer == 3) ? 12 : N / 256;
            typedef pg8::SchedM<N / 256, DM / 64, CLO, CHI> SchedT; SchedT S; S.init(bx, vcu);
            constexpr size_t OB0 = (layer == 1) ? WS_WA_OUT : (layer == 2) ? WS_WB_OUT : WS_WR_OUT;
            pg8::EpiResid<layer - 1, false> E0{ws, ap};
            pg8::gemm_phase<pg8::EpiBf16<layer, N>, SchedT, DM / 64, PH, WS_H, OB, pg8::EpiResid<layer - 1, false>, WS_Y, OB0>(ldsl, tid, S, E, E0);
            if constexpr (!DUPRUN && SchedT::T > 0) { int bx, wave, lane; fresh_ids(ldsl, bx, wave, lane); const int tid = wave * 64 + lane; (void)tid; if (bx >= SchedT::T) {
                CArgsP ap2 = (CArgsP)__builtin_amdgcn_kernarg_segment_ptr(); asm volatile("" : "+s"(ap2)); const CArgsP ap = ap2; unsigned char* const ws = ap2->ws;
                const int widx = (bx - SchedT::T) * NWAVES + wave, nw = (pg8::GRID - SchedT::T) * NWAVES;
                if constexpr (layer == 1) { conv_job(ap->in[I_BWOUT], DM, (bf16_t*)(ws + WS_WB_OUT), 0, 0, ws, ldsl, wave, lane, widx, nw); conv_job(ap->in[I_RWIN], R_IN, (bf16_t*)(ws + WS_WR_IN), 0, 2, ws, ldsl, wave, lane, widx, nw); }
                if constexpr (layer == 2) { conv_job(ap->in[I_RWOUT], DM, (bf16_t*)(ws + WS_WR_OUT), 0, 0, ws, ldsl, wave, lane, widx, nw); conv_job(ap->in[I_AWIN] + (size_t)DM * A_IN, A_IN, (bf16_t*)(ws + WS_WA_IN) + (size_t)A_IN * DM, 2560, 3, ws, ldsl, wave, lane, widx, nw);
                    conv_job(ap->in[I_AWOUT] + (size_t)DM * DM, DM, (bf16_t*)(ws + WS_WA_OUT) + (size_t)DM * DM, 0, 0, ws, ldsl, wave, lane, widx, nw);
                    LAS bf16_t* scr = (LAS bf16_t*)(ldsl + wave * 16384);
                    for (int it = widx; it < 32 * 16; it += nw) { const int mtx = it >> 4, sub = it & 15; const int gate = mtx >> 4, dir = (mtx >> 3) & 1, nblk = mtx & 7;
                        p0_transpose_item((gate ? ap->in[I_RWX] : ap->in[I_RWA]) + (size_t)(dir * 8 + nblk) * 65536, 256, 256, (bf16_t*)(ws + WS_WG), scr, sub, lane, -(mtx + 1)); } } } }
        }
    }
    else if constexpr (KIND == K_GEMM_RES) {
        constexpr size_t OB = (layer == 0) ? WS_WA_OUT : (layer == 3) ? WS_WA_OUT + (size_t)DM * DM * 2 : (layer == 1) ? WS_WB_OUT : WS_WR_OUT;
        typedef pg8::Sched<32, DM / 256, DM / 64, 1, 0, TAIL_SPLIT> SchedT; SchedT S; S.init(bx, vcu);
        pg8::EpiResid<layer, DUPRUN> E{ws, ap};
        pg8::gemm_phase<pg8::EpiResid<layer, DUPRUN>, SchedT, DM / 64, PH, WS_Y, OB>(ldsl, tid, S, E);
    }
    else if constexpr (KIND == K_GEMM_GATES) {
        typedef pg8::Sched<MROWS / 256, 32, 4, 0, 1, false> SchedT; SchedT S; S.init(bx, vcu);
        pg8::EpiGates E{ws, ap};
        pg8::gemm_phase<pg8::EpiGates, SchedT, 4, PH, WS_UP, WS_WG>(ldsl, tid, S, E);
    }
    else if constexpr (KIND == K_ATT_A) {
        if constexpr (layer == 0 && !DUPRUN) { mods_reduce(ap, ws, 2, gt_, NGT); mods_reduce(ap, ws, 3, gt_, NGT); }
        const int nlat = 512, ntot = (layer == 0) ? 576 : 512;
        for (int u = vcu; u < ntot; u += G) {
            int b, h, qrow, seq;
            if (u < nlat) { const int qb = u & 7, hh = (u >> 3) & 15; b = u >> 7; h = hh; qrow = b * TT + CTXL + qb * 256; seq = TT; }
            else { const int v = u - nlat; b = v >> 4; h = v & 15; qrow = b * TT; seq = CTXL; }
            const int g4 = h >> 2;
            const bf16_t* Qb = U + (size_t)qrow * A_IN + h * 128;
            const bf16_t* Kh = U + (size_t)(b * TT) * A_IN + 2048 + g4 * 128;
            const bf16_t* Vh = U + (size_t)(b * TT) * A_IN + 2560 + g4 * 128;
            const bf16_t* Zb = U + (size_t)qrow * A_IN + 3072 + h * 128;
            att::attn_unit<A_IN, DM, true>(Qb, Kh, Vh, Y + (size_t)qrow * DM + h * 128, Zb, seq, ldsg, tid);
        }
    }
    else if constexpr (KIND == K_ATT_B) {
        for (int u = vcu; u < 1152; u += G) {
            int b, h, mv, qrow, seq;
            if (u < 1024) { const int qb = u & 7; mv = (u >> 3) & 3; h = (u >> 5) & 7; b = u >> 8; qrow = b * TT + CTXL + qb * 256; seq = TT; }
            else { const int v = u - 1024; mv = v & 3; h = (v >> 2) & 7; b = v >> 5; qrow = b * TT; seq = CTXL; }
            const int m = mv >> 1, vh = mv & 1;
            const bf16_t* Qb = U + (size_t)qrow * B_IN + m * 1024 + h * 128;
            const bf16_t* Kh = U + (size_t)(b * TT) * B_IN + 2048 + m * 1024 + h * 128;
            const bf16_t* Vh = U + (size_t)(b * TT) * B_IN + 4096 + h * 256 + vh * 128;
            att::attn_unit<B_IN, 4096, false>(Qb, Kh, Vh, OD + (size_t)qrow * 4096 + (m * 8 + h) * 256 + vh * 128, nullptr, seq, ldsg, tid);
        }
    }
    else if constexpr (KIND == K_COMBINE) {
        float s1 = ap->in[I_BLAM][lane] * ap->in[I_BLAM][128 + lane] + ap->in[I_BLAM][64 + lane] * ap->in[I_BLAM][192 + lane];
        float s2 = ap->in[I_BLAM][256 + lane] * ap->in[I_BLAM][384 + lane] + ap->in[I_BLAM][320 + lane] * ap->in[I_BLAM][448 + lane];
        s1 = wave_sum(s1); s2 = wave_sum(s2);
        const float lam = expf(s1) - expf(s2) + LAM_INIT1;
        const int hsel = lane >> 5, j = lane & 31;
        for (int it0 = gw; it0 < MROWS * 4; it0 += 2 * NGW) {
            u32x4 r0v[2], r1v[2], zrv[2]; bool ok[2];
#pragma unroll
            for (int q = 0; q < 2; ++q) { const int it = it0 + q * NGW; ok[q] = it < MROWS * 4; const int itc = ok[q] ? it : 0; const int row = itc >> 2, h = (itc & 3) * 2 + hsel;
                r0v[q] = *(const u32x4*)(OD + (size_t)row * 4096 + h * 256 + j * 8); r1v[q] = *(const u32x4*)(OD + (size_t)row * 4096 + (8 + h) * 256 + j * 8); zrv[q] = *(const u32x4*)(U + (size_t)row * B_IN + 6144 + h * 256 + j * 8); }
#pragma unroll
            for (int q = 0; q < 2; ++q) if (ok[q]) { const int it = it0 + q * NGW; const int row = it >> 2, h = (it & 3) * 2 + hsel; const u32x4 r0 = r0v[q], r1 = r1v[q], zr = zrv[q];
                float o[8] = {bflo(r0.x) - lam * bflo(r1.x), bfhi(r0.x) - lam * bfhi(r1.x), bflo(r0.y) - lam * bflo(r1.y), bfhi(r0.y) - lam * bfhi(r1.y),
                              bflo(r0.z) - lam * bflo(r1.z), bfhi(r0.z) - lam * bfhi(r1.z), bflo(r0.w) - lam * bflo(r1.w), bfhi(r0.w) - lam * bfhi(r1.w)};
                const float z[8] = {bflo(zr.x), bfhi(zr.x), bflo(zr.y), bfhi(zr.y), bflo(zr.z), bfhi(zr.z), bflo(zr.w), bfhi(zr.w)};
                float ss = 0.f;
#pragma unroll
                for (int k = 0; k < 8; ++k) ss += o[k] * o[k];
                ss += shx<1>(ss); ss += shx<2>(ss); ss += shx<4>(ss); ss += shx<8>(ss); ss += shx<16>(ss);
                const float rstd = frsq(ss * (1.0f / 256.0f) + EPS); const float* sg = ap->in[I_BSUBG] + j * 8;
#pragma unroll
                for (int k = 0; k < 8; ++k) o[k] = (o[k] * rstd * sg[k]) * (1.0f - LAM_INIT1) * siluf_(z[k]);
                u32x4 w; w.x = pk2(o[0], o[1]); w.y = pk2(o[2], o[3]); w.z = pk2(o[4], o[5]); w.w = pk2(o[6], o[7]);
                *(u32x4*)(Y + (size_t)row * DM + h * 256 + j * 8) = w; }
        }
    }
    else if constexpr (KIND == K_CONV) {
        const int c8 = (gt_ & 255) * 8;
        f32x4 wv[4][2], bv[2];
#pragma unroll
        for (int jj = 0; jj < 4; ++jj) { wv[jj][0] = *(const f32x4*)(ap->in[I_RCONVW] + jj * DM + c8); wv[jj][1] = *(const f32x4*)(ap->in[I_RCONVW] + jj * DM + c8 + 4); }
        bv[0] = *(const f32x4*)(ap->in[I_RCONVB] + c8); bv[1] = *(const f32x4*)(ap->in[I_RCONVB] + c8 + 4);
        for (int it = gt_; it < (MROWS / 4) * 256; it += NGT) {
            const int row0 = (it >> 8) * 4; const int b = row0 / TT, t0 = row0 - b * TT; const int lo = (t0 < CTXL) ? 0 : CTXL, hi_ = (t0 < CTXL) ? CTXL : TT;
            u32x4 rv[7];
#pragma unroll
            for (int q = 0; q < 7; ++q) { const int ts = t0 + q - 2; rv[q] = (ts >= lo && ts < hi_) ? *(const u32x4*)(U + (size_t)(b * TT + ts) * R_IN + c8) : (u32x4){0u, 0u, 0u, 0u}; }
#pragma unroll
            for (int r = 0; r < 4; ++r) { f32x4 a0 = bv[0], a1 = bv[1];
#pragma unroll
                for (int jj = 0; jj < 4; ++jj) { const u32x4 x = rv[r + jj]; a0 += (f32x4){bflo(x.x), bfhi(x.x), bflo(x.y), bfhi(x.y)} * wv[jj][0]; a1 += (f32x4){bflo(x.z), bfhi(x.z), bflo(x.w), bfhi(x.w)} * wv[jj][1]; }
                u32x4 o; o.x = pk2(a0.x, a0.y); o.y = pk2(a0.z, a0.w); o.z = pk2(a1.x, a1.y); o.w = pk2(a1.z, a1.w);
                *(u32x4*)(UP + (size_t)(row0 + r) * DM + c8) = o; }
        }
    }
    else if constexpr (KIND == K_SCAN_AGG) {
        const float* __restrict__ AGA = (const float*)(ws + WS_AG16); const float* __restrict__ AGB = AGA + (size_t)576 * 2 * DM; float* __restrict__ CAR = (float*)(ws + WS_CARRY);
        if (wave == 0 && vcu < 256) { const int b = vcu >> 6, dir = (vcu >> 5) & 1, ch = (vcu & 31) * 64 + lane; float h = 0.f;
            for (int k = 0; k < 9; ++k) {
                float av[16], bv[16]; unsigned off[16];
#pragma unroll
                for (int j = 0; j < 16; ++j) { const int q = 16 * k + j; const int c = dir ? (q < 16 ? 15 - q : 159 - q) : q; off[j] = (unsigned)(((b * 144 + c) * 2 + dir) * DM + ch); av[j] = AGA[off[j]]; bv[j] = AGB[off[j]]; }
#pragma unroll
                for (int j = 0; j < 16; ++j) { CAR[off[j]] = h; h = fmaf(av[j], h, bv[j]); }
            } }
    }
    else if constexpr (KIND == K_SCAN_APPLY) {
        const float* __restrict__ CAR = (const float*)(ws + WS_CARRY); const unsigned* __restrict__ SABr = SAB; const bf16_t* __restrict__ Ur = U; bf16_t* __restrict__ Yr = Y;
        for (int it = gt_; it < 576 * 512; it += NGT) {
            const int c4 = it & 511, g = it >> 9; const unsigned r0 = (unsigned)g * 16u;
            f32x4 hf = *(const f32x4*)(CAR + ((size_t)g * 2) * DM + c4 * 4), hr = *(const f32x4*)(CAR + ((size_t)g * 2 + 1) * DM + c4 * 4);
            u32x4 wf[16], wrv[16]; u32x2 zr[16];
#pragma unroll
            for (int s = 0; s < 16; ++s) { wf[s] = *(const u32x4*)(SABr + ((size_t)(r0 + s) * 2) * DM + c4 * 4); wrv[s] = *(const u32x4*)(SABr + ((size_t)(r0 + s) * 2 + 1) * DM + c4 * 4); zr[s] = *(const u32x2*)(Ur + (size_t)(r0 + s) * R_IN + DM + c4 * 4); }
            f32x4 hfv[16];
#pragma unroll
            for (int s = 0; s < 16; ++s) { const u32x4 w = wf[s];
                const f32x4 a = {__expf(bflo(w.x)), __expf(bflo(w.y)), __expf(bflo(w.z)), __expf(bflo(w.w))}, bb = {bfhi(w.x), bfhi(w.y), bfhi(w.z), bfhi(w.w)}; hf = a * hf + bb; hfv[s] = hf; }
#pragma unroll
            for (int s = 15; s >= 0; --s) { const u32x4 w = wrv[s];
                const f32x4 a = {__expf(bflo(w.x)), __expf(bflo(w.y)), __expf(bflo(w.z)), __expf(bflo(w.w))}, bb = {bfhi(w.x), bfhi(w.y), bfhi(w.z), bfhi(w.w)}; hr = a * hr + bb;
                const f32x4 y = hfv[s] + hr;
                u32x2 o; o.x = pk2(y.x * siluf_(bflo(zr[s].x)), y.y * siluf_(bfhi(zr[s].x))); o.y = pk2(y.z * siluf_(bflo(zr[s].y)), y.w * siluf_(bfhi(zr[s].y)));
                *(u32x2*)(Yr + (size_t)(r0 + s) * DM + c4 * 4) = o; }
        }
    }
    else {
        const float* gsrc = ap->in[I_NORMF];
        for (int r = gw; r < NB * SEQ; r += NGW) {
            const int b = r >> 11, t = r & (SEQ - 1); const size_t row = (size_t)b * TT + CTXL + t;
            const f32x4* xr = (const f32x4*)(X + row * DM) + lane; f32x4 v[8]; float s = 0.f;
#pragma unroll
            for (int j = 0; j < 8; ++j) { v[j] = xr[64 * j]; s += (v[j].x * v[j].x + v[j].y * v[j].y) + (v[j].z * v[j].z + v[j].w * v[j].w); }
            const float rstd = 1.0f / sqrtf(wave_sum(s) * (1.0f / DM) + EPS);
            f32x4* o = (f32x4*)(ap->out + (size_t)r * DM) + lane;
#pragma unroll
            for (int j = 0; j < 8; ++j) { const f32x4 g = *(const f32x4*)(gsrc + 4 * lane + 256 * j); o[64 * j] = (v[j] * rstd) * g; }
        }
    }
}

constexpr int N_PHASES_C = 19;
__global__ void __launch_bounds__(NWAVES * 64, 2) fwd_mega(Args args) {
    extern __shared__ __attribute__((aligned(16))) unsigned char lds[];
    LAS unsigned char* ldsl0 = (LAS unsigned char*)lds;
    for (int u = threadIdx.x; u < (LDS_BYTES - LDSCTL_OFF) / 4; u += NWAVES * 64) ((LAS unsigned*)(ldsl0 + LDSCTL_OFF))[u] = 0u;
    __syncthreads();
    { const int wv = __builtin_amdgcn_readfirstlane((int)threadIdx.x >> 6); if ((threadIdx.x & 63) == 0) ((volatile LAS unsigned*)(ldsl0 + LDSCTL_OFF))[hw_slot()] = (unsigned)wv;
      if (threadIdx.x == 0) ((volatile LAS unsigned*)(ldsl0 + MISC_OFF))[12] = blockIdx.x;
      if (!MK_PER_PHASE) (void)xcd_barrier_post((unsigned*)((gu32*)(args.ws + WS_CTL) + CW_BAR), (volatile LAS unsigned*)(ldsl0 + MISC_OFF) + 8, threadIdx.x == 0); }
    __syncthreads();
#define WAVE_IDX() ((int)__builtin_amdgcn_readfirstlane((int)((volatile LAS unsigned*)((LAS unsigned char*)lds + LDSCTL_OFF))[hw_slot()]))
#define KARG() ({ CArgsP ap_ = (CArgsP)__builtin_amdgcn_kernarg_segment_ptr(); asm volatile("" : "+s"(ap_)); ap_; })
#define GRID_BAR() do { CArgsP ap_ = KARG(); XcdBarrier b_; b_.bar = (unsigned*)((gu32*)(ap_->ws + WS_CTL) + CW_BAR); b_.x = xb_xcc_id(); b_.st = (volatile LAS unsigned*)((LAS unsigned char*)lds + MISC_OFF) + 8; xcd_barrier(b_, WAVE_IDX()); } while (0)
#if MK_PER_PHASE
#define PHASE(k, KIND, LAYER) if constexpr ((PH_MASK >> (k)) & 1) { CArgsP apq_ = KARG(); const int lo = apq_->ph_lo, hi = apq_->ph_hi; if (lo <= (k) && (k) < hi) { run_phase<KIND, LAYER, (k)>((char*)lds, WAVE_IDX()); } }
#else
#define PHASE(k, KIND, LAYER) if constexpr ((PH_MASK >> (k)) & 1) { run_phase<KIND, LAYER, (k)>((char*)lds, WAVE_IDX()); \
        if constexpr ((DUP_MASK >> (k)) & 1) { GRID_BAR(); run_phase<KIND, LAYER, 24 + ((k) & 7), true>((char*)lds, WAVE_IDX()); } \
        if constexpr ((k) + 1 < N_PHASES_C) { GRID_BAR(); if (DUP_BAR) GRID_BAR(); } }
#endif
    PHASE(0, K_PRO, 0) PHASE(1, K_MODRED, 0) PHASE(2, K_PRE0, 0)
    PHASE(3, K_GEMM_BF16, 0) PHASE(4, K_ATT_A, 0) PHASE(5, K_GEMM_RES, 0)
    PHASE(6, K_GEMM_BF16, 1) PHASE(7, K_ATT_B, 1) PHASE(8, K_COMBINE, 1) PHASE(9, K_GEMM_RES, 1)
    PHASE(10, K_GEMM_BF16, 2) PHASE(11, K_CONV, 2) PHASE(12, K_GEMM_GATES, 2) PHASE(13, K_SCAN_AGG, 2) PHASE(14, K_SCAN_APPLY, 2) PHASE(15, K_GEMM_RES, 2)
    PHASE(16, K_GEMM_BF16, 3) PHASE(17, K_ATT_A, 3) PHASE(18, K_GEMM_RES, 3)
#undef PHASE
#undef GRID_BAR
#undef KARG
#undef WAVE_IDX
}

constexpr int N_PHASES = N_PHASES_C;
extern "C" void kernel_launch(void* const* d_in, const int* in_sizes, int n_in, void* d_out, int out_size, void* d_ws, size_t ws_size, hipStream_t stream) {
    static int grid = 0;
    if (grid == 0) {
        if (n_in != 25 || in_sizes[0] != NB * SEQ * DM || out_size != NB * SEQ * DM || ws_size < WS_END) {
            fprintf(stderr, "kernel_launch: unexpected shapes: n_in %d in0 %d out %d ws %zu (need %zu)\n", n_in, n_in > 0 ? in_sizes[0] : -1, out_size, ws_size, (size_t)WS_END); grid = -1; return; }
        int dev = 0, cus = 0, per_cu = 0;
        if (hipGetDevice(&dev) != hipSuccess || hipDeviceGetAttribute(&cus, hipDeviceAttributeMultiprocessorCount, dev) != hipSuccess) { fprintf(stderr, "kernel_launch: device query failed\n"); grid = -1; return; }
        if (hipFuncSetAttribute((const void*)fwd_mega, hipFuncAttributeMaxDynamicSharedMemorySize, LDS_BYTES) != hipSuccess) { fprintf(stderr, "kernel_launch: hipFuncSetAttribute failed\n"); grid = -1; return; }
        if (hipOccupancyMaxActiveBlocksPerMultiprocessor(&per_cu, (const void*)fwd_mega, NWAVES * 64, LDS_BYTES) != hipSuccess || per_cu < 1) { fprintf(stderr, "kernel_launch: occupancy query says %d blocks/CU\n", per_cu); grid = -1; (void)hipGetLastError(); return; }
        if (cus != 256) { fprintf(stderr, "kernel_launch: built for a 256-CU device (MI355X), found %d CUs; nothing launched\n", cus); grid = -1; return; }
        grid = cus;
    }
    if (grid < 0) return;
    (void)hipMemsetAsync((char*)d_ws + WS_CTL, 0, CTL_ZERO_BYTES, stream);
    Args a{};
    for (int i = 0; i < 25; ++i) a.in[i] = (const float*)d_in[i];
    a.out = (float*)d_out; a.ws = (unsigned char*)d_ws;
#if MK_PER_PHASE
    for (int p = 0; p < N_PHASES; ++p) { a.ph_lo = p; a.ph_hi = p + 1; hipLaunchKernelGGL(fwd_mega, dim3(grid), dim3(NWAVES * 64), LDS_BYTES, stream, a); }
#else
    a.ph_lo = 0; a.ph_hi = N_PHASES;
    void* kargs[] = {&a};
    hipError_t e = hipLaunchCooperativeKernel((const void*)fwd_mega, dim3(grid), dim3(NWAVES * 64), kargs, LDS_BYTES, stream);
    if (e != hipSuccess) fprintf(stderr, "kernel_launch: cooperative launch failed: %s (grid %d)\n", hipGetErrorString(e), grid);
#endif
}
```

```cpp
#include <hip/hip_runtime.h>
#include <cstdio>
#include <cstdint>
#include <cmath>

#ifndef PH_MASK
#define PH_MASK 0x7ffff
#endif
#ifndef DUP_MASK
#define DUP_MASK 0
#endif
#ifndef DUP_SUB
#define DUP_SUB 0
#endif
#ifndef DUP_BAR
#define DUP_BAR 0
#endif
#ifndef TAIL_SPLIT
#define TAIL_SPLIT false
#endif
#ifndef MK_PER_PHASE
#define MK_PER_PHASE 0
#endif

constexpr int NB = 4, SEQ = 2048, CTXL = 256, DM = 2048, TT = SEQ + CTXL  , MROWS = NB * TT  ;
constexpr int A_IN = 5120, B_IN = 8192, R_IN = 4096;
constexpr float EPS = 1e-6f;
constexpr int CH = 32, NCH = TT / CH  , NCC = CTXL / CH  ;
constexpr float LAM_INIT1 = 0.35550906759096927f;

typedef unsigned short bf16_t;
typedef short bf16x8 __attribute__((ext_vector_type(8)));
typedef short s16x4 __attribute__((ext_vector_type(4)));
typedef float f32x4 __attribute__((ext_vector_type(4)));
typedef float f32x8 __attribute__((ext_vector_type(8)));
typedef float f32x16 __attribute__((ext_vector_type(16)));
typedef unsigned u32x4 __attribute__((ext_vector_type(4)));
typedef unsigned u32x2 __attribute__((ext_vector_type(2)));
#define LAS __attribute__((address_space(3)))
#define GAS __attribute__((address_space(1)))

__device__ __forceinline__ unsigned pk2(float lo, float hi) { unsigned r; asm("v_cvt_pk_bf16_f32 %0, %1, %2" : "=v"(r) : "v"(lo), "v"(hi)); return r; }
__device__ __forceinline__ unsigned f2bf(float f) { return pk2(f, 0.f) & 0xffffu; }
__device__ __forceinline__ float bflo(unsigned w) { return __uint_as_float(w << 16); }
__device__ __forceinline__ float bfhi(unsigned w) { return __uint_as_float(w & 0xffff0000u); }
__device__ __forceinline__ float bf1(bf16_t v) { return __uint_as_float((unsigned)v << 16); }
__device__ __forceinline__ unsigned cvt_pk_bf16(float lo, float hi) { unsigned r; asm volatile("v_cvt_pk_bf16_f32 %0, %1, %2" : "=v"(r) : "v"(lo), "v"(hi)); return r; }
__device__ __forceinline__ float frcp(float x) { return __builtin_amdgcn_rcpf(x); }
__device__ __forceinline__ float frsq(float x) { return __builtin_amdgcn_rsqf(x); }
__device__ __forceinline__ float fsqrt_(float x) { return __builtin_amdgcn_sqrtf(x); }
__device__ __forceinline__ float sigmoidf_(float x) { return frcp(1.0f + __expf(-x)); }
__device__ __forceinline__ float siluf_(float x) { return x * frcp(1.0f + __expf(-x)); }
template <int M> __device__ __forceinline__ float shx(float v) { return __int_as_float(__builtin_amdgcn_ds_swizzle(__float_as_int(v), (M << 10) | 0x1f)); }
__device__ __forceinline__ float wave_sum(float v) {
    v += shx<1>(v); v += shx<2>(v); v += shx<4>(v); v += shx<8>(v); v += shx<16>(v);
    auto rr = __builtin_amdgcn_permlane32_swap(__float_as_uint(v), __float_as_uint(v), false, false);
    return __uint_as_float(rr[0]) + __uint_as_float(rr[1]);
}

constexpr size_t MiB = 1u << 20;
constexpr size_t WS_CTL = 0, WS_MODS = 1 * MiB, CTL_ZERO_BYTES = 2 * MiB;
constexpr size_t WS_GM = 2 * MiB + 128 * 1024;
constexpr size_t WS_SHW = 2 * MiB + 512 * 1024;
constexpr size_t WS_SSQ = 282 * MiB;
constexpr size_t WS_FSQ = 281 * MiB;
constexpr size_t WS_SHWP = 568 * MiB;
constexpr size_t WS_TAB = 2 * MiB;
constexpr size_t WS_WA_IN = 4 * MiB, WS_WA_OUT = 44 * MiB, WS_WB_IN = 60 * MiB, WS_WB_OUT = 92 * MiB, WS_WR_IN = 100 * MiB, WS_WR_OUT = 116 * MiB, WS_WG = 124 * MiB;
constexpr size_t WS_X = 128 * MiB;
constexpr size_t WS_H = 200 * MiB;
constexpr size_t WS_Y = 236 * MiB;
constexpr size_t WS_AGG = 272 * MiB;
constexpr size_t WS_U = 284 * MiB;
constexpr size_t WS_OD = 428 * MiB;
constexpr size_t WS_UP = 356 * MiB;
constexpr size_t WS_SA = 392 * MiB;
constexpr size_t WS_AG16 = 536 * MiB;
constexpr size_t WS_CARRY = 556 * MiB;
constexpr size_t WS_SLAB = 568 * MiB;
constexpr size_t WS_DUMMY = 632 * MiB;
constexpr size_t WS_END = 536 * MiB;
constexpr int CW_BAR = 4096, CW_SEAM = 16384;

struct Args { const float* in[25]; float* out; unsigned char* ws; int ph_lo, ph_hi; };
typedef const __attribute__((address_space(4))) Args* CArgsP;
enum { I_X = 0, I_C, I_CTX, I_CCTX, I_ADAW, I_ADAB, I_NORMG, I_NORMF, I_AWIN, I_AQG, I_AKG, I_AWOUT, I_BWIN, I_BLAM, I_BSUBG, I_BWOUT,
       I_RWIN, I_RCONVW, I_RCONVB, I_RWA, I_RBA, I_RWX, I_RBX, I_RLAM, I_RWOUT };


__host__ __device__ __forceinline__ int qk_pi(int c) { return (c & 64) | (((c >> 2) & 1) << 5) | (((c >> 3) & 7) << 2) | (c & 3); }
__host__ __device__ __forceinline__ int qk_pi_inv(int e) { return (e & 64) | (((e >> 2) & 7) << 3) | (((e >> 5) & 1) << 2) | (e & 3); }

namespace pg8 {
constexpr int BM = 256, BK = 64, HALF = 128, HTB = HALF * BK * 2, STAGE_BYTES = 8 * HTB, NXCD = 8, WGM = 8;
__host__ __device__ __forceinline__ int lds_byte(int r, int c) { const int st = (r >> 4) * 2 + (c >> 5), rr = r & 15, cc = c & 31, ob = rr * 64 + cc * 2; return st * 1024 + (ob ^ (((ob >> 9) & 1) << 5)); }
__host__ __device__ __forceinline__ void stage_rc(int b, int& R, int& C) { const int st = b / 1024, sb = b % 1024, swz = sb ^ (((sb >> 9) & 1) << 5); R = (st >> 1) * 16 + swz / 64; C = (st & 1) * 32 + (swz % 64) / 2; }
__host__ __device__ __forceinline__ int perm32(int rho) { const int n = rho >> 4, i = rho & 15; return 8 * (i >> 2) + 4 * n + (i & 3); }

struct Unit { int pm, pn, acol, kofs, nt, kind; };

constexpr int GRID = 256;
template <int NM, int NN, int KT, int ROWMODE, int GATES, bool SPLIT> struct Sched {
    static constexpr int nM = NM, nN = NN, nwg = NM * NN, G = GRID, R = nwg / G, T = nwg - R * G;
    static constexpr int F0 = (!SPLIT || T == 0 || R == 0) ? 1 : (G / T >= 8 ? 8 : G / T >= 4 ? 4 : G / T >= 2 ? 2 : 1);
    static constexpr int F = (KT / F0 >= 4) ? F0 : (KT / (F0 / 2 > 0 ? F0 / 2 : 1) >= 4 ? (F0 / 2 > 0 ? F0 / 2 : 1) : 1);
    int c, v;
    __device__ void init(int c_, int v_) { c = c_; v = v_; }
    __device__ bool is_slice(int i) const { return F > 1 && i == R; }
    __device__ bool next(int i, Unit& u) const {
        long L; u.kofs = 0; u.nt = KT;
        if (i < R) L = (long)i * G + c;
        else if (i == R && T > 0) { if (F == 1) { L = (long)R * G + c; if (L >= nwg) return false; } else { if (v >= T * F) return false; const int tt = v / F, sj = v - tt * F; u.nt = KT / F; u.kofs = sj * u.nt * BK; L = (long)R * G + tt; } }
        else return false;
        int wgid = (int)L; { const int q = nwg / NXCD, r = nwg % NXCD, xcd = wgid % NXCD, off = wgid / NXCD; wgid = (xcd < r ? xcd * (q + 1) : r * (q + 1) + (xcd - r) * q) + off; }
        const int nig = WGM * nN, gid = wgid / nig, fm = gid * WGM, gsz = (nM - fm) < WGM ? (nM - fm) : WGM;
        int pm = fm + ((wgid % nig) % gsz); u.pn = (wgid % nig) / gsz;
        if (ROWMODE == 1) pm = 9 * (pm >> 3) + 1 + (pm & 7);
        u.pm = pm; u.acol = GATES ? 256 * (u.pn >> 2) : 0; return true;
    }
};

template <int NN, int KT, int CLO, int CHI> struct SchedM {
    static constexpr int G = GRID, NLAT = 32 * NN, NCX = 4 * (CHI - CLO), TOT = 32 + NLAT + NCX, R = TOT / G, T = TOT - R * G, F = 1;
    int c;
    __device__ void init(int c_, int) { c = c_; }
    __device__ bool is_slice(int) const { return false; }
    __device__ bool next(int i, Unit& u) const {
        const int L = i * G + c; if (L >= TOT) return false; u.kofs = 0; u.nt = KT; u.acol = 0;
        if (L < 32) { u.kind = 0; u.pm = 9 * (L >> 3); u.pn = L & 7; return true; }
        if (L < 32 + NLAT) { u.kind = 1; constexpr int nwg = NLAT; int wgid = L - 32; { constexpr int q = nwg / NXCD; const int xcd = wgid % NXCD, off = wgid / NXCD; wgid = xcd * q + off; }
            constexpr int nig = WGM * NN; const int gid = wgid / nig, fm = gid * WGM; const int pmi = fm + ((wgid % nig) % WGM); u.pn = (wgid % nig) / WGM; u.pm = 9 * (pmi >> 3) + 1 + (pmi & 7); return true; }
        const int r = L - 32 - NLAT; u.kind = 2; u.pm = 9 * (r / (CHI - CLO)); u.pn = CLO + r % (CHI - CLO); return true;
    }
};

__device__ __forceinline__ int opq(int x) { asm volatile("" : "+s"(x)); return x; }
constexpr int RSTD_OFF = 131072;
constexpr int SHWT_OFF = 147456;
constexpr int HSQ_OFF = 139264;
template <int LAYER, int N> struct EpiBf16 {
    unsigned char* ws; CArgsP ap;
    static constexpr int QKT = (LAYER == 1) ? 16 : (LAYER == 2) ? 0 : 10; static constexpr bool RMS = (LAYER != 1);
    template <class SchedT> __device__ __forceinline__ void prep(LAS unsigned char* lds, const SchedT& S, int tid) const {
        const float* ssq = (const float*)(ws + WS_SSQ); Unit u;
        for (int i = 0; i < 8 && S.next(i, u); ++i) if (tid < 256) { const f32x4* p4 = (const f32x4*)(ssq + (size_t)(u.pm * BM + tid) * 32); float s = 0.f;
#pragma unroll
            for (int j = 0; j < 8; ++j) { const f32x4 v = p4[j]; s += (v.x + v.y) + (v.z + v.w); }
            ((LAS float*)(lds + opq(RSTD_OFF)))[i * 256 + tid] = frsq(s * (1.0f / DM) + EPS); }
        else { const int t2 = tid - 256; const int bq = u.pm / 9, mr = (u.pm - 9 * bq) == 0 ? 4 : bq; float sv;
            if constexpr (LAYER <= 1) sv = ((const float*)(ws + WS_SHW))[(size_t)(LAYER * 5 + mr) * 8192 + u.pn * BM + t2];
            else { const float* pp = (const float*)(ws + WS_SHWP) + (size_t)(LAYER - 1) * 32 * 5 * 8192 + (size_t)mr * 8192 + u.pn * BM + t2; sv = 0.f;
                float pv[32];
#pragma unroll
                for (int kb = 0; kb < 32; ++kb) pv[kb] = pp[(size_t)kb * 5 * 8192];
#pragma unroll
                for (int kb = 0; kb < 32; ++kb) sv += pv[kb]; }
            ((LAS float*)(lds + opq(SHWT_OFF)))[i * 256 + t2] = sv; }
    }
    __device__ __forceinline__ void operator()(f32x4 (&acc)[2][2][4][2], const Unit& u, int ui, LAS unsigned char* lds, int wr, int wc, int tl_, unsigned gmask) const {
        unsigned char* w_ = ws; asm volatile("" : "+v"(tl_), "+s"(w_)); const int lane = tl_ & 63, fr = lane & 15, fq = lane >> 4;
        const int bq = u.pm / 9, pr_ = u.pm - 9 * bq, isctx = pr_ == 0;
        bf16_t* O = (bf16_t*)(w_ + WS_U);
        const int rl0 = wr * 64 + fr, row0 = u.pm * BM + rl0, col0 = u.pn * BM + wc * 32 + 8 * fq;
        const LAS float* rt = (const LAS float*)(lds + opq(RSTD_OFF)) + ui * 256 + rl0;
        f32x4 sv[2][2];
#pragma unroll
        for (int bj = 0; bj < 2; ++bj)
#pragma unroll
            for (int n = 0; n < 2; ++n) sv[bj][n] = *(const LAS f32x4*)((const LAS float*)(lds + opq(SHWT_OFF)) + ui * 256 + wc * 32 + 8 * fq + bj * HALF + 4 * n);
        if (QKT == 0 || u.pn >= QKT) {
#pragma unroll
            for (int ai = 0; ai < 2; ++ai)
#pragma unroll
                for (int m = 0; m < 4; ++m) { if (!((gmask >> (ai * 4 + m)) & 1u)) continue; bf16_t* rowp = O + (size_t)(row0 + ai * HALF + m * 16) * N + col0; const float rs = rt[ai * HALF + m * 16];
#pragma unroll
                    for (int bj = 0; bj < 2; ++bj) { const f32x4 v0 = acc[ai][bj][m][0] * rs + sv[bj][0], v1 = acc[ai][bj][m][1] * rs + sv[bj][1];
                        u32x4 w; w.x = cvt_pk_bf16(v0[0], v0[1]); w.y = cvt_pk_bf16(v0[2], v0[3]); w.z = cvt_pk_bf16(v1[0], v1[1]); w.w = cvt_pk_bf16(v1[2], v1[3]);
                        *(u32x4*)(rowp + bj * HALF) = w; } }
            return;
        }
        LAS float* hs = (LAS float*)(lds + opq(HSQ_OFF));
        if constexpr (RMS) {
#pragma unroll
            for (int ai = 0; ai < 2; ++ai)
#pragma unroll
                for (int m = 0; m < 4; ++m) { const int rl = rl0 + ai * HALF + m * 16; const float rs = rt[ai * HALF + m * 16];
#pragma unroll
                    for (int bj = 0; bj < 2; ++bj) { const f32x4 v0 = acc[ai][bj][m][0] * rs + sv[bj][0], v1 = acc[ai][bj][m][1] * rs + sv[bj][1];
                        float q = ((v0[0] * v0[0] + v0[1] * v0[1]) + (v0[2] * v0[2] + v0[3] * v0[3])) + ((v1[0] * v1[0] + v1[1] * v1[1]) + (v1[2] * v1[2] + v1[3] * v1[3]));
                        q += shx<16>(q); { auto rr = __builtin_amdgcn_permlane32_swap(__float_as_uint(q), __float_as_uint(q), false, false); q = __uint_as_float(rr[0]) + __uint_as_float(rr[1]); }
                        if (fq == 0) hs[rl * 8 + bj * 4 + wc] = q; } }
            asm volatile("s_waitcnt lgkmcnt(0)" ::: "memory"); __builtin_amdgcn_s_barrier(); asm volatile("" ::: "memory");
        }
        const int i16 = 4 * (wc & 1) + fq, hf = wc >> 1;
        f32x4 g0 = {1.f, 1.f, 1.f, 1.f}, g1 = g0;
        if constexpr (RMS) { const float* gg = ((u.pn < 8) ? ap->in[I_AQG] : ap->in[I_AKG]) + (LAYER == 3 ? 128 : 0) + 64 * hf + 4 * i16; g0 = *(const f32x4*)gg; g1 = *(const f32x4*)(gg + 32); }
        const float* tc = (const float*)(w_ + WS_TAB) + 4 * i16; const float* ts = tc + 96 * 32;
#pragma unroll
        for (int ai = 0; ai < 2; ++ai)
#pragma unroll
            for (int m = 0; m < 4; ++m) { if (!((gmask >> (ai * 4 + m)) & 1u)) continue; const int rl = rl0 + ai * HALF + m * 16; const float rs = rt[ai * HALF + m * 16];
                bf16_t* rowp = O + (size_t)(u.pm * BM + rl) * N + col0;
                f32x4 cs = {1.f, 1.f, 1.f, 1.f}, sn = {0.f, 0.f, 0.f, 0.f};
                if (!isctx) { const int tl = (pr_ - 1) * 256 + rl; const int pos = hf ? 32 + (tl & 63) : (tl >> 6); cs = *(const f32x4*)(tc + pos * 32); sn = *(const f32x4*)(ts + pos * 32); }
#pragma unroll
                for (int bj = 0; bj < 2; ++bj) { f32x4 x1 = acc[ai][bj][m][0] * rs + sv[bj][0], x2 = acc[ai][bj][m][1] * rs + sv[bj][1];
                    if constexpr (RMS) { const f32x4 pq = *(const LAS f32x4*)(hs + rl * 8 + bj * 4); const float rh = frsq(((pq[0] + pq[1]) + (pq[2] + pq[3])) * (1.0f / 128.0f) + EPS); x1 = x1 * rh * g0; x2 = x2 * rh * g1; }
                    const f32x4 y1 = x1 * cs - x2 * sn, y2 = x1 * sn + x2 * cs;
                    u32x4 w; w.x = cvt_pk_bf16(y1[0], y1[1]); w.y = cvt_pk_bf16(y1[2], y1[3]); w.z = cvt_pk_bf16(y2[0], y2[1]); w.w = cvt_pk_bf16(y2[2], y2[3]);
                    *(u32x4*)(rowp + bj * HALF) = w; } }
    }
};
template <int LAYER, bool DUP> struct EpiResid {
    unsigned char* ws; CArgsP ap;
    static constexpr bool NEXT = LAYER < 3;
    template <class SchedT> __device__ __forceinline__ void prep(LAS unsigned char*, const SchedT&, int) const {}
    __device__ __forceinline__ void operator()(f32x4 (&acc)[2][2][4][2], const Unit& u, int, LAS unsigned char* lds, int wr, int wc, int tl_, unsigned gmask) const {
        unsigned char* w_ = ws; asm volatile("" : "+v"(tl_), "+s"(w_)); const int lane = tl_ & 63, fr = lane & 15, fq = lane >> 4;
        const int bq = u.pm / 9, pr_ = u.pm - 9 * bq, isctx = pr_ == 0, mr = isctx ? 4 : bq;
        if constexpr (LAYER == 3 && !DUP) {
            const float* gt = (const float*)(w_ + WS_MODS) + (size_t)(LAYER * 5 + mr) * 6144 + 4096;
            const bf16_t* xbin = (const bf16_t*)(w_ + WS_X) + (size_t)u.pm * BM * DM;
            const int rl0 = wr * 64 + fr, col0 = u.pn * BM + wc * 32 + 8 * fq, lrow0 = bq * SEQ + (pr_ - 1) * 256;
            float* fsq = (float*)(w_ + WS_FSQ);
            f32x4 gv[2][2];
#pragma unroll
            for (int bj = 0; bj < 2; ++bj)
#pragma unroll
                for (int n = 0; n < 2; ++n) gv[bj][n] = *(const f32x4*)(gt + col0 + bj * HALF + 4 * n);
#pragma unroll
            for (int ai = 0; ai < 2; ++ai)
#pragma unroll
                for (int m = 0; m < 4; ++m) { const int rl = rl0 + ai * HALF + m * 16; const unsigned ro = (unsigned)(rl * DM + col0) * 4u; float sq = 0.f;
#pragma unroll
                    for (int bj = 0; bj < 2; ++bj) { const u32x4 bw = *(const u32x4*)((const char*)xbin + (ro >> 1) + bj * HALF * 2);
                        const f32x4 bs[2] = {(f32x4){bflo(bw.x), bfhi(bw.x), bflo(bw.y), bfhi(bw.y)}, (f32x4){bflo(bw.z), bfhi(bw.z), bflo(bw.w), bfhi(bw.w)}};
#pragma unroll
                        for (int n = 0; n < 2; ++n) { const f32x4 xn = bs[n] + gv[bj][n] * acc[ai][bj][m][n]; acc[ai][bj][m][n] = xn;
                            sq += (xn[0] * xn[0] + xn[1] * xn[1]) + (xn[2] * xn[2] + xn[3] * xn[3]); } }
                    sq += shx<16>(sq); { auto rr = __builtin_amdgcn_permlane32_swap(__float_as_uint(sq), __float_as_uint(sq), false, false); sq = __uint_as_float(rr[0]) + __uint_as_float(rr[1]); }
                    if (fq == 0) __hip_atomic_store(fsq + (size_t)(lrow0 + rl) * 32 + u.pn * 4 + wc, sq, __ATOMIC_RELAXED, __HIP_MEMORY_SCOPE_AGENT);
                    if (m & 1) asm volatile("" ::: "memory"); }
            asm volatile("s_waitcnt vmcnt(0)" ::: "memory"); __builtin_amdgcn_s_barrier(); asm volatile("" ::: "memory");
            const int tid = (wr * 4 + wc) * 64 + lane; const int panel = bq * 8 + pr_ - 1;
            if (tid == 0) { unsigned* cw = (unsigned*)(w_ + WS_CTL) + CW_SEAM + panel * 16;
                __hip_atomic_fetch_add(cw, 1u, __ATOMIC_RELAXED, __HIP_MEMORY_SCOPE_AGENT);
                unsigned sp = 0; while (__hip_atomic_load(cw, __ATOMIC_RELAXED, __HIP_MEMORY_SCOPE_AGENT) < 8u) { __builtin_amdgcn_s_sleep(1); if (++sp > (1u << 22)) break; }
                __builtin_amdgcn_fence(__ATOMIC_ACQUIRE, "agent"); asm volatile("s_waitcnt vmcnt(0)" ::: "memory"); }
            asm volatile("" ::: "memory"); __builtin_amdgcn_s_barrier(); asm volatile("" ::: "memory");
            LAS float* rt = (LAS float*)(lds + opq(HSQ_OFF));
            if (tid < 256) { const f32x4* p4 = (const f32x4*)(fsq + (size_t)(lrow0 + tid) * 32); float sa = 0.f;
#pragma unroll
                for (int j = 0; j < 8; ++j) { const f32x4 v = p4[j]; sa += (v.x + v.y) + (v.z + v.w); }
                rt[tid] = frsq(sa * (1.0f / DM) + EPS); }
            asm volatile("s_waitcnt lgkmcnt(0)" ::: "memory"); __builtin_amdgcn_s_barrier(); asm volatile("" ::: "memory");
            const float* nf = ap->in[I_NORMF] + col0; float* outp = ap->out + (size_t)lrow0 * DM;
#pragma unroll
            for (int bj = 0; bj < 2; ++bj)
#pragma unroll
                for (int n = 0; n < 2; ++n) gv[bj][n] = *(const f32x4*)(nf + bj * HALF + 4 * n);
#pragma unroll
            for (int ai = 0; ai < 2; ++ai)
#pragma unroll
                for (int m = 0; m < 4; ++m) { const int rl = rl0 + ai * HALF + m * 16; const float rs = rt[rl]; const unsigned ro = (unsigned)(rl * DM + col0) * 4u;
#pragma unroll
                    for (int bj = 0; bj < 2; ++bj)
#pragma unroll
                        for (int n = 0; n < 2; ++n) *(f32x4*)((char*)outp + ro + (bj * HALF + 4 * n) * 4) = acc[ai][bj][m][n] * rs * gv[bj][n]; }
            return;
        }
        const float* gt = (const float*)(w_ + WS_MODS) + (size_t)(LAYER * 5 + mr) * 6144 + 4096;
        const float* gmN = (const float*)(w_ + WS_GM) + (size_t)((LAYER + 1) * 5 + mr) * DM;
        const float* basep = (LAYER == 0) ? (isctx ? ap->in[I_CTX] + (size_t)(bq * CTXL) * DM : ap->in[I_X] + (size_t)(bq * SEQ + (pr_ - 1) * 256) * DM) : nullptr;
        const bf16_t* xbin = (const bf16_t*)(w_ + WS_X) + (size_t)u.pm * BM * DM;
        bf16_t* outp = (bf16_t*)(w_ + (DUP ? WS_DUMMY : WS_X)) + (size_t)u.pm * BM * DM; bf16_t* hp = (bf16_t*)(w_ + (DUP ? WS_DUMMY + 72 * MiB : WS_H)) + (size_t)u.pm * BM * DM;
        float* ssq = (float*)(w_ + (DUP ? WS_DUMMY + 108 * MiB : WS_SSQ));
        const int rl0 = wr * 64 + fr, col0 = u.pn * BM + wc * 32 + 8 * fq;
        f32x4 gv[2][2], mv[2][2];
#pragma unroll
        for (int bj = 0; bj < 2; ++bj)
#pragma unroll
            for (int n = 0; n < 2; ++n) { gv[bj][n] = *(const f32x4*)(gt + col0 + bj * HALF + 4 * n); if (NEXT) mv[bj][n] = *(const f32x4*)(gmN + col0 + bj * HALF + 4 * n); }
#pragma unroll
        for (int ai = 0; ai < 2; ++ai)
#pragma unroll
            for (int m = 0; m < 4; ++m) { if (!((gmask >> (ai * 4 + m)) & 1u)) continue; const int rl = rl0 + ai * HALF + m * 16; const unsigned ro = (unsigned)(rl * DM + col0) * 4u; float sq = 0.f;
#pragma unroll
                for (int bj = 0; bj < 2; ++bj) { f32x4 xn[2], bs[2];
                    if constexpr (LAYER == 0) { bs[0] = *(const f32x4*)((const char*)basep + ro + bj * HALF * 4); bs[1] = *(const f32x4*)((const char*)basep + ro + bj * HALF * 4 + 16); }
                    else { const u32x4 bw = *(const u32x4*)((const char*)xbin + (ro >> 1) + bj * HALF * 2); bs[0] = (f32x4){bflo(bw.x), bfhi(bw.x), bflo(bw.y), bfhi(bw.y)}; bs[1] = (f32x4){bflo(bw.z), bfhi(bw.z), bflo(bw.w), bfhi(bw.w)}; }
#pragma unroll
                    for (int n = 0; n < 2; ++n) { xn[n] = bs[n] + gv[bj][n] * acc[ai][bj][m][n];
                        if (NEXT) sq += (xn[n][0] * xn[n][0] + xn[n][1] * xn[n][1]) + (xn[n][2] * xn[n][2] + xn[n][3] * xn[n][3]); }
                    { u32x4 xw; xw.x = cvt_pk_bf16(xn[0][0], xn[0][1]); xw.y = cvt_pk_bf16(xn[0][2], xn[0][3]); xw.z = cvt_pk_bf16(xn[1][0], xn[1][1]); xw.w = cvt_pk_bf16(xn[1][2], xn[1][3]);
                        *(u32x4*)((char*)outp + (ro >> 1) + bj * HALF * 2) = xw; }
                    if (NEXT) { const f32x4 h0 = xn[0] * mv[bj][0], h1 = xn[1] * mv[bj][1]; u32x4 w; w.x = cvt_pk_bf16(h0[0], h0[1]); w.y = cvt_pk_bf16(h0[2], h0[3]); w.z = cvt_pk_bf16(h1[0], h1[1]); w.w = cvt_pk_bf16(h1[2], h1[3]);
                        *(u32x4*)((char*)hp + (ro >> 1) + bj * HALF * 2) = w; } }
                if (NEXT) { sq += shx<16>(sq); { auto rr = __builtin_amdgcn_permlane32_swap(__float_as_uint(sq), __float_as_uint(sq), false, false); sq = __uint_as_float(rr[0]) + __uint_as_float(rr[1]); }
                    if (fq == 0) ssq[(size_t)(u.pm * BM + rl) * 32 + u.pn * 4 + wc] = sq; }
                if (m & 1) asm volatile("" ::: "memory"); }
    }
};
template <int CTRL> __device__ __forceinline__ float dpp_f(float oldv, float src) { return __int_as_float(__builtin_amdgcn_update_dpp(__float_as_int(oldv), __float_as_int(src), CTRL, 0xf, 0xf, false)); }
struct EpiGates {
    unsigned char* ws; CArgsP ap;
    template <class SchedT> __device__ __forceinline__ void prep(LAS unsigned char*, const SchedT&, int) const {}
    __device__ __forceinline__ void operator()(f32x4 (&acc)[2][2][4][2], const Unit& u, int, LAS unsigned char*, int wr, int wc, int tl_, unsigned gmask) const {
        unsigned char* w_ = ws; asm volatile("" : "+v"(tl_), "+s"(w_)); const int lane = tl_ & 63, fr = lane & 15, fq = lane >> 4;
        const bf16_t* UP = (const bf16_t*)(w_ + WS_UP); const float* ba = ap->in[I_RBA]; const float* bx = ap->in[I_RBX]; const float* c8 = (const float*)(w_ + WS_TAB + 65536);
        unsigned* AB = (unsigned*)(w_ + WS_SA); float* AGA = (float*)(w_ + WS_AG16); float* AGB = AGA + (size_t)576 * 2 * DM;
        const int nblk = u.pn >> 2, dir = (u.pn >> 1) & 1, jt = u.pn & 1;
        const int row0 = u.pm * BM + wr * 64 + fr, chb = nblk * 256 + jt * 128 + 16 * wc + 4 * fq;
#pragma unroll
        for (int bj = 0; bj < 2; ++bj) { const int ch = chb + 64 * bj;
            const f32x4 bav = *(const f32x4*)(ba + dir * DM + ch), bxv = *(const f32x4*)(bx + dir * DM + ch), cv = *(const f32x4*)(c8 + dir * DM + ch);
#pragma unroll
            for (int ai = 0; ai < 2; ++ai)
#pragma unroll
                for (int m = 0; m < 4; ++m) { if (!((gmask >> (ai * 4 + m)) & 1u)) continue; const int row = row0 + ai * HALF + m * 16;
                    const u32x2 upw = *(const u32x2*)((const char*)UP + (unsigned)(row * DM + ch) * 2u);
                    const float up[4] = {bflo(upw.x), bfhi(upw.x), bflo(upw.y), bfhi(upw.y)};
                    const f32x4 pr = acc[ai][bj][m][0] + bav, pi = acc[ai][bj][m][1] + bxv; u32x4 w; f32x4 A, Bv;
#pragma unroll
                    for (int j = 0; j < 4; ++j) { const float r = sigmoidf_(pr[j]), ig = sigmoidf_(pi[j]); const float la = -r * cv[j]; const float a = __expf(la);
                        const float om = fmaf(-a, a, 1.0f);
                        w[j] = cvt_pk_bf16(la, fsqrt_(om) * (ig * up[j]));
                        A[j] = __expf(bflo(w[j])); Bv[j] = bfhi(w[j]); }
                    *(u32x4*)((char*)AB + (unsigned)((row * 2 + dir) * DM + ch) * 4u) = w;
#define GSTEP(CT) _Pragma("unroll") for (int j = 0; j < 4; ++j) { const float ap = dpp_f<CT>(1.0f, A[j]), bp = dpp_f<CT>(0.0f, Bv[j]); Bv[j] = fmaf(A[j], bp, Bv[j]); A[j] = A[j] * ap; }
                    if (dir == 0) { GSTEP(0x111) GSTEP(0x112) GSTEP(0x114) GSTEP(0x118) } else { GSTEP(0x101) GSTEP(0x102) GSTEP(0x104) GSTEP(0x108) }
#undef GSTEP
                    if (fr == (dir ? 0 : 15)) { const unsigned ao = (unsigned)((((u.pm * 16 + ai * 8 + wr * 4 + m) * 2 + dir) * DM + ch) * 4u); *(f32x4*)((char*)AGA + ao) = A; *(f32x4*)((char*)AGB + ao) = Bv; }
                    asm volatile("" ::: "memory"); __builtin_amdgcn_sched_barrier(0); } }
    }
};

struct NoEpi { unsigned char* ws; template <class SchedT> __device__ __forceinline__ void prep(LAS unsigned char*, const SchedT&, int) const {}
    __device__ __forceinline__ void operator()(f32x4 (&)[2][2][4][2], const Unit&, int, LAS unsigned char*, int, int, int, unsigned) const {} };
template <class Epi, class SchedT, int KT, int BANK, size_t OA, size_t OB, class Epi0 = NoEpi, size_t OA0 = 0, size_t OB0 = 0>
__device__ __forceinline__ void gemm_phase(LAS unsigned char* lds, const int tid, const SchedT& S, const Epi& E, const Epi0& E0 = Epi0{}) {
    constexpr bool MERGED = !__is_same(Epi0, NoEpi);
    constexpr bool SP2 = true, ALIGN_EPI = true;
    const int wid = __builtin_amdgcn_readfirstlane(tid >> 6), lane = tid & 63, wr = wid >> 2, wc = wid & 3, fr = lane & 15, fq = lane >> 4;
    constexpr int K = KT * BK, lda = DM;
    unsigned voffA[2], voffB[2];
#pragma unroll
    for (int i = 0; i < 2; ++i) { int R, C; stage_rc(tid * 16 + i * 8192, R, C); const int Rb = (R & ~31) + perm32(R & 31);
        voffA[i] = (unsigned)(R * lda + C) * 2u; voffB[i] = (unsigned)(Rb * K + C) * 2u; }
    constexpr unsigned kstep = (unsigned)(BK * 2);
    constexpr unsigned hstepA = (unsigned)HALF * lda * 2, hstepB = (unsigned)HALF * K * 2;
    constexpr unsigned tstepA = 2 * hstepA, tstepB = 2 * hstepB;
    const unsigned ldsw = (unsigned)wid * 1024u;
    const int aoff = lds_byte(wr * 64 + fr, fq * 8), boff = lds_byte(wc * 32 + fr, fq * 8);
#define PG8_SA(b, h) (((b) * 2 + (h)) * HTB)
#define PG8_SB(b, h) ((4 + (b) * 2 + (h)) * HTB)
#define PG8_STAGE(bufoff, goff, voff) do { _Pragma("unroll") for (int _i = 0; _i < 2; ++_i) \
        __builtin_amdgcn_global_load_lds((const unsigned*)((const char*)E.ws + (unsigned)((goff) + (voff)[_i])), (LAS unsigned*)(lds + (bufoff) + ldsw + _i * 8192), 16, 0, 0); } while (0)
#define PG8_LDA(dst, b, h) do { _Pragma("unroll") for (int m = 0; m < 4; ++m) _Pragma("unroll") for (int k = 0; k < 2; ++k) dst[m][k] = *(const LAS bf16x8*)(lds + PG8_SA(b, h) + aoff + m * 2048 + k * 1024); } while (0)
#define PG8_LDB(dst, b, h) do { _Pragma("unroll") for (int n = 0; n < 2; ++n) _Pragma("unroll") for (int k = 0; k < 2; ++k) dst[n][k] = *(const LAS bf16x8*)(lds + PG8_SB(b, h) + boff + n * 2048 + k * 1024); } while (0)
#define PG8_MMA(ai, bj, At, Bt) do { __builtin_amdgcn_s_setprio(1); _Pragma("unroll") for (int m = 0; m < 4; ++m) _Pragma("unroll") for (int n = 0; n < 2; ++n) _Pragma("unroll") for (int k = 0; k < 2; ++k) \
        acc[ai][bj][m][n] = __builtin_amdgcn_mfma_f32_16x16x32_bf16(Bt[n][k], At[m][k], acc[ai][bj][m][n], 0, 0, 0); __builtin_amdgcn_s_setprio(0); } while (0)
#define PG8_WAIT_V(n) asm volatile("s_waitcnt vmcnt(" #n ")" ::: "memory")
#define PG8_WAIT_L(n) asm volatile("s_waitcnt lgkmcnt(" #n ")" ::: "memory")
#define PG8_BAR __builtin_amdgcn_s_barrier()
#define PG8_SCHED __builtin_amdgcn_sched_barrier(0)
    Unit cur, nxt; int ui = 0;
    if (!S.next(0, cur)) return;
    E.prep(lds, S, tid); __syncthreads();
    f32x4 acc[2][2][4][2];
#pragma unroll
    for (int a = 0; a < 2; ++a)
#pragma unroll
        for (int b = 0; b < 2; ++b)
#pragma unroll
            for (int m = 0; m < 4; ++m)
#pragma unroll
                for (int n = 0; n < 2; ++n) acc[a][b][m][n] = (f32x4){0.f, 0.f, 0.f, 0.f};
    bf16x8 At[4][2], B0[2][2], B1[2][2];
#define PG8_UA(u) ((unsigned)((MERGED && (u).kind == 0) ? OA0 : OA) + (unsigned)(u).pm * tstepA + (unsigned)((u).acol + (u).kofs) * 2u)
#define PG8_UB(u) ((unsigned)((MERGED && (u).kind == 0) ? OB0 : OB) + (unsigned)(u).pn * tstepB + (unsigned)(u).kofs * 2u)
    unsigned cA = PG8_UA(cur), cB = PG8_UB(cur);
    {
        PG8_STAGE(PG8_SB(0, 0), cB, voffB); PG8_STAGE(PG8_SB(0, 1), cB + hstepB, voffB); PG8_STAGE(PG8_SA(0, 0), cA, voffA); PG8_STAGE(PG8_SA(0, 1), cA + hstepA, voffA);
        if (wr == 1) PG8_BAR;
        PG8_WAIT_V(2); PG8_BAR;
        PG8_STAGE(PG8_SB(1, 0), cB + kstep, voffB); PG8_STAGE(PG8_SA(1, 0), cA + kstep, voffA); PG8_STAGE(PG8_SB(1, 1), cB + hstepB + kstep, voffB);
        PG8_WAIT_V(6); PG8_BAR;
    }
    for (;;) {
        const bool has_next = S.next(ui + 1, nxt);
        const unsigned nA = has_next ? PG8_UA(nxt) : cA, nB = has_next ? PG8_UB(nxt) : cB;
        const int nt = cur.nt;
        for (int t = 0; t < nt; t += 2) {
            const bool last = (t == nt - 2);
            if constexpr (MERGED) if (last && has_next && nxt.kind == 2) {
                unsigned char* w0_ = E.ws; asm volatile("" : "+s"(w0_));
                if (wid == 0) { unsigned* cw = (unsigned*)(w0_ + WS_CTL) + CW_SEAM + 1024 + BANK * 64 + (nxt.pm / 9) * 16; unsigned sp_ = 0;
                    while ((unsigned)__builtin_amdgcn_readfirstlane((int)__hip_atomic_load(cw, __ATOMIC_RELAXED, __HIP_MEMORY_SCOPE_AGENT)) < 8u) { __builtin_amdgcn_s_sleep(2); if (++sp_ > (1u << 22)) break; }
                    __builtin_amdgcn_fence(__ATOMIC_ACQUIRE, "agent"); asm volatile("s_waitcnt vmcnt(0)" ::: "memory"); }
                asm volatile("" ::: "memory"); PG8_BAR; asm volatile("" ::: "memory");
                if (tid < 256) { const f32x4* p4 = (const f32x4*)((const float*)(w0_ + WS_SSQ) + (size_t)(nxt.pm * BM + tid) * 32); float s_ = 0.f;
#pragma unroll
                    for (int j = 0; j < 8; ++j) { const f32x4 v_ = p4[j]; s_ += (v_.x + v_.y) + (v_.z + v_.w); }
                    ((LAS float*)(lds + opq(RSTD_OFF)))[(ui + 1) * 256 + tid] = frsq(s_ * (1.0f / DM) + EPS); }
            }
            const unsigned a1 = cA + (unsigned)(t + 1) * kstep;
            const unsigned a2 = last ? nA : cA + (unsigned)(t + 2) * kstep, b2 = last ? nB : cB + (unsigned)(t + 2) * kstep;
            const unsigned a3 = a2 + kstep, b3 = b2 + kstep;
            PG8_LDB(B0, 0, 0); PG8_LDB(B1, 0, 1); PG8_SCHED; PG8_LDA(At, 0, 0); PG8_STAGE(PG8_SA(1, 1), a1 + hstepA, voffA);
            PG8_WAIT_V(8); PG8_WAIT_L(0); PG8_BAR; PG8_MMA(0, 0, At, B0); PG8_MMA(0, 1, At, B1); PG8_BAR; PG8_SCHED;
            PG8_LDA(At, 0, 1); PG8_STAGE(PG8_SB(0, 0), b2, voffB); PG8_STAGE(PG8_SB(0, 1), b2 + hstepB, voffB); PG8_STAGE(PG8_SA(0, 0), a2, voffA);
            PG8_WAIT_V(8); PG8_WAIT_L(0); PG8_BAR; PG8_MMA(1, 0, At, B0); PG8_MMA(1, 1, At, B1); PG8_BAR; PG8_SCHED;
            PG8_LDB(B0, 1, 0); PG8_LDB(B1, 1, 1); PG8_SCHED; PG8_LDA(At, 1, 0); PG8_STAGE(PG8_SA(0, 1), a2 + hstepA, voffA);
            PG8_WAIT_V(8); PG8_WAIT_L(0); PG8_BAR; PG8_MMA(0, 0, At, B0); PG8_MMA(0, 1, At, B1); PG8_BAR; PG8_SCHED;
            PG8_LDA(At, 1, 1); PG8_STAGE(PG8_SB(1, 0), b3, voffB); PG8_STAGE(PG8_SB(1, 1), b3 + hstepB, voffB); PG8_STAGE(PG8_SA(1, 0), a3, voffA);
            PG8_WAIT_V(8); PG8_WAIT_L(0); PG8_BAR; PG8_MMA(1, 0, At, B0); PG8_MMA(1, 1, At, B1); PG8_BAR; PG8_SCHED;
        }
        if constexpr (ALIGN_EPI) { if (wr == 0) PG8_BAR; }
        if (MERGED && cur.kind == 0) {
            E0(acc, cur, ui, lds, wr, wc, tid, 0xffu);
            asm volatile("s_waitcnt vmcnt(0)" ::: "memory"); PG8_BAR; asm volatile("" ::: "memory");
            if (tid == 0) { unsigned char* w0_ = E.ws; asm volatile("" : "+s"(w0_)); unsigned* cw = (unsigned*)(w0_ + WS_CTL) + CW_SEAM + 1024 + BANK * 64 + (cur.pm / 9) * 16;
                __builtin_amdgcn_fence(__ATOMIC_RELEASE, "agent"); asm volatile("s_waitcnt vmcnt(0)" ::: "memory");
                __hip_atomic_fetch_add(cw, 1u, __ATOMIC_RELAXED, __HIP_MEMORY_SCOPE_AGENT); }
        } else
        if (!S.is_slice(ui)) E(acc, cur, ui, lds, wr, wc, tid, 0xffu);
        if (!has_next) break;
#pragma unroll
        for (int a = 0; a < 2; ++a)
#pragma unroll
            for (int b = 0; b < 2; ++b)
#pragma unroll
                for (int m = 0; m < 4; ++m)
#pragma unroll
                    for (int n = 0; n < 2; ++n) acc[a][b][m][n] = (f32x4){0.f, 0.f, 0.f, 0.f};
        cur = nxt; cA = nA; cB = nB; ++ui;
        if constexpr (ALIGN_EPI) { if (wr == 1) PG8_BAR; }
    }
    PG8_WAIT_V(0);
    if constexpr (!ALIGN_EPI) { if (wr == 0) PG8_BAR; }
    PG8_BAR;
    if constexpr (SchedT::F > 1) if (S.is_slice(ui)) {
        unsigned char* w_ = E.ws; asm volatile("" : "+s"(w_)); float* slab = (float*)(w_ + WS_SLAB); unsigned* cnt = (unsigned*)(w_ + WS_CTL) + CW_SEAM + BANK * 4096;
        constexpr int F = SchedT::F; const int tt = S.v / F, sj = S.v - tt * F; float* my = slab + ((size_t)(tt * F + sj) * 32) * 2048;
#pragma unroll
        for (int a = 0; a < 2; ++a)
#pragma unroll
            for (int b = 0; b < 2; ++b)
#pragma unroll
                for (int m = 0; m < 4; ++m)
#pragma unroll
                    for (int n = 0; n < 2; ++n) { float* sp_ = my + (size_t)((((a * 2 + b) * 4 + m) * 2 + n) * 512 + tid) * 4;
                        asm volatile("global_store_dwordx4 %0, %1, off sc1\n\ts_nop 1" :: "v"(sp_), "v"(acc[a][b][m][n]) : "memory"); }
        asm volatile("s_waitcnt vmcnt(0)" ::: "memory"); __syncthreads();
        if (tid == 0) { unsigned* cw = cnt + tt * 16;
            __hip_atomic_fetch_add(cw, 1u, __ATOMIC_RELAXED, __HIP_MEMORY_SCOPE_AGENT);
            unsigned sp = 0; while (__hip_atomic_load(cw, __ATOMIC_RELAXED, __HIP_MEMORY_SCOPE_AGENT) < (unsigned)F) { __builtin_amdgcn_s_sleep(1); if (++sp > (1u << 22)) break; }
            __builtin_amdgcn_fence(__ATOMIC_ACQUIRE, "agent"); asm volatile("s_waitcnt vmcnt(0)" ::: "memory"); }
        __syncthreads();
        constexpr int per = 8 / F; const unsigned gmask = ((1u << per) - 1u) << (sj * per);
        const float* t0 = slab + ((size_t)(tt * F) * 32) * 2048;
#pragma unroll
        for (int a = 0; a < 2; ++a)
#pragma unroll
            for (int m = 0; m < 4; ++m) if ((gmask >> (a * 4 + m)) & 1u) {
#pragma unroll
                for (int b = 0; b < 2; ++b)
#pragma unroll
                    for (int n = 0; n < 2; ++n) { const float* fp = t0 + (size_t)((((a * 2 + b) * 4 + m) * 2 + n) * 512 + tid) * 4; f32x4 sm = *(const f32x4*)fp;
#pragma unroll
                        for (int sl = 1; sl < F; ++sl) sm += *(const f32x4*)(fp + (size_t)sl * 32 * 2048);
                        acc[a][b][m][n] = sm; } }
        E(acc, cur, ui, lds, wr, wc, tid, gmask);
        asm volatile("s_waitcnt vmcnt(0)" ::: "memory"); __syncthreads();
    }
#undef PG8_UA
#undef PG8_UB
#undef PG8_SA
#undef PG8_SB
#undef PG8_STAGE
#undef PG8_LDA
#undef PG8_LDB
#undef PG8_MMA
#undef PG8_WAIT_V
#undef PG8_WAIT_L
#undef PG8_BAR
#undef PG8_SCHED
}
}

namespace att {
constexpr int D = 128, NW = 8, QBLK = 32, KVBLK = 64;
constexpr float SCALE = 0.088388347648318440f;
constexpr float THR = 8.f;
constexpr int SHM_V = KVBLK * D * 2, SHM_K = KVBLK * D * 2, SHM_ATTN = 3 * SHM_V + 3 * SHM_K + NW * 64 * 4;
#define KSWZ(row, colB) ((row) * 256 + ((colB) ^ (((row) & 7) << 4)))
#define SBAR() __builtin_amdgcn_sched_barrier(0)
__device__ __forceinline__ int crow(int r, int hi) { return (r & 3) + 8 * (r >> 2) + 4 * hi; }
__device__ __forceinline__ unsigned cvtpk(float lo, float hi) { unsigned r; asm volatile("v_cvt_pk_bf16_f32 %0, %1, %2" : "=v"(r) : "v"(lo), "v"(hi)); return r; }
__device__ __forceinline__ bf16x8 ld8(const bf16_t* p) { return *reinterpret_cast<const bf16x8*>(p); }

__device__ __forceinline__ void partialSM(f32x16& p0, f32x16& p1, float& m_reg, float& mn, float& alpha) {
  constexpr float C = SCALE * 1.4426950408889634f;
  float pmax = p0[0]; for (int r = 1; r < 16; ++r) pmax = fmaxf(pmax, p0[r]); for (int r = 0; r < 16; ++r) pmax = fmaxf(pmax, p1[r]);
  { auto rr = __builtin_amdgcn_permlane32_swap(__float_as_uint(pmax), __float_as_uint(pmax), false, false);
    pmax = fmaxf(__uint_as_float(rr[0]), __uint_as_float(rr[1])); }
  if (__builtin_expect(__all(pmax - m_reg <= THR / SCALE), 1)) { mn = m_reg; alpha = 1.f; }
  else { mn = fmaxf(m_reg, pmax); alpha = __builtin_amdgcn_exp2f((m_reg - mn) * C); m_reg = mn; }
  float mnC = -mn * C;
  for (int r = 0; r < 16; ++r) p0[r] = fmaf(p0[r], C, mnC); for (int r = 0; r < 16; ++r) p1[r] = fmaf(p1[r], C, mnC);
  for (int r = 0; r < 16; ++r) p0[r] = __builtin_amdgcn_exp2f(p0[r]);
}
__device__ __forceinline__ void finishSM(f32x16& p0, f32x16& p1, float alpha, float& l_reg, bf16x8& pa0, bf16x8& pa1, bf16x8& pa2, bf16x8& pa3) {
  for (int r = 0; r < 16; ++r) p1[r] = __builtin_amdgcn_exp2f(p1[r]);
  float ps = 0; for (int r = 0; r < 16; ++r) ps += p0[r]; for (int r = 0; r < 16; ++r) ps += p1[r];
  { auto rr = __builtin_amdgcn_permlane32_swap(__float_as_uint(ps), __float_as_uint(ps), false, false);
    ps = __uint_as_float(rr[0]) + __uint_as_float(rr[1]); }
  l_reg = l_reg * alpha + ps;
#define PK4(P, BASE, OUT) do { unsigned a0 = cvtpk(P[BASE + 0], P[BASE + 1]), a1 = cvtpk(P[BASE + 2], P[BASE + 3]);   \
    unsigned b0 = cvtpk(P[BASE + 4], P[BASE + 5]), b1 = cvtpk(P[BASE + 6], P[BASE + 7]);                              \
    auto r0 = __builtin_amdgcn_permlane32_swap(a0, b0, false, false); auto r1 = __builtin_amdgcn_permlane32_swap(a1, b1, false, false); \
    u32x4 w = {r0[0], r1[0], r0[1], r1[1]}; OUT = *reinterpret_cast<bf16x8*>(&w); } while (0)
  PK4(p0, 0, pa0); PK4(p0, 8, pa1); PK4(p1, 0, pa2); PK4(p1, 8, pa3);
#undef PK4
}
__device__ __forceinline__ void qkt(f32x16& p0, f32x16& p1, const bf16_t* Ks, const bf16x8* qr, int r32, int hi) {
  p0 = f32x16{}; p1 = f32x16{};
  for (int d0 = 0; d0 < 8; ++d0) { int cb = (d0 * 16 + hi * 8) * 2;
    bf16x8 b0 = *reinterpret_cast<const bf16x8*>((const char*)Ks + KSWZ(r32, cb));
    bf16x8 b1 = *reinterpret_cast<const bf16x8*>((const char*)Ks + KSWZ(32 + r32, cb));
    p0 = __builtin_amdgcn_mfma_f32_32x32x16_bf16(b0, qr[d0], p0, 0, 0, 0);
    p1 = __builtin_amdgcn_mfma_f32_32x32x16_bf16(b1, qr[d0], p1, 0, 0, 0); }
}
__device__ __forceinline__ int v_st(int k, int c) { const int kk = (k & ~0xC) | ((k & 4) << 1) | ((k & 8) >> 1); return ((kk >> 3) * 4 + (c >> 5)) * 512 + ((kk & 7) * 32 + (c & 31)) * 2; }
__device__ __forceinline__ int v_rd_base(int lane) { return ((lane & 3) << 3) | (((lane >> 2) & 3) << 6) | (((lane >> 4) & 1) << 5) | (((lane >> 5) & 1) << 8); }
constexpr int v_rd_off(int d0, int ks, int half) { return d0 * 512 + ks * 4096 + half * 2048; }
template <int OFF> __device__ __forceinline__ s16x4 tr_read(int vb) {
  s16x4 r; asm volatile("ds_read_b64_tr_b16 %0, %1 offset:%2" : "=&v"(r) : "v"(vb), "i"(OFF) : "memory"); return r;
}
template <int D0> __device__ __forceinline__ void pv_one(f32x16& od, int vb, bf16x8 pa0, bf16x8 pa1, bf16x8 pa2, bf16x8 pa3) {
  const s16x4 l0 = tr_read<v_rd_off(D0, 0, 0)>(vb), h0 = tr_read<v_rd_off(D0, 0, 1)>(vb), l1 = tr_read<v_rd_off(D0, 1, 0)>(vb), h1 = tr_read<v_rd_off(D0, 1, 1)>(vb);
  const s16x4 l2 = tr_read<v_rd_off(D0, 2, 0)>(vb), h2 = tr_read<v_rd_off(D0, 2, 1)>(vb), l3 = tr_read<v_rd_off(D0, 3, 0)>(vb), h3 = tr_read<v_rd_off(D0, 3, 1)>(vb);
  asm volatile("s_waitcnt lgkmcnt(0)" ::: "memory"); SBAR();
#define PK(L, H) (bf16x8){L[0], L[1], L[2], L[3], H[0], H[1], H[2], H[3]}
  od = __builtin_amdgcn_mfma_f32_32x32x16_bf16(pa0, PK(l0, h0), od, 0, 0, 0);
  od = __builtin_amdgcn_mfma_f32_32x32x16_bf16(pa1, PK(l1, h1), od, 0, 0, 0);
  od = __builtin_amdgcn_mfma_f32_32x32x16_bf16(pa2, PK(l2, h2), od, 0, 0, 0);
  od = __builtin_amdgcn_mfma_f32_32x32x16_bf16(pa3, PK(l3, h3), od, 0, 0, 0);
#undef PK
}
__device__ __forceinline__ void pv_d0(f32x16* o, int vb, bf16x8 pa0, bf16x8 pa1, bf16x8 pa2, bf16x8 pa3) {
  pv_one<0>(o[0], vb, pa0, pa1, pa2, pa3); pv_one<1>(o[1], vb, pa0, pa1, pa2, pa3); pv_one<2>(o[2], vb, pa0, pa1, pa2, pa3); pv_one<3>(o[3], vb, pa0, pa1, pa2, pa3);
}
template <int LD, int ldo, bool GATED>
__device__ __forceinline__ void attn_unit(const bf16_t* __restrict__ Qb, const bf16_t* __restrict__ Kh, const bf16_t* __restrict__ Vh,
                                          bf16_t* __restrict__ Ob, const bf16_t* __restrict__ Zb, int seq, char* lds, const int tid) {
  constexpr int SDEPTH = 2;
  const int wid = tid >> 6, lane = tid & 63, r32 = lane & 31, hi = lane >> 5;
  char* V_lds = lds; char* K_lds = lds + 3 * SHM_V;
  float* ws = (float*)(lds + 3 * SHM_V + 3 * SHM_K) + wid * 64; float* li_l = ws; float* al_l = ws + 32;
  float m_reg = -1e30f, l_reg = 0; f32x16 o[4] = {}; bf16x8 qr[8];
  { const unsigned qoff = (unsigned)((wid * QBLK + r32) * LD + hi * 8) * 2u;
#pragma unroll
    for (int d0 = 0; d0 < 8; ++d0) qr[d0] = *(const bf16x8*)((const char*)Qb + qoff + d0 * 32); }
  const int sr = tid >> 4, sc = (tid & 15) * 8, vst0 = v_st(sr, sc), vst1 = v_st(32 + sr, sc);
  const int vb0 = (int)(uintptr_t)V_lds + v_rd_base(lane);
  struct { bf16x8 vs0, vs1, ks0, ks1; } sr_[SDEPTH];
  const unsigned soff0 = (unsigned)(sr * LD + sc) * 2u, soff1 = (unsigned)((32 + sr) * LD + sc) * 2u;
#define SLOAD(i, k0) do { const char* vt_ = (const char*)Vh + (size_t)(k0) * (LD * 2); const char* kt_ = (const char*)Kh + (size_t)(k0) * (LD * 2); \
    sr_[i].vs0 = *(const bf16x8*)(vt_ + soff0); sr_[i].vs1 = *(const bf16x8*)(vt_ + soff1); sr_[i].ks0 = *(const bf16x8*)(kt_ + soff0); sr_[i].ks1 = *(const bf16x8*)(kt_ + soff1); } while (0)
#define SWRITE(so, i) do { *(bf16x8*)(V_lds + (so) + vst0) = sr_[i].vs0;          \
    *(bf16x8*)(V_lds + (so) + vst1) = sr_[i].vs1; int kc = sc * 2;               \
    *(bf16x8*)(K_lds + (so) + KSWZ(sr, kc)) = sr_[i].ks0;                       \
    *(bf16x8*)(K_lds + (so) + KSWZ(32 + sr, kc)) = sr_[i].ks1; } while (0)
#define SWAIT() do { asm volatile("s_waitcnt vmcnt(4)" ::: "memory"); } while (0)
#define RESC(a) do { if (__any((a) < 1.f)) { if (hi == 0) al_l[r32] = (a); asm volatile("s_waitcnt lgkmcnt(0)" ::: "memory"); \
    for (int d = 0; d < 4; ++d) for (int r = 0; r < 16; ++r) o[d][r] *= al_l[crow(r, hi)]; } } while (0)
#define ROT() do { const int t_ = sp; sp = sc_; sc_ = sn; sn = t_; } while (0)
  f32x16 pA0, pA1, pB0, pB1; float mnA, mnB, alA, alB; bf16x8 pa0, pa1, pa2, pa3; const int NT = seq / KVBLK;
  constexpr int SE = 0, SO = SDEPTH - 1;
  int sp = 0, sc_ = SHM_V, sn = 2 * SHM_V;
  SLOAD(SE, 0); asm volatile("s_waitcnt vmcnt(0)" ::: "memory"); SWRITE(0, SE); __syncthreads();
  qkt(pA0, pA1, (const bf16_t*)K_lds, qr, r32, hi); partialSM(pA0, pA1, m_reg, mnA, alA);
  SLOAD(SO, KVBLK); if (2 < NT) SLOAD(SE, 2 * KVBLK);
  SWAIT(); SWRITE(SHM_V, SO);
  for (int j = 1; j + 1 < NT; j += 2) {
    __syncthreads();
    SBAR(); qkt(pB0, pB1, (const bf16_t*)(K_lds + sc_), qr, r32, hi);
    finishSM(pA0, pA1, alA, l_reg, pa0, pa1, pa2, pa3); SBAR();
    SLOAD(SO, (j + SDEPTH) * KVBLK); SBAR();
    pv_d0(o, vb0 + sp, pa0, pa1, pa2, pa3); partialSM(pB0, pB1, m_reg, mnB, alB);
    SWAIT(); SWRITE(sn, SE);
    RESC(alB); ROT();
    __syncthreads();
    SBAR(); qkt(pA0, pA1, (const bf16_t*)(K_lds + sc_), qr, r32, hi);
    finishSM(pB0, pB1, alB, l_reg, pa0, pa1, pa2, pa3); SBAR();
    if (j + 3 < NT) SLOAD(SE, (j + 1 + SDEPTH) * KVBLK); SBAR();
    pv_d0(o, vb0 + sp, pa0, pa1, pa2, pa3); partialSM(pA0, pA1, m_reg, mnA, alA);
    SWAIT(); SWRITE(sn, SO);
    RESC(alA); ROT();
  }
  __syncthreads();
  SBAR(); qkt(pB0, pB1, (const bf16_t*)(K_lds + sc_), qr, r32, hi);
  finishSM(pA0, pA1, alA, l_reg, pa0, pa1, pa2, pa3); SBAR();
  pv_d0(o, vb0 + sp, pa0, pa1, pa2, pa3); partialSM(pB0, pB1, m_reg, mnB, alB);
  RESC(alB);
  finishSM(pB0, pB1, alB, l_reg, pa0, pa1, pa2, pa3); SBAR();
  pv_d0(o, vb0 + sc_, pa0, pa1, pa2, pa3); SBAR();
  if (hi == 0) li_l[r32] = l_reg; asm volatile("s_waitcnt lgkmcnt(0)" ::: "memory");
  float rli[16];
#pragma unroll
  for (int r = 0; r < 16; ++r) rli[r] = __builtin_amdgcn_rcpf(li_l[crow(r, hi)]);
  __syncthreads();
  { bf16_t* stg = (bf16_t*)lds + wid * 4096;
#pragma unroll
    for (int r = 0; r < 16; ++r) { const int orow = crow(r, hi);
#pragma unroll
      for (int d0 = 0; d0 < 4; ++d0) stg[orow * 128 + d0 * 32 + r32] = (bf16_t)f2bf(o[d0][r] * rli[r]); }
    asm volatile("s_waitcnt lgkmcnt(0)" ::: "memory");
#define ZLD(i) (*(const u32x4*)((const char*)Zb + (unsigned)((wid * QBLK + (i) * 4 + (lane >> 4)) * LD + (lane & 15) * 8) * 2u))
    u32x4 za, zb; if constexpr (GATED) { za = ZLD(0); zb = ZLD(1); }
#pragma unroll 1
    for (int i = 0; i < 8; i += 2) { u32x4 na, nb; if constexpr (GATED) { const int i2 = (i + 2) & 7; na = ZLD(i2); nb = ZLD(i2 + 1); }
#pragma unroll
      for (int q = 0; q < 2; ++q) { const int row = (i + q) * 4 + (lane >> 4), ch = lane & 15; u32x4 v = *(const u32x4*)(stg + row * 128 + ch * 8);
        if constexpr (GATED) { const u32x4 z = q ? zb : za;
          v.x = pk2(bflo(v.x) * siluf_(bflo(z.x)), bfhi(v.x) * siluf_(bfhi(z.x))); v.y = pk2(bflo(v.y) * siluf_(bflo(z.y)), bfhi(v.y) * siluf_(bfhi(z.y)));
          v.z = pk2(bflo(v.z) * siluf_(bflo(z.z)), bfhi(v.z) * siluf_(bfhi(z.z))); v.w = pk2(bflo(v.w) * siluf_(bflo(z.w)), bfhi(v.w) * siluf_(bfhi(z.w))); }
        *(u32x4*)((char*)Ob + (unsigned)((wid * QBLK + row) * ldo + ch * 8) * 2u) = v; }
      if constexpr (GATED) { za = na; zb = nb; } }
#undef ZLD
    asm volatile("s_waitcnt lgkmcnt(0)" ::: "memory"); }
  __syncthreads();
#undef SLOAD
#undef SWRITE
#undef SWAIT
#undef RESC
#undef ROT
}
#undef KSWZ
#undef SBAR
}

constexpr int RING_BYTES = 131072, ATT_OST_OFF = 69632  , LDSCTL_OFF = 155648, MISC_OFF = LDSCTL_OFF + 320, LDS_BYTES = 163840;
static_assert(att::SHM_ATTN <= RING_BYTES && MISC_OFF + 128 <= LDS_BYTES, "LDS map");
constexpr int NWAVES = 8;

typedef GAS unsigned gu32;
#define RLX_AGENT __ATOMIC_RELAXED, __HIP_MEMORY_SCOPE_AGENT
#define LDS_WAIT() asm volatile("s_waitcnt lgkmcnt(0)" ::: "memory")
#define VM_WAIT() asm volatile("s_waitcnt vmcnt(0)" ::: "memory")

#define XB_TMO      128
#define XB_XCNT(j)  (256  + 64 * (j))
#define XB_XSUB(j)  (1280 + 64 * (j))
#define XB_XGEN(j)  (2304 + 64 * (j))
#define XB_TOP      3328
#define XB_TOPGEN   3392
#define XCD_BAR_WORDS 3456
#define XB_SPIN_CAP (1u << 18)
__device__ __forceinline__ unsigned xb_ld(unsigned* p)              { return __hip_atomic_load(p, __ATOMIC_RELAXED, __HIP_MEMORY_SCOPE_AGENT); }
__device__ __forceinline__ unsigned xb_add(unsigned* p, unsigned v) { return __hip_atomic_fetch_add(p, v, __ATOMIC_RELAXED, __HIP_MEMORY_SCOPE_AGENT); }
__device__ __forceinline__ int lane_id_opaque() { int lo_, r_; asm volatile("v_mbcnt_lo_u32_b32 %0, -1, 0" : "=v"(lo_)); asm volatile("v_mbcnt_hi_u32_b32 %0, -1, %1" : "=v"(r_) : "v"(lo_)); return r_; }
__device__ __forceinline__ unsigned hw_slot() { return (unsigned)__builtin_amdgcn_s_getreg((5 << 11) | 4) & 63u; }
__device__ __forceinline__ unsigned xb_xcc_id() { return (unsigned)__builtin_amdgcn_s_getreg((3 << 11) | 20) & 0xFu; }
#define XB_SPIN(cond, bar) do { unsigned _sp = 0; while (cond) { __builtin_amdgcn_s_sleep(1); \
    if ((++_sp & 255u) == 0u) { if (xb_ld(&(bar)[XB_TMO])) break; if (_sp > XB_SPIN_CAP) { atomicAdd(&(bar)[XB_TMO], 1u); break; } } } } while (0)
struct XcdBarrier { unsigned* bar; unsigned x; volatile LAS unsigned* st; };
__device__ __forceinline__ XcdBarrier xcd_barrier_post(unsigned* bar, volatile LAS unsigned* st, bool is_t0) {
    XcdBarrier b; b.bar = bar; b.x = xb_xcc_id(); b.st = st;
    if (is_t0) (void)xb_add(&bar[XB_XCNT(b.x)], 1u);
    return b;
}
__device__ __forceinline__ void xcd_barrier_complete(unsigned* bar, unsigned x, unsigned& nloc, unsigned& nx) {
    const unsigned G = 256u;
    unsigned sum, cnt, mine, sp = 0u;
    for (;;) {
        sum = 0u; cnt = 0u; mine = 0u;
#pragma unroll
        for (unsigned j = 0; j < 16; ++j) { const unsigned c = xb_ld(&bar[XB_XCNT(j)]); sum += c; cnt += (c > 0u) ? 1u : 0u; mine = (j == x) ? c : mine; }
        if (sum == G) break;
        __builtin_amdgcn_s_sleep(1);
        if ((++sp & 255u) == 0u) { if (xb_ld(&bar[XB_TMO])) break; if (sp > XB_SPIN_CAP) { atomicAdd(&bar[XB_TMO], 1u); break; } }
    }
    nloc = mine > 0u ? mine : 1u; nx = cnt > 0u ? cnt : 1u;
}
__device__ __forceinline__ void xcd_barrier(const XcdBarrier& b, int wave_s) {
    asm volatile("s_waitcnt vmcnt(0)" ::: "memory");
    __syncthreads();
    if (wave_s == 0 && lane_id_opaque() == 0) {
        unsigned* bar = b.bar;
        __builtin_amdgcn_s_waitcnt(0);
        unsigned nloc = b.st[0], nx = b.st[1];
        if (nloc == 0u) { xcd_barrier_complete(bar, b.x, nloc, nx); b.st[0] = nloc; b.st[1] = nx; }
        const unsigned old = xb_add(&bar[XB_XSUB(b.x)], 1u);
        const unsigned gen = old / nloc;
        if (old + 1u == (gen + 1u) * nloc) {
            __builtin_amdgcn_fence(__ATOMIC_RELEASE, "agent");
            asm volatile("s_waitcnt vmcnt(0)" ::: "memory");
            const unsigned og = xb_add(&bar[XB_TOP], 1u);
            const unsigned tg = og / nx;
            if (og + 1u == (tg + 1u) * nx) xb_add(&bar[XB_TOPGEN], 1u);
            else XB_SPIN(xb_ld(&bar[XB_TOPGEN]) == tg, bar);
            __builtin_amdgcn_fence(__ATOMIC_ACQUIRE, "agent");
            xb_add(&bar[XB_XGEN(b.x)], 1u);
            asm volatile("s_waitcnt vmcnt(0)" ::: "memory");
        } else {
            XB_SPIN(xb_ld(&bar[XB_XGEN(b.x)]) == gen, bar);
            __builtin_amdgcn_fence(__ATOMIC_ACQUIRE, "agent");
            asm volatile("s_waitcnt vmcnt(0)" ::: "memory");
        }
    }
    __syncthreads();
}

__device__ __forceinline__ int p0_dst_row(int ns, int qkcols) {
    if (qkcols > 0) return (ns < qkcols) ? ((ns & ~127) | qk_pi_inv(ns & 127)) : ns;
    if (qkcols < 0) { const int code = -qkcols - 1, gate = code >> 4, dir = (code >> 3) & 1, nblk = code & 7, e = ns & 127;
        const int c = (((e >> 6) & 1) << 7) | (((e >> 4) & 3) << 5) | (((e >> 2) & 3) << 3) | (gate << 2) | (e & 3); return (nblk * 4 + dir * 2 + (ns >> 7)) * 256 + c; }
    return ns;
}
__device__ __forceinline__ void p0_transpose_item(const float* __restrict__ W, int K, int N, bf16_t* __restrict__ WT, LAS bf16_t* scr, int item, int lane, int qkcols, const float* shl = nullptr, float* shwp = nullptr) {
    const int nblk = N / 64, kb = item / nblk, nb = item % nblk, k0 = 64 * kb, n0 = 64 * nb;
    const int n4 = (lane & 15) * 4, kr = lane >> 4;
    f32x4 v[16];
#pragma unroll
    for (int i = 0; i < 16; ++i) v[i] = *(const f32x4*)(W + (size_t)(k0 + 4 * i + kr) * N + n0 + n4);
    float shv[5];
    if (shl) {
#pragma unroll
        for (int r = 0; r < 5; ++r) shv[r] = shl[(size_t)r * 6144 + k0 + lane]; }
#pragma unroll
    for (int i = 0; i < 16; ++i) { const int k = 4 * i + kr;
        scr[(n4 + 0) * 72 + k] = (bf16_t)f2bf(v[i].x); scr[(n4 + 1) * 72 + k] = (bf16_t)f2bf(v[i].y); scr[(n4 + 2) * 72 + k] = (bf16_t)f2bf(v[i].z); scr[(n4 + 3) * 72 + k] = (bf16_t)f2bf(v[i].w); }
    LAS float* shs = (LAS float*)(scr + 64 * 72);
    if (shl) {
#pragma unroll
        for (int r = 0; r < 5; ++r) shs[r * 64 + lane] = shv[r]; }
    LDS_WAIT(); asm volatile("" ::: "memory");
#pragma unroll
    for (int i = 0; i < 8; ++i) { const int n = 8 * i + (lane >> 3), kc = (lane & 7) * 8;
        const u32x4 o = *(const LAS u32x4*)(scr + n * 72 + kc);
        const int ns = n0 + n, nd = p0_dst_row(ns, qkcols);
        *(u32x4*)(WT + (size_t)nd * K + k0 + kc) = o; }
    if (shl) { float a0 = 0.f, a1 = 0.f, a2 = 0.f, a3 = 0.f, a4 = 0.f;
#pragma unroll 1
        for (int c = 0; c < 8; ++c) { const u32x4 w = *(const LAS u32x4*)(scr + lane * 72 + c * 8);
            const float wf[8] = {bflo(w.x), bfhi(w.x), bflo(w.y), bfhi(w.y), bflo(w.z), bfhi(w.z), bflo(w.w), bfhi(w.w)};
#pragma unroll
            for (int h = 0; h < 2; ++h) { const f32x4 s0 = *(const LAS f32x4*)(shs + c * 8 + h * 4), s1 = *(const LAS f32x4*)(shs + 64 + c * 8 + h * 4), s2 = *(const LAS f32x4*)(shs + 128 + c * 8 + h * 4),
                                 s3 = *(const LAS f32x4*)(shs + 192 + c * 8 + h * 4), s4 = *(const LAS f32x4*)(shs + 256 + c * 8 + h * 4);
#pragma unroll
                for (int e = 0; e < 4; ++e) { const float x = wf[h * 4 + e]; a0 += x * s0[e]; a1 += x * s1[e]; a2 += x * s2[e]; a3 += x * s3[e]; a4 += x * s4[e]; } } }
        const int nd = p0_dst_row(n0 + lane, qkcols); float* o = shwp + (size_t)kb * 5 * 8192 + nd;
        o[0] = a0; o[8192] = a1; o[2 * 8192] = a2; o[3 * 8192] = a3; o[4 * 8192] = a4; }
    LDS_WAIT(); asm volatile("" ::: "memory");
}
__device__ __forceinline__ void conv_job(const float* W, int N, bf16_t* WT, int qkcols, int shw_layer, unsigned char* ws, LAS unsigned char* ldsl, int wave, int lane, int widx, int nw) {
    LAS bf16_t* scr = (LAS bf16_t*)(ldsl + wave * 16384);
    const float* shl = shw_layer > 0 ? (const float*)(ws + WS_MODS) + (size_t)shw_layer * 5 * 6144 : nullptr;
    float* shwp = shw_layer > 0 ? (float*)(ws + WS_SHWP) + (size_t)(shw_layer - 1) * 32 * 5 * 8192 : nullptr;
    const int items = (DM / 64) * (N / 64);
    for (int it = widx; it < items; it += nw) { int l2 = lane; asm volatile("" : "+v"(l2));
        p0_transpose_item(W, DM, N, WT, scr, it, l2, qkcols, shl, shwp); }
}
__device__ __forceinline__ void sincos_d(float angf, float& s, float& c) {
    const double a = (double)angf; const double kq = rint(a * 0.63661977236758134308); const double r = a - kq * 1.57079632679489661923; const double r2 = r * r;
    const double sp = r * (1.0 + r2 * (-1.0 / 6 + r2 * (1.0 / 120 + r2 * (-1.0 / 5040 + r2 * (1.0 / 362880 + r2 * (-1.0 / 39916800 + r2 * (1.0 / 6227020800.0)))))));
    const double cp = 1.0 + r2 * (-0.5 + r2 * (1.0 / 24 + r2 * (-1.0 / 720 + r2 * (1.0 / 40320 + r2 * (-1.0 / 3628800 + r2 * (1.0 / 479001600.0))))));
    const int q = ((int)kq) & 3;
    const double ss = (q == 0) ? sp : (q == 1) ? cp : (q == 2) ? -sp : -cp;
    const double cc = (q == 0) ? cp : (q == 1) ? -sp : (q == 2) ? -cp : sp;
    s = (float)ss; c = (float)cc;
}

__device__ __forceinline__ void ada_fill_sil(CArgsP ap, LAS float* sil, int tid) {
    for (int i = tid; i < 5 * DM; i += NWAVES * 64) { const int r = i / DM, k = i - r * DM; const float v = (r < 4) ? ap->in[I_C][r * DM + k] : ap->in[I_CCTX][k]; sil[i] = siluf_(v); }
}
__device__ __forceinline__ void ada_item(CArgsP ap, unsigned char* ws, const LAS float* sil, int l, int kc, int ng, int lane) {
    const int nq = ng * 64 + lane;
    const float* wp = ap->in[I_ADAW] + ((size_t)l * DM + kc * 128) * 6144 + nq * 4;
    f32x4 a0 = {0, 0, 0, 0}, a1 = a0, a2 = a0, a3 = a0, a4 = a0;
#pragma unroll 8
    for (int k = 0; k < 128; ++k) { const f32x4 w = *(const f32x4*)(wp + (size_t)k * 6144); const int kk = kc * 128 + k;
        a0 += w * sil[kk]; a1 += w * sil[DM + kk]; a2 += w * sil[2 * DM + kk]; a3 += w * sil[3 * DM + kk]; a4 += w * sil[4 * DM + kk]; }
    if (kc == 0) { const f32x4 bv = *(const f32x4*)(ap->in[I_ADAB] + l * 6144 + nq * 4); a0 += bv; a1 += bv; a2 += bv; a3 += bv; a4 += bv; }
    float* mp = (float*)(ws + WS_AGG) + ((size_t)(kc * 4 + l) * 5) * 6144 + nq * 4;
    *(f32x4*)(mp) = a0; *(f32x4*)(mp + 6144) = a1; *(f32x4*)(mp + 2 * 6144) = a2; *(f32x4*)(mp + 3 * 6144) = a3; *(f32x4*)(mp + 4 * 6144) = a4;
}
__device__ __forceinline__ void ada_layer(CArgsP ap, unsigned char* ws, const LAS float* sil, int l, int lane, int widx, int nw) {
    for (int it = widx; it < 384; it += nw) ada_item(ap, ws, sil, l, it / 24, it % 24, lane);
}
__device__ __forceinline__ void mods_reduce(CArgsP ap, unsigned char* ws, int l, int gt_, int NGT) {
    const float* part = (const float*)(ws + WS_AGG) + (size_t)l * 5 * 6144; float* mods = (float*)(ws + WS_MODS) + (size_t)l * 5 * 6144; float* GM = (float*)(ws + WS_GM) + (size_t)l * 5 * DM;
    for (int it = gt_; it < 5 * 6144 / 4; it += NGT) { f32x4 acc = {0.f, 0.f, 0.f, 0.f};
#pragma unroll
        for (int kc = 0; kc < 16; ++kc) acc += *(const f32x4*)(part + (size_t)kc * 4 * 5 * 6144 + (size_t)it * 4);
        *(f32x4*)(mods + (size_t)it * 4) = acc;
        const int r = (it * 4) / 6144, c = it * 4 - r * 6144;
        if (l >= 1 && c >= DM && c < 2 * DM) { const f32x4 g = *(const f32x4*)(ap->in[I_NORMG] + l * DM + (c - DM)); *(f32x4*)(GM + (size_t)r * DM + (c - DM)) = g * (acc + 1.0f); } }
}

__device__ __forceinline__ void fresh_ids(LAS unsigned char* ldsl, int& bx, int& wave, int& lane) {
    bx = __builtin_amdgcn_readfirstlane((int)((volatile LAS unsigned*)(ldsl + MISC_OFF))[12]); wave = __builtin_amdgcn_readfirstlane((int)((volatile LAS unsigned*)(ldsl + LDSCTL_OFF))[hw_slot()]); lane = lane_id_opaque();
    asm volatile("" : "+s"(bx), "+s"(wave), "+v"(lane));
}

enum { K_PRO, K_MODRED, K_PRE0, K_GEMM_BF16, K_GEMM_RES, K_GEMM_GATES, K_QKPOST, K_ATT_A, K_ATT_B, K_COMBINE, K_CONV, K_SCAN_AGG, K_SCAN_APPLY, K_FINAL };
template <int KIND, int layer, int PH, bool DUPRUN = false>
__device__ __forceinline__ void run_phase(char* ldsg, int wave_s) {
    LAS unsigned char* ldsl = (LAS unsigned char*)ldsg;
    CArgsP ap = (CArgsP)__builtin_amdgcn_kernarg_segment_ptr();
    asm volatile("" : "+s"(ap));
    int G = pg8::GRID, bx = __builtin_amdgcn_readfirstlane((int)((volatile LAS unsigned*)(ldsl + MISC_OFF))[12]), wave = wave_s;
    asm volatile("" : "+s"(G)); asm volatile("" : "+s"(bx)); asm volatile("" : "+s"(wave));
    int tid = wave * 64 + lane_id_opaque();
    asm volatile("" : "+v"(tid));
    const int lane = tid & 63;
    const int vcu = (G % 8 == 0) ? (bx % 8) * (G / 8) + bx / 8 : bx;
    const int gw = vcu * NWAVES + wave, NGW = G * NWAVES;
    const int gt_ = vcu * NWAVES * 64 + tid, NGT = G * NWAVES * 64;
    unsigned char* ws = ap->ws;
    float* mods = (float*)(ws + WS_MODS);
    float* tabc = (float*)(ws + WS_TAB); float* tabs = tabc + 96 * 32; float* c8t = (float*)(ws + WS_TAB + 65536);
    bf16_t* WA_IN = (bf16_t*)(ws + WS_WA_IN); bf16_t* WA_OUT = (bf16_t*)(ws + WS_WA_OUT); bf16_t* WB_IN = (bf16_t*)(ws + WS_WB_IN); bf16_t* WB_OUT = (bf16_t*)(ws + WS_WB_OUT);
    bf16_t* WR_IN = (bf16_t*)(ws + WS_WR_IN); bf16_t* WR_OUT = (bf16_t*)(ws + WS_WR_OUT); bf16_t* WG = (bf16_t*)(ws + WS_WG);
    float* X = (float*)(ws + WS_X); bf16_t* H = (bf16_t*)(ws + WS_H); bf16_t* Y = (bf16_t*)(ws + WS_Y); bf16_t* U = (bf16_t*)(ws + WS_U); bf16_t* OD = (bf16_t*)(ws + WS_OD);
    unsigned* SAB = (unsigned*)(ws + WS_SA); float* AGG = (float*)(ws + WS_AGG);
    bf16_t* UP = (bf16_t*)(ws + WS_UP); float* GM = (float*)(ws + WS_GM); float* SHW = (float*)(ws + WS_SHW); float* SSQ = (float*)(ws + WS_SSQ);
    (void)GM; (void)SHW; (void)SSQ; (void)mods; (void)tabc; (void)tabs; (void)c8t; (void)WA_IN; (void)WA_OUT; (void)WB_IN; (void)WB_OUT; (void)WR_IN; (void)WR_OUT; (void)WG; (void)X; (void)H; (void)Y; (void)U; (void)OD; (void)SAB; (void)AGG; (void)UP;
    (void)gw; (void)NGW; (void)gt_; (void)NGT; (void)lane; (void)ldsl;

    if constexpr (KIND == K_PRO) {
        for (int rep_a = 0; rep_a < (DUP_SUB == 1 ? 2 : 1); ++rep_a)
        {
            LAS float* sil = (LAS float*)ldsl;
            ada_fill_sil(ap, sil, tid); __syncthreads();
            if (wave < 3) { const int it = bx + 256 * wave; ada_item(ap, ws, sil, it / 384, (it % 384) / 24, it % 24, lane); }
            __syncthreads();
        }
        for (int rep_b = 0; rep_b < (DUP_SUB == 2 ? 2 : 1); ++rep_b) {
            LAS bf16_t* scr = (LAS bf16_t*)(ldsl + wave * 16384);
            constexpr int I_AIN = (DM / 64) * (A_IN / 64), I_SQ = (DM / 64) * (DM / 64), I_BIN = (DM / 64) * (B_IN / 64);
            constexpr int NITEMS = I_AIN + I_SQ + I_BIN;
            for (int it = gw; it < NITEMS; it += NGW) {
                int r = it;
                if (r < I_AIN) { p0_transpose_item(ap->in[I_AWIN], DM, A_IN, WA_IN, scr, r, lane, 2560); continue; } r -= I_AIN;
                if (r < I_SQ) { p0_transpose_item(ap->in[I_AWOUT], DM, DM, WA_OUT, scr, r, lane, 0); continue; } r -= I_SQ;
                p0_transpose_item(ap->in[I_BWIN], DM, B_IN, WB_IN, scr, r, lane, 4096);
            }
        }
        for (int it = gt_; it < 96 * 32; it += NGT) { const int pos = it >> 5, j = it & 31; const float freq = powf(10000.0f, -(float)j / 32.0f); const float p = (float)(pos < 32 ? pos : pos - 32);
            float s, c; sincos_d(p * freq, s, c); tabc[it] = c; tabs[it] = s; }
        for (int it = gt_; it < 2 * DM; it += NGT) { const float lam = ap->in[I_RLAM][it]; const float z = -lam; const float sp = fmaxf(z, 0.f) + log1pf(__expf(-fabsf(z))); c8t[it] = 8.0f * sp; }
    }
    else if constexpr (KIND == K_MODRED) {
        mods_reduce(ap, ws, 0, gt_, NGT); mods_reduce(ap, ws, 1, gt_, NGT);
    }
    else if constexpr (KIND == K_PRE0) {
        { const float* gsrc = ap->in[I_NORMG];
          for (int row = gw; row < MROWS; row += NGW) {
            const int b = row / TT, t = row - b * TT; const float* mrow = mods + (size_t)(t < CTXL ? 4 : b) * 6144;
            const float* xsrc = (t < CTXL) ? ap->in[I_CTX] + (size_t)(b * CTXL + t) * DM : ap->in[I_X] + (size_t)(b * SEQ + t - CTXL) * DM;
            const f32x4* xr = (const f32x4*)xsrc + lane; f32x4 v[8]; float s = 0.f;
#pragma unroll
            for (int j = 0; j < 8; ++j) { v[j] = xr[64 * j]; s += (v[j].x * v[j].x + v[j].y * v[j].y) + (v[j].z * v[j].z + v[j].w * v[j].w); }
            s = wave_sum(s);
            if (lane < 32) SSQ[(size_t)row * 32 + lane] = (lane == 0) ? s : 0.f;
            u32x2* o8 = (u32x2*)(H + (size_t)row * DM) + lane;
#pragma unroll
            for (int j = 0; j < 8; ++j) { const int c = 4 * lane + 256 * j; const f32x4 g = *(const f32x4*)(gsrc + c), sc = *(const f32x4*)(mrow + DM + c);
                const f32x4 y = v[j] * g * (sc + 1.0f); u32x2 w; w.x = pk2(y.x, y.y); w.y = pk2(y.z, y.w); o8[64 * j] = w; }
          } }
        for (int l = 0; l < 2; ++l) {
            LAS float* shl = (LAS float*)ldsl;
            __syncthreads();
            for (int i = tid; i < 5 * DM; i += NWAVES * 64) { const int r = i >> 11, k = i & (DM - 1); shl[i] = mods[(size_t)(l * 5 + r) * 6144 + k]; }
            __syncthreads();
            const bf16_t* Wt = (l == 0) ? WA_IN : (l == 3) ? WA_IN + (size_t)A_IN * DM : (l == 1) ? WB_IN : WR_IN; const int N = (l == 1) ? B_IN : (l == 2) ? R_IN : A_IN;
            for (int n = gw; n < N; n += NGW) { float a0 = 0.f, a1 = 0.f, a2 = 0.f, a3 = 0.f, a4 = 0.f;
#pragma unroll
                for (int j = 0; j < 4; ++j) { const int k0 = j * 512 + lane * 8; const u32x4 w = *(const u32x4*)(Wt + (size_t)n * DM + k0);
                    const float wf[8] = {bflo(w.x), bfhi(w.x), bflo(w.y), bfhi(w.y), bflo(w.z), bfhi(w.z), bflo(w.w), bfhi(w.w)};
#pragma unroll
                    for (int e = 0; e < 8; ++e) { a0 += wf[e] * shl[k0 + e]; a1 += wf[e] * shl[DM + k0 + e]; a2 += wf[e] * shl[2 * DM + k0 + e]; a3 += wf[e] * shl[3 * DM + k0 + e]; a4 += wf[e] * shl[4 * DM + k0 + e]; } }
                a0 = wave_sum(a0); a1 = wave_sum(a1); a2 = wave_sum(a2); a3 = wave_sum(a3); a4 = wave_sum(a4);
                if (lane == 0) { float* o = SHW + (size_t)l * 5 * 8192 + n; o[0] = a0; o[8192] = a1; o[2 * 8192] = a2; o[3 * 8192] = a3; o[4 * 8192] = a4; } }
        }
    }
    else if constexpr (KIND == K_GEMM_BF16) {
        constexpr size_t OB = (layer == 0) ? WS_WA_IN : (layer == 3) ? WS_WA_IN + (size_t)A_IN * DM * 2 : (layer == 1) ? WS_WB_IN : WS_WR_IN;
        constexpr int N = (layer == 1) ? B_IN : (layer == 2) ? R_IN : A_IN;
        pg8::EpiBf16<layer, N> E{ws, ap};
        if constexpr (layer == 0) {
            typedef pg8::Sched<MROWS / 256, N / 256, DM / 64, 0, 0, TAIL_SPLIT> SchedT; SchedT S; S.init(bx, vcu);
            pg8::gemm_phase<pg8::EpiBf16<layer, N>, SchedT, DM / 64, PH, WS_H, OB>(ldsl, tid, S, E);
            if constexpr (!DUPRUN && SchedT::F == 1 && SchedT::T > 0) { int bx, wave, lane; fresh_ids(ldsl, bx, wave, lane); const int tid = wave * 64 + lane; if (bx >= SchedT::T) {
                CArgsP ap2 = (CArgsP)__builtin_amdgcn_kernarg_segment_ptr(); asm volatile("" : "+s"(ap2)); const CArgsP ap = ap2; unsigned char* const ws = ap2->ws;
                const int widx = (bx - SchedT::T) * NWAVES + wave, nw = (pg8::GRID - SchedT::T) * NWAVES;
                LAS float* sil = (LAS float*)ldsl; ada_fill_sil(ap, sil, tid); __syncthreads(); ada_layer(ap, ws, sil, 2, lane, widx, nw); ada_layer(ap, ws, sil, 3, lane, widx, nw); } }
        } else {
            constexpr int CLO = (layer == 3) ? 8 : 0, CHI = (layer == 3) ? 12 : N / 256;
            typedef pg8::SchedM<N / 256, DM / 64, CLO, CHI> SchedT; SchedT S; S.init(bx, vcu);
            constexpr size_t OB0 = (layer == 1) ? WS_WA_OUT : (layer == 2) ? WS_WB_OUT : WS_WR_OUT;
            pg8::EpiResid<layer - 1, false> E0{ws, ap};
            pg8::gemm_phase<pg8::EpiBf16<layer, N>, SchedT, DM / 64, PH, WS_H, OB, pg8::EpiResid<layer - 1, false>, WS_Y, OB0>(ldsl, tid, S, E, E0);
            if constexpr (!DUPRUN && SchedT::T > 0) { int bx, wave, lane; fresh_ids(ldsl, bx, wave, lane); const int tid = wave * 64 + lane; (void)tid; if (bx >= SchedT::T) {
                CArgsP ap2 = (CArgsP)__builtin_amdgcn_kernarg_segment_ptr(); asm volatile("" : "+s"(ap2)); const CArgsP ap = ap2; unsigned char* const ws = ap2->ws;
                const int widx = (bx - SchedT::T) * NWAVES + wave, nw = (pg8::GRID - SchedT::T) * NWAVES;
                if constexpr (layer == 1) { conv_job(ap->in[I_BWOUT], DM, (bf16_t*)(ws + WS_WB_OUT), 0, 0, ws, ldsl, wave, lane, widx, nw); conv_job(ap->in[I_RWIN], R_IN, (bf16_t*)(ws + WS_WR_IN), 0, 2, ws, ldsl, wave, lane, widx, nw); }
                if constexpr (layer == 2) { conv_job(ap->in[I_RWOUT], DM, (bf16_t*)(ws + WS_WR_OUT), 0, 0, ws, ldsl, wave, lane, widx, nw); conv_job(ap->in[I_AWIN] + (size_t)DM * A_IN, A_IN, (bf16_t*)(ws + WS_WA_IN) + (size_t)A_IN * DM, 2560, 3, ws, ldsl, wave, lane, widx, nw);
                    conv_job(ap->in[I_AWOUT] + (size_t)DM * DM, DM, (bf16_t*)(ws + WS_WA_OUT) + (size_t)DM * DM, 0, 0, ws, ldsl, wave, lane, widx, nw);
                    LAS bf16_t* scr = (LAS bf16_t*)(ldsl + wave * 16384);
                    for (int it = widx; it < 32 * 16; it += nw) { const int mtx = it >> 4, sub = it & 15; const int gate = mtx >> 4, dir = (mtx >> 3) & 1, nblk = mtx & 7;
                        p0_transpose_item((gate ? ap->in[I_RWX] : ap->in[I_RWA]) + (size_t)(dir * 8 + nblk) * 65536, 256, 256, (bf16_t*)(ws + WS_WG), scr, sub, lane, -(mtx + 1)); } } } }
        }
    }
    else if constexpr (KIND == K_GEMM_RES) {
        constexpr size_t OB = (layer == 0) ? WS_WA_OUT : (layer == 3) ? WS_WA_OUT + (size_t)DM * DM * 2 : (layer == 1) ? WS_WB_OUT : WS_WR_OUT;
        typedef pg8::Sched<32, DM / 256, DM / 64, 1, 0, TAIL_SPLIT> SchedT; SchedT S; S.init(bx, vcu);
        pg8::EpiResid<layer, DUPRUN> E{ws, ap};
        pg8::gemm_phase<pg8::EpiResid<layer, DUPRUN>, SchedT, DM / 64, PH, WS_Y, OB>(ldsl, tid, S, E);
    }
    else if constexpr (KIND == K_GEMM_GATES) {
        typedef pg8::Sched<MROWS / 256, 32, 4, 0, 1, false> SchedT; SchedT S; S.init(bx, vcu);
        pg8::EpiGates E{ws, ap};
        pg8::gemm_phase<pg8::EpiGates, SchedT, 4, PH, WS_UP, WS_WG>(ldsl, tid, S, E);
    }
    else if constexpr (KIND == K_ATT_A) {
        if constexpr (layer == 0 && !DUPRUN) { mods_reduce(ap, ws, 2, gt_, NGT); mods_reduce(ap, ws, 3, gt_, NGT); }
        const int nlat = 512, ntot = (layer == 0) ? 576 : 512;
        for (int u = vcu; u < ntot; u += G) {
            int b, h, qrow, seq;
            if (u < nlat) { const int qb = u & 7, hh = (u >> 3) & 15; b = u >> 7; h = hh; qrow = b * TT + CTXL + qb * 256; seq = TT; }
            else { const int v = u - nlat; b = v >> 4; h = v & 15; qrow = b * TT; seq = CTXL; }
            const int g4 = h >> 2;
            const bf16_t* Qb = U + (size_t)qrow * A_IN + h * 128;
            const bf16_t* Kh = U + (size_t)(b * TT) * A_IN + 2048 + g4 * 128;
            const bf16_t* Vh = U + (size_t)(b * TT) * A_IN + 2560 + g4 * 128;
            const bf16_t* Zb = U + (size_t)qrow * A_IN + 3072 + h * 128;
            att::attn_unit<A_IN, DM, true>(Qb, Kh, Vh, Y + (size_t)qrow * DM + h * 128, Zb, seq, ldsg, tid);
        }
    }
    else if constexpr (KIND == K_ATT_B) {
        for (int u = vcu; u < 1152; u += G) {
            int b, h, mv, qrow, seq;
            if (u < 1024) { const int qb = u & 7; mv = (u >> 3) & 3; h = (u >> 5) & 7; b = u >> 8; qrow = b * TT + CTXL + qb * 256; seq = TT; }
            else { const int v = u - 1024; mv = v & 3; h = (v >> 2) & 7; b = v >> 5; qrow = b * TT; seq = CTXL; }
            const int m = mv >> 1, vh = mv & 1;
            const bf16_t* Qb = U + (size_t)qrow * B_IN + m * 1024 + h * 128;
            const bf16_t* Kh = U + (size_t)(b * TT) * B_IN + 2048 + m * 1024 + h * 128;
            const bf16_t* Vh = U + (size_t)(b * TT) * B_IN + 4096 + h * 256 + vh * 128;
            att::attn_unit<B_IN, 4096, false>(Qb, Kh, Vh, OD + (size_t)qrow * 4096 + (m * 8 + h) * 256 + vh * 128, nullptr, seq, ldsg, tid);
        }
    }
    else if constexpr (KIND == K_COMBINE) {
        float s1 = ap->in[I_BLAM][lane] * ap->in[I_BLAM][128 + lane] + ap->in[I_BLAM][64 + lane] * ap->in[I_BLAM][192 + lane];
        float s2 = ap->in[I_BLAM][256 + lane] * ap->in[I_BLAM][384 + lane] + ap->in[I_BLAM][320 + lane] * ap->in[I_BLAM][448 + lane];
        s1 = wave_sum(s1); s2 = wave_sum(s2);
        const float lam = expf(s1) - expf(s2) + LAM_INIT1;
        const int hsel = lane >> 5, j = lane & 31;
        for (int it0 = gw; it0 < MROWS * 4; it0 += 2 * NGW) {
            u32x4 r0v[2], r1v[2], zrv[2]; bool ok[2];
#pragma unroll
            for (int q = 0; q < 2; ++q) { const int it = it0 + q * NGW; ok[q] = it < MROWS * 4; const int itc = ok[q] ? it : 0; const int row = itc >> 2, h = (itc & 3) * 2 + hsel;
                r0v[q] = *(const u32x4*)(OD + (size_t)row * 4096 + h * 256 + j * 8); r1v[q] = *(const u32x4*)(OD + (size_t)row * 4096 + (8 + h) * 256 + j * 8); zrv[q] = *(const u32x4*)(U + (size_t)row * B_IN + 6144 + h * 256 + j * 8); }
#pragma unroll
            for (int q = 0; q < 2; ++q) if (ok[q]) { const int it = it0 + q * NGW; const int row = it >> 2, h = (it & 3) * 2 + hsel; const u32x4 r0 = r0v[q], r1 = r1v[q], zr = zrv[q];
                float o[8] = {bflo(r0.x) - lam * bflo(r1.x), bfhi(r0.x) - lam * bfhi(r1.x), bflo(r0.y) - lam * bflo(r1.y), bfhi(r0.y) - lam * bfhi(r1.y),
                              bflo(r0.z) - lam * bflo(r1.z), bfhi(r0.z) - lam * bfhi(r1.z), bflo(r0.w) - lam * bflo(r1.w), bfhi(r0.w) - lam * bfhi(r1.w)};
                const float z[8] = {bflo(zr.x), bfhi(zr.x), bflo(zr.y), bfhi(zr.y), bflo(zr.z), bfhi(zr.z), bflo(zr.w), bfhi(zr.w)};
                float ss = 0.f;
#pragma unroll
                for (int k = 0; k < 8; ++k) ss += o[k] * o[k];
                ss += shx<1>(ss); ss += shx<2>(ss); ss += shx<4>(ss); ss += shx<8>(ss); ss += shx<16>(ss);
                const float rstd = frsq(ss * (1.0f / 256.0f) + EPS); const float* sg = ap->in[I_BSUBG] + j * 8;
#pragma unroll
                for (int k = 0; k < 8; ++k) o[k] = (o[k] * rstd * sg[k]) * (1.0f - LAM_INIT1) * siluf_(z[k]);
                u32x4 w; w.x = pk2(o[0], o[1]); w.y = pk2(o[2], o[3]); w.z = pk2(o[4], o[5]); w.w = pk2(o[6], o[7]);
                *(u32x4*)(Y + (size_t)row * DM + h * 256 + j * 8) = w; }
        }
    }
    else if constexpr (KIND == K_CONV) {
        const int c8 = (gt_ & 255) * 8;
        f32x4 wv[4][2], bv[2];
#pragma unroll
        for (int jj = 0; jj < 4; ++jj) { wv[jj][0] = *(const f32x4*)(ap->in[I_RCONVW] + jj * DM + c8); wv[jj][1] = *(const f32x4*)(ap->in[I_RCONVW] + jj * DM + c8 + 4); }
        bv[0] = *(const f32x4*)(ap->in[I_RCONVB] + c8); bv[1] = *(const f32x4*)(ap->in[I_RCONVB] + c8 + 4);
        for (int it = gt_; it < (MROWS / 4) * 256; it += NGT) {
            const int row0 = (it >> 8) * 4; const int b = row0 / TT, t0 = row0 - b * TT; const int lo = (t0 < CTXL) ? 0 : CTXL, hi_ = (t0 < CTXL) ? CTXL : TT;
            u32x4 rv[7];
#pragma unroll
            for (int q = 0; q < 7; ++q) { const int ts = t0 + q - 2; rv[q] = (ts >= lo && ts < hi_) ? *(const u32x4*)(U + (size_t)(b * TT + ts) * R_IN + c8) : (u32x4){0u, 0u, 0u, 0u}; }
#pragma unroll
            for (int r = 0; r < 4; ++r) { f32x4 a0 = bv[0], a1 = bv[1];
#pragma unroll
                for (int jj = 0; jj < 4; ++jj) { const u32x4 x = rv[r + jj]; a0 += (f32x4){bflo(x.x), bfhi(x.x), bflo(x.y), bfhi(x.y)} * wv[jj][0]; a1 += (f32x4){bflo(x.z), bfhi(x.z), bflo(x.w), bfhi(x.w)} * wv[jj][1]; }
                u32x4 o; o.x = pk2(a0.x, a0.y); o.y = pk2(a0.z, a0.w); o.z = pk2(a1.x, a1.y); o.w = pk2(a1.z, a1.w);
                *(u32x4*)(UP + (size_t)(row0 + r) * DM + c8) = o; }
        }
    }
    else if constexpr (KIND == K_SCAN_AGG) {
        const float* __restrict__ AGA = (const float*)(ws + WS_AG16); const float* __restrict__ AGB = AGA + (size_t)576 * 2 * DM; float* __restrict__ CAR = (float*)(ws + WS_CARRY);
        if (wave == 0 && vcu < 256) { const int b = vcu >> 6, dir = (vcu >> 5) & 1, ch = (vcu & 31) * 64 + lane; float h = 0.f;
            for (int k = 0; k < 9; ++k) {
                float av[16], bv[16]; unsigned off[16];
#pragma unroll
                for (int j = 0; j < 16; ++j) { const int q = 16 * k + j; const int c = dir ? (q < 16 ? 15 - q : 159 - q) : q; off[j] = (unsigned)(((b * 144 + c) * 2 + dir) * DM + ch); av[j] = AGA[off[j]]; bv[j] = AGB[off[j]]; }
#pragma unroll
                for (int j = 0; j < 16; ++j) { CAR[off[j]] = h; h = fmaf(av[j], h, bv[j]); }
            } }
    }
    else if constexpr (KIND == K_SCAN_APPLY) {
        const float* __restrict__ CAR = (const float*)(ws + WS_CARRY); const unsigned* __restrict__ SABr = SAB; const bf16_t* __restrict__ Ur = U; bf16_t* __restrict__ Yr = Y;
        for (int it = gt_; it < 576 * 512; it += NGT) {
            const int c4 = it & 511, g = it >> 9; const unsigned r0 = (unsigned)g * 16u;
            f32x4 hf = *(const f32x4*)(CAR + ((size_t)g * 2) * DM + c4 * 4), hr = *(const f32x4*)(CAR + ((size_t)g * 2 + 1) * DM + c4 * 4);
            u32x4 wf[16], wrv[16]; u32x2 zr[16];
#pragma unroll
            for (int s = 0; s < 16; ++s) { wf[s] = *(const u32x4*)(SABr + ((size_t)(r0 + s) * 2) * DM + c4 * 4); wrv[s] = *(const u32x4*)(SABr + ((size_t)(r0 + s) * 2 + 1) * DM + c4 * 4); zr[s] = *(const u32x2*)(Ur + (size_t)(r0 + s) * R_IN + DM + c4 * 4); }
            f32x4 hfv[16];
#pragma unroll
            for (int s = 0; s < 16; ++s) { const u32x4 w = wf[s];
                const f32x4 a = {__expf(bflo(w.x)), __expf(bflo(w.y)), __expf(bflo(w.z)), __expf(bflo(w.w))}, bb = {bfhi(w.x), bfhi(w.y), bfhi(w.z), bfhi(w.w)}; hf = a * hf + bb; hfv[s] = hf; }
#pragma unroll
            for (int s = 15; s >= 0; --s) { const u32x4 w = wrv[s];
                const f32x4 a = {__expf(bflo(w.x)), __expf(bflo(w.y)), __expf(bflo(w.z)), __expf(bflo(w.w))}, bb = {bfhi(w.x), bfhi(w.y), bfhi(w.z), bfhi(w.w)}; hr = a * hr + bb;
                const f32x4 y = hfv[s] + hr;
                u32x2 o; o.x = pk2(y.x * siluf_(bflo(zr[s].x)), y.y * siluf_(bfhi(zr[s].x))); o.y = pk2(y.z * siluf_(bflo(zr[s].y)), y.w * siluf_(bfhi(zr[s].y)));
                *(u32x2*)(Yr + (size_t)(r0 + s) * DM + c4 * 4) = o; }
        }
    }
    else {
        const float* gsrc = ap->in[I_NORMF];
        for (int r = gw; r < NB * SEQ; r += NGW) {
            const int b = r >> 11, t = r & (SEQ - 1); const size_t row = (size_t)b * TT + CTXL + t;
            const f32x4* xr = (const f32x4*)(X + row * DM) + lane; f32x4 v[8]; float s = 0.f;
#pragma unroll
            for (int j = 0; j < 8; ++j) { v[j] = xr[64 * j]; s += (v[j].x * v[j].x + v[j].y * v[j].y) + (v[j].z * v[j].z + v[j].w * v[j].w); }
            const float rstd = 1.0f / sqrtf(wave_sum(s) * (1.0f / DM) + EPS);
            f32x4* o = (f32x4*)(ap->out + (size_t)r * DM) + lane;
#pragma unroll
            for (int j = 0; j < 8; ++j) { const f32x4 g = *(const f32x4*)(gsrc + 4 * lane + 256 * j); o[64 * j] = (v[j] * rstd) * g; }
        }
    }
}

constexpr int N_PHASES_C = 19;
__global__ void __launch_bounds__(NWAVES * 64, 2) fwd_mega(Args args) {
    extern __shared__ __attribute__((aligned(16))) unsigned char lds[];
    LAS unsigned char* ldsl0 = (LAS unsigned char*)lds;
    for (int u = threadIdx.x; u < (LDS_BYTES - LDSCTL_OFF) / 4; u += NWAVES * 64) ((LAS unsigned*)(ldsl0 + LDSCTL_OFF))[u] = 0u;
    __syncthreads();
    { const int wv = __builtin_amdgcn_readfirstlane((int)threadIdx.x >> 6); if ((threadIdx.x & 63) == 0) ((volatile LAS unsigned*)(ldsl0 + LDSCTL_OFF))[hw_slot()] = (unsigned)wv;
      if (threadIdx.x == 0) ((volatile LAS unsigned*)(ldsl0 + MISC_OFF))[12] = blockIdx.x;
      if (!MK_PER_PHASE) (void)xcd_barrier_post((unsigned*)((gu32*)(args.ws + WS_CTL) + CW_BAR), (volatile LAS unsigned*)(ldsl0 + MISC_OFF) + 8, threadIdx.x == 0); }
    __syncthreads();
#define WAVE_IDX() ((int)__builtin_amdgcn_readfirstlane((int)((volatile LAS unsigned*)((LAS unsigned char*)lds + LDSCTL_OFF))[hw_slot()]))
#define KARG() ({ CArgsP ap_ = (CArgsP)__builtin_amdgcn_kernarg_segment_ptr(); asm volatile("" : "+s"(ap_)); ap_; })
#define GRID_BAR() do { CArgsP ap_ = KARG(); XcdBarrier b_; b_.bar = (unsigned*)((gu32*)(ap_->ws + WS_CTL) + CW_BAR); b_.x = xb_xcc_id(); b_.st = (volatile LAS unsigned*)((LAS unsigned char*)lds + MISC_OFF) + 8; xcd_barrier(b_, WAVE_IDX()); } while (0)
#if MK_PER_PHASE
#define PHASE(k, KIND, LAYER) if constexpr ((PH_MASK >> (k)) & 1) { CArgsP apq_ = KARG(); const int lo = apq_->ph_lo, hi = apq_->ph_hi; if (lo <= (k) && (k) < hi) { run_phase<KIND, LAYER, (k)>((char*)lds, WAVE_IDX()); } }
#else
#define PHASE(k, KIND, LAYER) if constexpr ((PH_MASK >> (k)) & 1) { run_phase<KIND, LAYER, (k)>((char*)lds, WAVE_IDX()); \
        if constexpr ((DUP_MASK >> (k)) & 1) { GRID_BAR(); run_phase<KIND, LAYER, 24 + ((k) & 7), true>((char*)lds, WAVE_IDX()); } \
        if constexpr ((k) + 1 < N_PHASES_C) { GRID_BAR(); if (DUP_BAR) GRID_BAR(); } }
#endif
    PHASE(0, K_PRO, 0) PHASE(1, K_MODRED, 0) PHASE(2, K_PRE0, 0)
    PHASE(3, K_GEMM_BF16, 0) PHASE(4, K_ATT_A, 0) PHASE(5, K_GEMM_RES, 0)
    PHASE(6, K_GEMM_BF16, 1) PHASE(7, K_ATT_B, 1) PHASE(8, K_COMBINE, 1) PHASE(9, K_GEMM_RES, 1)
    PHASE(10, K_GEMM_BF16, 2) PHASE(11, K_CONV, 2) PHASE(12, K_GEMM_GATES, 2) PHASE(13, K_SCAN_AGG, 2) PHASE(14, K_SCAN_APPLY, 2) PHASE(15, K_GEMM_RES, 2)
    PHASE(16, K_GEMM_BF16, 3) PHASE(17, K_ATT_A, 3) PHASE(18, K_GEMM_RES, 3)
#undef PHASE
#undef GRID_BAR
#undef KARG
#undef WAVE_IDX
}

constexpr int N_PHASES = N_PHASES_C;
extern "C" void kernel_launch(void* const* d_in, const int* in_sizes, int n_in, void* d_out, int out_size, void* d_ws, size_t ws_size, hipStream_t stream) {
    static int grid = 0;
    if (grid == 0) {
        if (n_in != 25 || in_sizes[0] != NB * SEQ * DM || out_size != NB * SEQ * DM || ws_size < WS_END) {
            fprintf(stderr, "kernel_launch: unexpected shapes: n_in %d in0 %d out %d ws %zu (need %zu)\n", n_in, n_in > 0 ? in_sizes[0] : -1, out_size, ws_size, (size_t)WS_END); grid = -1; return; }
        int dev = 0, cus = 0, per_cu = 0;
        if (hipGetDevice(&dev) != hipSuccess || hipDeviceGetAttribute(&cus, hipDeviceAttributeMultiprocessorCount, dev) != hipSuccess) { fprintf(stderr, "kernel_launch: device query failed\n"); grid = -1; return; }
        if (hipFuncSetAttribute((const void*)fwd_mega, hipFuncAttributeMaxDynamicSharedMemorySize, LDS_BYTES) != hipSuccess) { fprintf(stderr, "kernel_launch: hipFuncSetAttribute failed\n"); grid = -1; return; }
        if (hipOccupancyMaxActiveBlocksPerMultiprocessor(&per_cu, (const void*)fwd_mega, NWAVES * 64, LDS_BYTES) != hipSuccess || per_cu < 1) { fprintf(stderr, "kernel_launch: occupancy query says %d blocks/CU\n", per_cu); grid = -1; (void)hipGetLastError(); return; }
        if (cus != 256) { fprintf(stderr, "kernel_launch: built for a 256-CU device (MI355X), found %d CUs; nothing launched\n", cus); grid = -1; return; }
        grid = cus;
    }
    if (grid < 0) return;
    (void)hipMemsetAsync((char*)d_ws + WS_CTL, 0, CTL_ZERO_BYTES, stream);
    Args a{};
    for (int i = 0; i < 25; ++i) a.in[i] = (const float*)d_in[i];
    a.out = (float*)d_out; a.ws = (unsigned char*)d_ws;
#if MK_PER_PHASE
    for (int p = 0; p < N_PHASES; ++p) { a.ph_lo = p; a.ph_hi = p + 1; hipLaunchKernelGGL(fwd_mega, dim3(grid), dim3(NWAVES * 64), LDS_BYTES, stream, a); }
#else
    a.ph_lo = 0; a.ph_hi = N_PHASES;
    void* kargs[] = {&a};
    hipError_t e = hipLaunchCooperativeKernel((const void*)fwd_mega, dim3(grid), dim3(NWAVES * 64), kargs, LDS_BYTES, stream);
    if (e != hipSuccess) fprintf(stderr, "kernel_launch: cooperative launch failed: %s (grid %d)\n", hipGetErrorString(e), grid);
#endif
}
```

```cpp
#include <hip/hip_runtime.h>
#include <cstdio>
#include <cstdint>
#include <cmath>

#ifndef PH_MASK
#define PH_MASK 0x7ffff
#endif
#ifndef DUP_MASK
#define DUP_MASK 0
#endif
#ifndef DUP_SUB
#define DUP_SUB 0
#endif
#ifndef DUP_BAR
#define DUP_BAR 0
#endif
#ifndef TAIL_SPLIT
#define TAIL_SPLIT false
#endif
#ifndef MK_PER_PHASE
#define MK_PER_PHASE 0
#endif

constexpr int NB = 4, SEQ = 2048, CTXL = 256, DM = 2048, TT = SEQ + CTXL  , MROWS = NB * TT  ;
constexpr int A_IN = 5120, B_IN = 8192, R_IN = 4096;
constexpr float EPS = 1e-6f;
constexpr int CH = 32, NCH = TT / CH  , NCC = CTXL / CH  ;
constexpr float LAM_INIT1 = 0.35550906759096927f;

typedef unsigned short bf16_t;
typedef short bf16x8 __attribute__((ext_vector_type(8)));
typedef short s16x4 __attribute__((ext_vector_type(4)));
typedef float f32x4 __attribute__((ext_vector_type(4)));
typedef float f32x8 __attribute__((ext_vector_type(8)));
typedef float f32x16 __attribute__((ext_vector_type(16)));
typedef unsigned u32x4 __attribute__((ext_vector_type(4)));
typedef unsigned u32x2 __attribute__((ext_vector_type(2)));
#define LAS __attribute__((address_space(3)))
#define GAS __attribute__((address_space(1)))

__device__ __forceinline__ unsigned pk2(float lo, float hi) { unsigned r; asm("v_cvt_pk_bf16_f32 %0, %1, %2" : "=v"(r) : "v"(lo), "v"(hi)); return r; }
__device__ __forceinline__ unsigned f2bf(float f) { return pk2(f, 0.f) & 0xffffu; }
__device__ __forceinline__ float bflo(unsigned w) { return __uint_as_float(w << 16); }
__device__ __forceinline__ float bfhi(unsigned w) { return __uint_as_float(w & 0xffff0000u); }
__device__ __forceinline__ float bf1(bf16_t v) { return __uint_as_float((unsigned)v << 16); }
__device__ __forceinline__ unsigned cvt_pk_bf16(float lo, float hi) { unsigned r; asm volatile("v_cvt_pk_bf16_f32 %0, %1, %2" : "=v"(r) : "v"(lo), "v"(hi)); return r; }
__device__ __forceinline__ float frcp(float x) { return __builtin_amdgcn_rcpf(x); }
__device__ __forceinline__ float frsq(float x) { return __builtin_amdgcn_rsqf(x); }
__device__ __forceinline__ float fsqrt_(float x) { return __builtin_amdgcn_sqrtf(x); }
__device__ __forceinline__ float sigmoidf_(float x) { return frcp(1.0f + __expf(-x)); }
__device__ __forceinline__ float siluf_(float x) { return x * frcp(1.0f + __expf(-x)); }
template <int M> __device__ __forceinline__ float shx(float v) { return __int_as_float(__builtin_amdgcn_ds_swizzle(__float_as_int(v), (M << 10) | 0x1f)); }
__device__ __forceinline__ float wave_sum(float v) {
    v += shx<1>(v); v += shx<2>(v); v += shx<4>(v); v += shx<8>(v); v += shx<16>(v);
    auto rr = __builtin_amdgcn_permlane32_swap(__float_as_uint(v), __float_as_uint(v), false, false);
    return __uint_as_float(rr[0]) + __uint_as_float(rr[1]);
}

constexpr size_t MiB = 1u << 20;
constexpr size_t WS_CTL = 0, WS_MODS = 1 * MiB, CTL_ZERO_BYTES = 2 * MiB;
constexpr size_t WS_GM = 2 * MiB + 128 * 1024;
constexpr size_t WS_SHW = 2 * MiB + 512 * 1024;
constexpr size_t WS_SSQ = 282 * MiB;
constexpr size_t WS_FSQ = 281 * MiB;
constexpr size_t WS_SHWP = 568 * MiB;
constexpr size_t WS_TAB = 2 * MiB;
constexpr size_t WS_WA_IN = 4 * MiB, WS_WA_OUT = 44 * MiB, WS_WB_IN = 60 * MiB, WS_WB_OUT = 92 * MiB, WS_WR_IN = 100 * MiB, WS_WR_OUT = 116 * MiB, WS_WG = 124 * MiB;
constexpr size_t WS_X = 128 * MiB;
constexpr size_t WS_H = 200 * MiB;
constexpr size_t WS_Y = 236 * MiB;
constexpr size_t WS_AGG = 272 * MiB;
constexpr size_t WS_U = 284 * MiB;
constexpr size_t WS_OD = 428 * MiB;
constexpr size_t WS_UP = 356 * MiB;
constexpr size_t WS_SA = 392 * MiB;
constexpr size_t WS_AG16 = 536 * MiB;
constexpr size_t WS_CARRY = 556 * MiB;
constexpr size_t WS_SLAB = 568 * MiB;
constexpr size_t WS_DUMMY = 632 * MiB;
constexpr size_t WS_END = 584 * MiB;
constexpr int CW_BAR = 4096, CW_SEAM = 16384;

struct Args { const float* in[25]; float* out; unsigned char* ws; int ph_lo, ph_hi; };
typedef const __attribute__((address_space(4))) Args* CArgsP;
enum { I_X = 0, I_C, I_CTX, I_CCTX, I_ADAW, I_ADAB, I_NORMG, I_NORMF, I_AWIN, I_AQG, I_AKG, I_AWOUT, I_BWIN, I_BLAM, I_BSUBG, I_BWOUT,
       I_RWIN, I_RCONVW, I_RCONVB, I_RWA, I_RBA, I_RWX, I_RBX, I_RLAM, I_RWOUT };


__host__ __device__ __forceinline__ int qk_pi(int c) { return (c & 64) | (((c >> 2) & 1) << 5) | (((c >> 3) & 7) << 2) | (c & 3); }
__host__ __device__ __forceinline__ int qk_pi_inv(int e) { return (e & 64) | (((e >> 2) & 7) << 3) | (((e >> 5) & 1) << 2) | (e & 3); }

namespace pg8 {
constexpr int BM = 256, BK = 64, HALF = 128, HTB = HALF * BK * 2, STAGE_BYTES = 8 * HTB, NXCD = 8, WGM = 8;
__host__ __device__ __forceinline__ int lds_byte(int r, int c) { const int st = (r >> 4) * 2 + (c >> 5), rr = r & 15, cc = c & 31, ob = rr * 64 + cc * 2; return st * 1024 + (ob ^ (((ob >> 9) & 1) << 5)); }
__host__ __device__ __forceinline__ void stage_rc(int b, int& R, int& C) { const int st = b / 1024, sb = b % 1024, swz = sb ^ (((sb >> 9) & 1) << 5); R = (st >> 1) * 16 + swz / 64; C = (st & 1) * 32 + (swz % 64) / 2; }
__host__ __device__ __forceinline__ int perm32(int rho) { const int n = rho >> 4, i = rho & 15; return 8 * (i >> 2) + 4 * n + (i & 3); }

struct Unit { int pm, pn, acol, kofs, nt, kind; };

constexpr int GRID = 256;
template <int NM, int NN, int KT, int ROWMODE, int GATES, bool SPLIT> struct Sched {
    static constexpr int nM = NM, nN = NN, nwg = NM * NN, G = GRID, R = nwg / G, T = nwg - R * G;
    static constexpr int F0 = (!SPLIT || T == 0 || R == 0) ? 1 : (G / T >= 8 ? 8 : G / T >= 4 ? 4 : G / T >= 2 ? 2 : 1);
    static constexpr int F = (KT / F0 >= 4) ? F0 : (KT / (F0 / 2 > 0 ? F0 / 2 : 1) >= 4 ? (F0 / 2 > 0 ? F0 / 2 : 1) : 1);
    int c, v;
    __device__ void init(int c_, int v_) { c = c_; v = v_; }
    __device__ bool is_slice(int i) const { return F > 1 && i == R; }
    __device__ bool next(int i, Unit& u) const {
        long L; u.kofs = 0; u.nt = KT; u.kind = 0;
        if (GATES && T > 0 && 2 * T <= G && i == R) { if (c >= 2 * T) return false; L = (long)R * G + (c >> 1); u.kind = 1 + (c & 1); }
        else
        if (i < R) L = (long)i * G + c;
        else if (i == R && T > 0) { if (F == 1) { L = (long)R * G + c; if (L >= nwg) return false; } else { if (v >= T * F) return false; const int tt = v / F, sj = v - tt * F; u.nt = KT / F; u.kofs = sj * u.nt * BK; L = (long)R * G + tt; } }
        else return false;
        int wgid = (int)L; { const int q = nwg / NXCD, r = nwg % NXCD, xcd = wgid % NXCD, off = wgid / NXCD; wgid = (xcd < r ? xcd * (q + 1) : r * (q + 1) + (xcd - r) * q) + off; }
        const int nig = WGM * nN, gid = wgid / nig, fm = gid * WGM, gsz = (nM - fm) < WGM ? (nM - fm) : WGM;
        int pm = fm + ((wgid % nig) % gsz); u.pn = (wgid % nig) / gsz;
        if (ROWMODE == 1) pm = 9 * (pm >> 3) + 1 + (pm & 7);
        u.pm = pm; u.acol = GATES ? 256 * (u.pn >> 2) : 0; return true;
    }
};

template <int NN, int KT, int CLO, int CHI> struct SchedM {
    static constexpr int G = GRID, NLAT = 32 * NN, NCX = 4 * (CHI - CLO), TOT = 32 + NLAT + NCX, R = TOT / G, T = TOT - R * G, F = 1;
    static constexpr int SH = (T > 0 && T + 32 <= G) ? 32 : 0;
    int c;
    __device__ void init(int c_, int) { c = c_; }
    __device__ bool is_slice(int) const { return false; }
    __device__ bool next(int i, Unit& u) const {
        int L = i * G + c; if (i == R && T > 0) { const int cc = c - SH; if (cc < 0 || cc >= T) return false; L = R * G + cc; }
        if (L >= TOT) return false; u.kofs = 0; u.nt = KT; u.acol = 0;
        if (L < 32) { u.kind = 0; u.pm = 9 * (L >> 3); u.pn = L & 7; return true; }
        if (L < 32 + NLAT) { u.kind = 1; constexpr int nwg = NLAT; int wgid = L - 32; { constexpr int q = nwg / NXCD; const int xcd = wgid % NXCD, off = wgid / NXCD; wgid = xcd * q + off; }
            constexpr int nig = WGM * NN; const int gid = wgid / nig, fm = gid * WGM; const int pmi = fm + ((wgid % nig) % WGM); u.pn = (wgid % nig) / WGM; u.pm = 9 * (pmi >> 3) + 1 + (pmi & 7); return true; }
        const int r = L - 32 - NLAT; u.kind = 2; u.pm = 9 * (r / (CHI - CLO)); u.pn = CLO + r % (CHI - CLO); return true;
    }
};

__device__ __forceinline__ int opq(int x) { asm volatile("" : "+s"(x)); return x; }
constexpr int RSTD_OFF = 131072;
constexpr int SHWT_OFF = 147456;
constexpr int HSQ_OFF = 139264;
template <int LAYER, int N> struct EpiBf16 {
    unsigned char* ws; CArgsP ap;
    static constexpr int QKT = (LAYER == 1) ? 16 : (LAYER == 2) ? 0 : 10; static constexpr bool RMS = (LAYER != 1);
    template <class SchedT> __device__ __forceinline__ void prep(LAS unsigned char* lds, const SchedT& S, int tid) const {
        const float* ssq = (const float*)(ws + WS_SSQ); Unit u;
        for (int i = 0; i < 8 && S.next(i, u); ++i) if (tid < 256) { const f32x4* p4 = (const f32x4*)(ssq + (size_t)(u.pm * BM + tid) * 32); float s = 0.f;
#pragma unroll
            for (int j = 0; j < 8; ++j) { const f32x4 v = p4[j]; s += (v.x + v.y) + (v.z + v.w); }
            ((LAS float*)(lds + opq(RSTD_OFF)))[i * 256 + tid] = frsq(s * (1.0f / DM) + EPS); }
        else { const int t2 = tid - 256; const int bq = u.pm / 9, mr = (u.pm - 9 * bq) == 0 ? 4 : bq; float sv;
            sv = ((const float*)(ws + WS_SHW))[(size_t)(LAYER * 5 + mr) * 8192 + u.pn * BM + t2];
            ((LAS float*)(lds + opq(SHWT_OFF)))[i * 256 + t2] = sv; }
    }
    __device__ __forceinline__ void operator()(f32x4 (&acc)[2][2][4][2], const Unit& u, int ui, LAS unsigned char* lds, int wr, int wc, int tl_, unsigned gmask) const {
        unsigned char* w_ = ws; asm volatile("" : "+v"(tl_), "+s"(w_)); const int lane = tl_ & 63, fr = lane & 15, fq = lane >> 4;
        const int bq = u.pm / 9, pr_ = u.pm - 9 * bq, isctx = pr_ == 0;
        bf16_t* O = (bf16_t*)(w_ + WS_U);
        const int rl0 = wr * 64 + fr, row0 = u.pm * BM + rl0, col0 = u.pn * BM + wc * 32 + 8 * fq;
        const LAS float* rt = (const LAS float*)(lds + opq(RSTD_OFF)) + ui * 256 + rl0;
        f32x4 sv[2][2];
#pragma unroll
        for (int bj = 0; bj < 2; ++bj)
#pragma unroll
            for (int n = 0; n < 2; ++n) sv[bj][n] = *(const LAS f32x4*)((const LAS float*)(lds + opq(SHWT_OFF)) + ui * 256 + wc * 32 + 8 * fq + bj * HALF + 4 * n);
        if (QKT == 0 || u.pn >= QKT) {
#pragma unroll
            for (int ai = 0; ai < 2; ++ai)
#pragma unroll
                for (int m = 0; m < 4; ++m) { if (!((gmask >> (ai * 4 + m)) & 1u)) continue; bf16_t* rowp = O + (size_t)(row0 + ai * HALF + m * 16) * N + col0; const float rs = rt[ai * HALF + m * 16];
#pragma unroll
                    for (int bj = 0; bj < 2; ++bj) { const f32x4 v0 = acc[ai][bj][m][0] * rs + sv[bj][0], v1 = acc[ai][bj][m][1] * rs + sv[bj][1];
                        u32x4 w; w.x = cvt_pk_bf16(v0[0], v0[1]); w.y = cvt_pk_bf16(v0[2], v0[3]); w.z = cvt_pk_bf16(v1[0], v1[1]); w.w = cvt_pk_bf16(v1[2], v1[3]);
                        *(u32x4*)(rowp + bj * HALF) = w; } }
            return;
        }
        LAS float* hs = (LAS float*)(lds + opq(HSQ_OFF));
        if constexpr (RMS) {
#pragma unroll
            for (int ai = 0; ai < 2; ++ai)
#pragma unroll
                for (int m = 0; m < 4; ++m) { const int rl = rl0 + ai * HALF + m * 16; const float rs = rt[ai * HALF + m * 16];
#pragma unroll
                    for (int bj = 0; bj < 2; ++bj) { const f32x4 v0 = acc[ai][bj][m][0] * rs + sv[bj][0], v1 = acc[ai][bj][m][1] * rs + sv[bj][1];
                        float q = ((v0[0] * v0[0] + v0[1] * v0[1]) + (v0[2] * v0[2] + v0[3] * v0[3])) + ((v1[0] * v1[0] + v1[1] * v1[1]) + (v1[2] * v1[2] + v1[3] * v1[3]));
                        q += shx<16>(q); { auto rr = __builtin_amdgcn_permlane32_swap(__float_as_uint(q), __float_as_uint(q), false, false); q = __uint_as_float(rr[0]) + __uint_as_float(rr[1]); }
                        if (fq == 0) hs[rl * 8 + bj * 4 + wc] = q; } }
            asm volatile("s_waitcnt lgkmcnt(0)" ::: "memory"); __builtin_amdgcn_s_barrier(); asm volatile("" ::: "memory");
        }
        const int i16 = 4 * (wc & 1) + fq, hf = wc >> 1;
        f32x4 g0 = {1.f, 1.f, 1.f, 1.f}, g1 = g0;
        if constexpr (RMS) { const float* gg = ((u.pn < 8) ? ap->in[I_AQG] : ap->in[I_AKG]) + (LAYER == 3 ? 128 : 0) + 64 * hf + 4 * i16; g0 = *(const f32x4*)gg; g1 = *(const f32x4*)(gg + 32); }
        const float* tc = (const float*)(w_ + WS_TAB) + 4 * i16; const float* ts = tc + 96 * 32;
#pragma unroll
        for (int ai = 0; ai < 2; ++ai)
#pragma unroll
            for (int m = 0; m < 4; ++m) { if (!((gmask >> (ai * 4 + m)) & 1u)) continue; const int rl = rl0 + ai * HALF + m * 16; const float rs = rt[ai * HALF + m * 16];
                bf16_t* rowp = O + (size_t)(u.pm * BM + rl) * N + col0;
                f32x4 cs = {1.f, 1.f, 1.f, 1.f}, sn = {0.f, 0.f, 0.f, 0.f};
                if (!isctx) { const int tl = (pr_ - 1) * 256 + rl; const int pos = hf ? 32 + (tl & 63) : (tl >> 6); cs = *(const f32x4*)(tc + pos * 32); sn = *(const f32x4*)(ts + pos * 32); }
#pragma unroll
                for (int bj = 0; bj < 2; ++bj) { f32x4 x1 = acc[ai][bj][m][0] * rs + sv[bj][0], x2 = acc[ai][bj][m][1] * rs + sv[bj][1];
                    if constexpr (RMS) { const f32x4 pq = *(const LAS f32x4*)(hs + rl * 8 + bj * 4); const float rh = frsq(((pq[0] + pq[1]) + (pq[2] + pq[3])) * (1.0f / 128.0f) + EPS); x1 = x1 * rh * g0; x2 = x2 * rh * g1; }
                    const f32x4 y1 = x1 * cs - x2 * sn, y2 = x1 * sn + x2 * cs;
                    u32x4 w; w.x = cvt_pk_bf16(y1[0], y1[1]); w.y = cvt_pk_bf16(y1[2], y1[3]); w.z = cvt_pk_bf16(y2[0], y2[1]); w.w = cvt_pk_bf16(y2[2], y2[3]);
                    *(u32x4*)(rowp + bj * HALF) = w; } }
    }
};
template <int LAYER, bool DUP> struct EpiResid {
    unsigned char* ws; CArgsP ap;
    static constexpr bool NEXT = LAYER < 3;
    template <class SchedT> __device__ __forceinline__ void prep(LAS unsigned char*, const SchedT&, int) const {}
    __device__ __forceinline__ void operator()(f32x4 (&acc)[2][2][4][2], const Unit& u, int, LAS unsigned char* lds, int wr, int wc, int tl_, unsigned gmask) const {
        unsigned char* w_ = ws; asm volatile("" : "+v"(tl_), "+s"(w_)); const int lane = tl_ & 63, fr = lane & 15, fq = lane >> 4;
        const int bq = u.pm / 9, pr_ = u.pm - 9 * bq, isctx = pr_ == 0, mr = isctx ? 4 : bq;
        if constexpr (LAYER == 3 && !DUP) {
            const float* gt = (const float*)(w_ + WS_MODS) + (size_t)(LAYER * 5 + mr) * 6144 + 4096;
            const bf16_t* xbin = (const bf16_t*)(w_ + WS_X) + (size_t)u.pm * BM * DM;
            const int rl0 = wr * 64 + fr, col0 = u.pn * BM + wc * 32 + 8 * fq, lrow0 = bq * SEQ + (pr_ - 1) * 256;
            float* fsq = (float*)(w_ + WS_FSQ);
            f32x4 gv[2][2];
#pragma unroll
            for (int bj = 0; bj < 2; ++bj)
#pragma unroll
                for (int n = 0; n < 2; ++n) gv[bj][n] = *(const f32x4*)(gt + col0 + bj * HALF + 4 * n);
#pragma unroll
            for (int ai = 0; ai < 2; ++ai)
#pragma unroll
                for (int m = 0; m < 4; ++m) { const int rl = rl0 + ai * HALF + m * 16; const unsigned ro = (unsigned)(rl * DM + col0) * 4u; float sq = 0.f;
#pragma unroll
                    for (int bj = 0; bj < 2; ++bj) { const u32x4 bw = *(const u32x4*)((const char*)xbin + (ro >> 1) + bj * HALF * 2);
                        const f32x4 bs[2] = {(f32x4){bflo(bw.x), bfhi(bw.x), bflo(bw.y), bfhi(bw.y)}, (f32x4){bflo(bw.z), bfhi(bw.z), bflo(bw.w), bfhi(bw.w)}};
#pragma unroll
                        for (int n = 0; n < 2; ++n) { const f32x4 xn = bs[n] + gv[bj][n] * acc[ai][bj][m][n]; acc[ai][bj][m][n] = xn;
                            sq += (xn[0] * xn[0] + xn[1] * xn[1]) + (xn[2] * xn[2] + xn[3] * xn[3]); } }
                    sq += shx<16>(sq); { auto rr = __builtin_amdgcn_permlane32_swap(__float_as_uint(sq), __float_as_uint(sq), false, false); sq = __uint_as_float(rr[0]) + __uint_as_float(rr[1]); }
                    if (fq == 0) __hip_atomic_store(fsq + (size_t)(lrow0 + rl) * 32 + u.pn * 4 + wc, sq, __ATOMIC_RELAXED, __HIP_MEMORY_SCOPE_AGENT);
                    if (m & 1) asm volatile("" ::: "memory"); }
            asm volatile("s_waitcnt vmcnt(0)" ::: "memory"); __builtin_amdgcn_s_barrier(); asm volatile("" ::: "memory");
            const int tid = (wr * 4 + wc) * 64 + lane; const int panel = bq * 8 + pr_ - 1;
            if (tid == 0) { unsigned* cw = (unsigned*)(w_ + WS_CTL) + CW_SEAM + panel * 16;
                __hip_atomic_fetch_add(cw, 1u, __ATOMIC_RELAXED, __HIP_MEMORY_SCOPE_AGENT);
                unsigned sp = 0; while (__hip_atomic_load(cw, __ATOMIC_RELAXED, __HIP_MEMORY_SCOPE_AGENT) < 8u) { __builtin_amdgcn_s_sleep(1); if (++sp > (1u << 22)) break; }
                __builtin_amdgcn_fence(__ATOMIC_ACQUIRE, "agent"); asm volatile("s_waitcnt vmcnt(0)" ::: "memory"); }
            asm volatile("" ::: "memory"); __builtin_amdgcn_s_barrier(); asm volatile("" ::: "memory");
            LAS float* rt = (LAS float*)(lds + opq(HSQ_OFF));
            if (tid < 256) { const f32x4* p4 = (const f32x4*)(fsq + (size_t)(lrow0 + tid) * 32); float sa = 0.f;
#pragma unroll
                for (int j = 0; j < 8; ++j) { const f32x4 v = p4[j]; sa += (v.x + v.y) + (v.z + v.w); }
                rt[tid] = frsq(sa * (1.0f / DM) + EPS); }
            asm volatile("s_waitcnt lgkmcnt(0)" ::: "memory"); __builtin_amdgcn_s_barrier(); asm volatile("" ::: "memory");
            const float* nf = ap->in[I_NORMF] + col0; float* outp = ap->out + (size_t)lrow0 * DM;
#pragma unroll
            for (int bj = 0; bj < 2; ++bj)
#pragma unroll
                for (int n = 0; n < 2; ++n) gv[bj][n] = *(const f32x4*)(nf + bj * HALF + 4 * n);
#pragma unroll
            for (int ai = 0; ai < 2; ++ai)
#pragma unroll
                for (int m = 0; m < 4; ++m) { const int rl = rl0 + ai * HALF + m * 16; const float rs = rt[rl]; const unsigned ro = (unsigned)(rl * DM + col0) * 4u;
#pragma unroll
                    for (int bj = 0; bj < 2; ++bj)
#pragma unroll
                        for (int n = 0; n < 2; ++n) *(f32x4*)((char*)outp + ro + (bj * HALF + 4 * n) * 4) = acc[ai][bj][m][n] * rs * gv[bj][n]; }
            return;
        }
        const float* gt = (const float*)(w_ + WS_MODS) + (size_t)(LAYER * 5 + mr) * 6144 + 4096;
        const float* gmN = (const float*)(w_ + WS_GM) + (size_t)((LAYER + 1) * 5 + mr) * DM;
        const float* basep = (LAYER == 0) ? (isctx ? ap->in[I_CTX] + (size_t)(bq * CTXL) * DM : ap->in[I_X] + (size_t)(bq * SEQ + (pr_ - 1) * 256) * DM) : nullptr;
        const bf16_t* xbin = (const bf16_t*)(w_ + WS_X) + (size_t)u.pm * BM * DM;
        bf16_t* outp = (bf16_t*)(w_ + (DUP ? WS_DUMMY : WS_X)) + (size_t)u.pm * BM * DM; bf16_t* hp = (bf16_t*)(w_ + (DUP ? WS_DUMMY + 72 * MiB : WS_H)) + (size_t)u.pm * BM * DM;
        float* ssq = (float*)(w_ + (DUP ? WS_DUMMY + 108 * MiB : WS_SSQ));
        const int rl0 = wr * 64 + fr, col0 = u.pn * BM + wc * 32 + 8 * fq;
        f32x4 gv[2][2], mv[2][2];
#pragma unroll
        for (int bj = 0; bj < 2; ++bj)
#pragma unroll
            for (int n = 0; n < 2; ++n) { gv[bj][n] = *(const f32x4*)(gt + col0 + bj * HALF + 4 * n); if (NEXT) mv[bj][n] = *(const f32x4*)(gmN + col0 + bj * HALF + 4 * n); }
#pragma unroll
        for (int ai = 0; ai < 2; ++ai)
#pragma unroll
            for (int m = 0; m < 4; ++m) { if (!((gmask >> (ai * 4 + m)) & 1u)) continue; const int rl = rl0 + ai * HALF + m * 16; const unsigned ro = (unsigned)(rl * DM + col0) * 4u; float sq = 0.f;
#pragma unroll
                for (int bj = 0; bj < 2; ++bj) { f32x4 xn[2], bs[2];
                    if constexpr (LAYER == 0) { bs[0] = *(const f32x4*)((const char*)basep + ro + bj * HALF * 4); bs[1] = *(const f32x4*)((const char*)basep + ro + bj * HALF * 4 + 16); }
                    else { const u32x4 bw = *(const u32x4*)((const char*)xbin + (ro >> 1) + bj * HALF * 2); bs[0] = (f32x4){bflo(bw.x), bfhi(bw.x), bflo(bw.y), bfhi(bw.y)}; bs[1] = (f32x4){bflo(bw.z), bfhi(bw.z), bflo(bw.w), bfhi(bw.w)}; }
#pragma unroll
                    for (int n = 0; n < 2; ++n) { xn[n] = bs[n] + gv[bj][n] * acc[ai][bj][m][n];
                        if (NEXT) sq += (xn[n][0] * xn[n][0] + xn[n][1] * xn[n][1]) + (xn[n][2] * xn[n][2] + xn[n][3] * xn[n][3]); }
                    { u32x4 xw; xw.x = cvt_pk_bf16(xn[0][0], xn[0][1]); xw.y = cvt_pk_bf16(xn[0][2], xn[0][3]); xw.z = cvt_pk_bf16(xn[1][0], xn[1][1]); xw.w = cvt_pk_bf16(xn[1][2], xn[1][3]);
                        *(u32x4*)((char*)outp + (ro >> 1) + bj * HALF * 2) = xw; }
                    if (NEXT) { const f32x4 h0 = xn[0] * mv[bj][0], h1 = xn[1] * mv[bj][1]; u32x4 w; w.x = cvt_pk_bf16(h0[0], h0[1]); w.y = cvt_pk_bf16(h0[2], h0[3]); w.z = cvt_pk_bf16(h1[0], h1[1]); w.w = cvt_pk_bf16(h1[2], h1[3]);
                        *(u32x4*)((char*)hp + (ro >> 1) + bj * HALF * 2) = w; } }
                if (NEXT) { sq += shx<16>(sq); { auto rr = __builtin_amdgcn_permlane32_swap(__float_as_uint(sq), __float_as_uint(sq), false, false); sq = __uint_as_float(rr[0]) + __uint_as_float(rr[1]); }
                    if (fq == 0) ssq[(size_t)(u.pm * BM + rl) * 32 + u.pn * 4 + wc] = sq; }
                if (m & 1) asm volatile("" ::: "memory"); }
    }
};
template <int CTRL> __device__ __forceinline__ float dpp_f(float oldv, float src) { return __int_as_float(__builtin_amdgcn_update_dpp(__float_as_int(oldv), __float_as_int(src), CTRL, 0xf, 0xf, false)); }
struct EpiGates {
    unsigned char* ws; CArgsP ap;
    template <class SchedT> __device__ __forceinline__ void prep(LAS unsigned char*, const SchedT&, int) const {}
    __device__ __forceinline__ void operator()(f32x4 (&acc)[2][2][4][2], const Unit& u, int, LAS unsigned char*, int wr, int wc, int tl_, unsigned gmask) const {
        unsigned char* w_ = ws; asm volatile("" : "+v"(tl_), "+s"(w_)); const int lane = tl_ & 63, fr = lane & 15, fq = lane >> 4;
        const bf16_t* UP = (const bf16_t*)(w_ + WS_UP); const float* ba = ap->in[I_RBA]; const float* bx = ap->in[I_RBX]; const float* c8 = (const float*)(w_ + WS_TAB + 65536);
        unsigned* AB = (unsigned*)(w_ + WS_SA); float* AGA = (float*)(w_ + WS_AG16); float* AGB = AGA + (size_t)576 * 2 * DM;
        const int nblk = u.pn >> 2, dir = (u.pn >> 1) & 1, jt = u.pn & 1;
        const int row0 = u.pm * BM + wr * 64 + fr, chb = nblk * 256 + jt * 128 + 16 * wc + 4 * fq;
#pragma unroll
        for (int bj = 0; bj < 2; ++bj) { if (u.kind != 0 && u.kind - 1 != bj) continue; const int ch = chb + 64 * bj;
            const f32x4 bav = *(const f32x4*)(ba + dir * DM + ch), bxv = *(const f32x4*)(bx + dir * DM + ch), cv = *(const f32x4*)(c8 + dir * DM + ch);
#pragma unroll
            for (int ai = 0; ai < 2; ++ai)
#pragma unroll
                for (int m = 0; m < 4; ++m) { if (!((gmask >> (ai * 4 + m)) & 1u)) continue; const int row = row0 + ai * HALF + m * 16;
                    const u32x2 upw = *(const u32x2*)((const char*)UP + (unsigned)(row * DM + ch) * 2u);
                    const float up[4] = {bflo(upw.x), bfhi(upw.x), bflo(upw.y), bfhi(upw.y)};
                    const f32x4 pr = acc[ai][bj][m][0] + bav, pi = acc[ai][bj][m][1] + bxv; u32x4 w; f32x4 A, Bv;
#pragma unroll
                    for (int j = 0; j < 4; ++j) { const float r = sigmoidf_(pr[j]), ig = sigmoidf_(pi[j]); const float la = -r * cv[j]; const float a = __expf(la);
                        const float om = fmaf(-a, a, 1.0f);
                        w[j] = cvt_pk_bf16(la, fsqrt_(om) * (ig * up[j]));
                        A[j] = __expf(bflo(w[j])); Bv[j] = bfhi(w[j]); }
                    *(u32x4*)((char*)AB + (unsigned)((row * 2 + dir) * DM + ch) * 4u) = w;
#define GSTEP(CT) asm volatile("s_nop 1\n\tv_fmac_f32_dpp %0, %0, %4 " CT " row_mask:0xf bank_mask:0xf\n\tv_fmac_f32_dpp %1, %1, %5 " CT " row_mask:0xf bank_mask:0xf\n\tv_fmac_f32_dpp %2, %2, %6 " CT " row_mask:0xf bank_mask:0xf\n\tv_fmac_f32_dpp %3, %3, %7 " CT " row_mask:0xf bank_mask:0xf\n\t" \
                                   "v_mul_f32_dpp %4, %4, %4 " CT " row_mask:0xf bank_mask:0xf\n\tv_mul_f32_dpp %5, %5, %5 " CT " row_mask:0xf bank_mask:0xf\n\tv_mul_f32_dpp %6, %6, %6 " CT " row_mask:0xf bank_mask:0xf\n\tv_mul_f32_dpp %7, %7, %7 " CT " row_mask:0xf bank_mask:0xf" \
                                   : "+v"(Bv[0]), "+v"(Bv[1]), "+v"(Bv[2]), "+v"(Bv[3]), "+v"(A[0]), "+v"(A[1]), "+v"(A[2]), "+v"(A[3]));
                    if (dir == 0) { GSTEP("row_shr:1") GSTEP("row_shr:2") GSTEP("row_shr:4") GSTEP("row_shr:8") } else { GSTEP("row_shl:1") GSTEP("row_shl:2") GSTEP("row_shl:4") GSTEP("row_shl:8") }
#undef GSTEP
                    if (fr == (dir ? 0 : 15)) { const unsigned ao = (unsigned)((((u.pm * 16 + ai * 8 + wr * 4 + m) * 2 + dir) * DM + ch) * 4u); *(f32x4*)((char*)AGA + ao) = A; *(f32x4*)((char*)AGB + ao) = Bv; }
                    asm volatile("" ::: "memory"); __builtin_amdgcn_sched_barrier(0); } }
    }
};

struct NoEpi { unsigned char* ws; template <class SchedT> __device__ __forceinline__ void prep(LAS unsigned char*, const SchedT&, int) const {}
    __device__ __forceinline__ void operator()(f32x4 (&)[2][2][4][2], const Unit&, int, LAS unsigned char*, int, int, int, unsigned) const {} };
template <class Epi, class SchedT, int KT, int BANK, size_t OA, size_t OB, class Epi0 = NoEpi, size_t OA0 = 0, size_t OB0 = 0>
__device__ __forceinline__ void gemm_phase(LAS unsigned char* lds, const int tid, const SchedT& S, const Epi& E, const Epi0& E0 = Epi0{}) {
    constexpr bool MERGED = !__is_same(Epi0, NoEpi);
    constexpr bool SP2 = true, ALIGN_EPI = true;
    const int wid = __builtin_amdgcn_readfirstlane(tid >> 6), lane = tid & 63, wr = wid >> 2, wc = wid & 3, fr = lane & 15, fq = lane >> 4;
    constexpr int K = KT * BK, lda = DM;
    unsigned voffA[2], voffB[2];
#pragma unroll
    for (int i = 0; i < 2; ++i) { int R, C; stage_rc(tid * 16 + i * 8192, R, C); const int Rb = (R & ~31) + perm32(R & 31);
        voffA[i] = (unsigned)(R * lda + C) * 2u; voffB[i] = (unsigned)(Rb * K + C) * 2u; }
    constexpr unsigned kstep = (unsigned)(BK * 2);
    constexpr unsigned hstepA = (unsigned)HALF * lda * 2, hstepB = (unsigned)HALF * K * 2;
    constexpr unsigned tstepA = 2 * hstepA, tstepB = 2 * hstepB;
    const unsigned ldsw = (unsigned)wid * 1024u;
    const int aoff = lds_byte(wr * 64 + fr, fq * 8), boff = lds_byte(wc * 32 + fr, fq * 8);
#define PG8_SA(b, h) (((b) * 2 + (h)) * HTB)
#define PG8_SB(b, h) ((4 + (b) * 2 + (h)) * HTB)
#define PG8_STAGE(bufoff, goff, voff) do { _Pragma("unroll") for (int _i = 0; _i < 2; ++_i) \
        __builtin_amdgcn_global_load_lds((const unsigned*)((const char*)E.ws + (unsigned)((goff) + (voff)[_i])), (LAS unsigned*)(lds + (bufoff) + ldsw + _i * 8192), 16, 0, 0); } while (0)
#define PG8_LDA(dst, b, h) do { _Pragma("unroll") for (int m = 0; m < 4; ++m) _Pragma("unroll") for (int k = 0; k < 2; ++k) dst[m][k] = *(const LAS bf16x8*)(lds + PG8_SA(b, h) + aoff + m * 2048 + k * 1024); } while (0)
#define PG8_LDB(dst, b, h) do { _Pragma("unroll") for (int n = 0; n < 2; ++n) _Pragma("unroll") for (int k = 0; k < 2; ++k) dst[n][k] = *(const LAS bf16x8*)(lds + PG8_SB(b, h) + boff + n * 2048 + k * 1024); } while (0)
#define PG8_MMA(ai, bj, At, Bt) do { __builtin_amdgcn_s_setprio(1); _Pragma("unroll") for (int m = 0; m < 4; ++m) _Pragma("unroll") for (int n = 0; n < 2; ++n) _Pragma("unroll") for (int k = 0; k < 2; ++k) \
        acc[ai][bj][m][n] = __builtin_amdgcn_mfma_f32_16x16x32_bf16(Bt[n][k], At[m][k], acc[ai][bj][m][n], 0, 0, 0); __builtin_amdgcn_s_setprio(0); } while (0)
#define PG8_WAIT_V(n) asm volatile("s_waitcnt vmcnt(" #n ")" ::: "memory")
#define PG8_WAIT_L(n) asm volatile("s_waitcnt lgkmcnt(" #n ")" ::: "memory")
#define PG8_BAR __builtin_amdgcn_s_barrier()
#define PG8_SCHED __builtin_amdgcn_sched_barrier(0)
    Unit cur, nxt; int ui = 0;
    if (!S.next(0, cur)) return;
    E.prep(lds, S, tid); __syncthreads();
    f32x4 acc[2][2][4][2];
#pragma unroll
    for (int a = 0; a < 2; ++a)
#pragma unroll
        for (int b = 0; b < 2; ++b)
#pragma unroll
            for (int m = 0; m < 4; ++m)
#pragma unroll
                for (int n = 0; n < 2; ++n) acc[a][b][m][n] = (f32x4){0.f, 0.f, 0.f, 0.f};
    bf16x8 At[4][2], B0[2][2], B1[2][2];
#define PG8_UA(u) ((unsigned)((MERGED && (u).kind == 0) ? OA0 : OA) + (unsigned)(u).pm * tstepA + (unsigned)((u).acol + (u).kofs) * 2u)
#define PG8_UB(u) ((unsigned)((MERGED && (u).kind == 0) ? OB0 : OB) + (unsigned)(u).pn * tstepB + (unsigned)(u).kofs * 2u)
    unsigned cA = PG8_UA(cur), cB = PG8_UB(cur);
    {
        PG8_STAGE(PG8_SB(0, 0), cB, voffB); PG8_STAGE(PG8_SB(0, 1), cB + hstepB, voffB); PG8_STAGE(PG8_SA(0, 0), cA, voffA); PG8_STAGE(PG8_SA(0, 1), cA + hstepA, voffA);
        if (wr == 1) PG8_BAR;
        PG8_WAIT_V(2); PG8_BAR;
        PG8_STAGE(PG8_SB(1, 0), cB + kstep, voffB); PG8_STAGE(PG8_SA(1, 0), cA + kstep, voffA); PG8_STAGE(PG8_SB(1, 1), cB + hstepB + kstep, voffB);
        PG8_WAIT_V(6); PG8_BAR;
    }
    for (;;) {
        const bool has_next = S.next(ui + 1, nxt);
        const unsigned nA = has_next ? PG8_UA(nxt) : cA, nB = has_next ? PG8_UB(nxt) : cB;
        const int nt = cur.nt;
        for (int t = 0; t < nt; t += 2) {
            const bool last = (t == nt - 2);
            if constexpr (MERGED) if (last && has_next && nxt.kind == 2) {
                unsigned char* w0_ = E.ws; asm volatile("" : "+s"(w0_));
                if (wid == 0) { unsigned* cw = (unsigned*)(w0_ + WS_CTL) + CW_SEAM + 1024 + BANK * 64 + (nxt.pm / 9) * 16; unsigned sp_ = 0;
                    while ((unsigned)__builtin_amdgcn_readfirstlane((int)__hip_atomic_load(cw, __ATOMIC_RELAXED, __HIP_MEMORY_SCOPE_AGENT)) < 8u) { __builtin_amdgcn_s_sleep(2); if (++sp_ > (1u << 22)) break; }
                    __builtin_amdgcn_fence(__ATOMIC_ACQUIRE, "agent"); asm volatile("s_waitcnt vmcnt(0)" ::: "memory"); }
                asm volatile("" ::: "memory"); PG8_BAR; asm volatile("" ::: "memory");
                if (tid < 256) { const f32x4* p4 = (const f32x4*)((const float*)(w0_ + WS_SSQ) + (size_t)(nxt.pm * BM + tid) * 32); float s_ = 0.f;
#pragma unroll
                    for (int j = 0; j < 8; ++j) { const f32x4 v_ = p4[j]; s_ += (v_.x + v_.y) + (v_.z + v_.w); }
                    ((LAS float*)(lds + opq(RSTD_OFF)))[(ui + 1) * 256 + tid] = frsq(s_ * (1.0f / DM) + EPS); }
            }
            const unsigned a1 = cA + (unsigned)(t + 1) * kstep;
            const unsigned a2 = last ? nA : cA + (unsigned)(t + 2) * kstep, b2 = last ? nB : cB + (unsigned)(t + 2) * kstep;
            const unsigned a3 = a2 + kstep, b3 = b2 + kstep;
            PG8_LDB(B0, 0, 0); PG8_LDB(B1, 0, 1); PG8_SCHED; PG8_LDA(At, 0, 0); PG8_STAGE(PG8_SA(1, 1), a1 + hstepA, voffA);
            PG8_WAIT_V(8); PG8_WAIT_L(0); PG8_BAR; PG8_MMA(0, 0, At, B0); PG8_MMA(0, 1, At, B1); PG8_BAR; PG8_SCHED;
            PG8_LDA(At, 0, 1); PG8_STAGE(PG8_SB(0, 0), b2, voffB); PG8_STAGE(PG8_SB(0, 1), b2 + hstepB, voffB); PG8_STAGE(PG8_SA(0, 0), a2, voffA);
            PG8_WAIT_V(8); PG8_WAIT_L(0); PG8_BAR; PG8_MMA(1, 0, At, B0); PG8_MMA(1, 1, At, B1); PG8_BAR; PG8_SCHED;
            PG8_LDB(B0, 1, 0); PG8_LDB(B1, 1, 1); PG8_SCHED; PG8_LDA(At, 1, 0); PG8_STAGE(PG8_SA(0, 1), a2 + hstepA, voffA);
            PG8_WAIT_V(8); PG8_WAIT_L(0); PG8_BAR; PG8_MMA(0, 0, At, B0); PG8_MMA(0, 1, At, B1); PG8_BAR; PG8_SCHED;
            PG8_LDA(At, 1, 1); PG8_STAGE(PG8_SB(1, 0), b3, voffB); PG8_STAGE(PG8_SB(1, 1), b3 + hstepB, voffB); PG8_STAGE(PG8_SA(1, 0), a3, voffA);
            PG8_WAIT_V(8); PG8_WAIT_L(0); PG8_BAR; PG8_MMA(1, 0, At, B0); PG8_MMA(1, 1, At, B1); PG8_BAR; PG8_SCHED;
        }
        if constexpr (ALIGN_EPI) { if (wr == 0) PG8_BAR; }
        if (MERGED && cur.kind == 0) {
            E0(acc, cur, ui, lds, wr, wc, tid, 0xffu);
            asm volatile("s_waitcnt vmcnt(0)" ::: "memory"); PG8_BAR; asm volatile("" ::: "memory");
            if (tid == 0) { unsigned char* w0_ = E.ws; asm volatile("" : "+s"(w0_)); unsigned* cw = (unsigned*)(w0_ + WS_CTL) + CW_SEAM + 1024 + BANK * 64 + (cur.pm / 9) * 16;
                __builtin_amdgcn_fence(__ATOMIC_RELEASE, "agent"); asm volatile("s_waitcnt vmcnt(0)" ::: "memory");
                __hip_atomic_fetch_add(cw, 1u, __ATOMIC_RELAXED, __HIP_MEMORY_SCOPE_AGENT); }
        } else
        if (!S.is_slice(ui)) E(acc, cur, ui, lds, wr, wc, tid, 0xffu);
        if (!has_next) break;
#pragma unroll
        for (int a = 0; a < 2; ++a)
#pragma unroll
            for (int b = 0; b < 2; ++b)
#pragma unroll
                for (int m = 0; m < 4; ++m)
#pragma unroll
                    for (int n = 0; n < 2; ++n) acc[a][b][m][n] = (f32x4){0.f, 0.f, 0.f, 0.f};
        cur = nxt; cA = nA; cB = nB; ++ui;
        if constexpr (ALIGN_EPI) { if (wr == 1) PG8_BAR; }
    }
    PG8_WAIT_V(0);
    if constexpr (!ALIGN_EPI) { if (wr == 0) PG8_BAR; }
    PG8_BAR;
    if constexpr (SchedT::F > 1) if (S.is_slice(ui)) {
        unsigned char* w_ = E.ws; asm volatile("" : "+s"(w_)); float* slab = (float*)(w_ + WS_SLAB); unsigned* cnt = (unsigned*)(w_ + WS_CTL) + CW_SEAM + BANK * 4096;
        constexpr int F = SchedT::F; const int tt = S.v / F, sj = S.v - tt * F; float* my = slab + ((size_t)(tt * F + sj) * 32) * 2048;
#pragma unroll
        for (int a = 0; a < 2; ++a)
#pragma unroll
            for (int b = 0; b < 2; ++b)
#pragma unroll
                for (int m = 0; m < 4; ++m)
#pragma unroll
                    for (int n = 0; n < 2; ++n) { float* sp_ = my + (size_t)((((a * 2 + b) * 4 + m) * 2 + n) * 512 + tid) * 4;
                        asm volatile("global_store_dwordx4 %0, %1, off sc1\n\ts_nop 1" :: "v"(sp_), "v"(acc[a][b][m][n]) : "memory"); }
        asm volatile("s_waitcnt vmcnt(0)" ::: "memory"); __syncthreads();
        if (tid == 0) { unsigned* cw = cnt + tt * 16;
            __hip_atomic_fetch_add(cw, 1u, __ATOMIC_RELAXED, __HIP_MEMORY_SCOPE_AGENT);
            unsigned sp = 0; while (__hip_atomic_load(cw, __ATOMIC_RELAXED, __HIP_MEMORY_SCOPE_AGENT) < (unsigned)F) { __builtin_amdgcn_s_sleep(1); if (++sp > (1u << 22)) break; }
            __builtin_amdgcn_fence(__ATOMIC_ACQUIRE, "agent"); asm volatile("s_waitcnt vmcnt(0)" ::: "memory"); }
        __syncthreads();
        constexpr int per = 8 / F; const unsigned gmask = ((1u << per) - 1u) << (sj * per);
        const float* t0 = slab + ((size_t)(tt * F) * 32) * 2048;
#pragma unroll
        for (int a = 0; a < 2; ++a)
#pragma unroll
            for (int m = 0; m < 4; ++m) if ((gmask >> (a * 4 + m)) & 1u) {
#pragma unroll
                for (int b = 0; b < 2; ++b)
#pragma unroll
                    for (int n = 0; n < 2; ++n) { const float* fp = t0 + (size_t)((((a * 2 + b) * 4 + m) * 2 + n) * 512 + tid) * 4; f32x4 sm = *(const f32x4*)fp;
#pragma unroll
                        for (int sl = 1; sl < F; ++sl) sm += *(const f32x4*)(fp + (size_t)sl * 32 * 2048);
                        acc[a][b][m][n] = sm; } }
        E(acc, cur, ui, lds, wr, wc, tid, gmask);
        asm volatile("s_waitcnt vmcnt(0)" ::: "memory"); __syncthreads();
    }
#undef PG8_UA
#undef PG8_UB
#undef PG8_SA
#undef PG8_SB
#undef PG8_STAGE
#undef PG8_LDA
#undef PG8_LDB
#undef PG8_MMA
#undef PG8_WAIT_V
#undef PG8_WAIT_L
#undef PG8_BAR
#undef PG8_SCHED
}
}

namespace att {
constexpr int D = 128, NW = 8, QBLK = 32, KVBLK = 64;
constexpr float SCALE = 0.088388347648318440f;
constexpr float THR = 8.f;
constexpr int SHM_V = KVBLK * D * 2, SHM_K = KVBLK * D * 2, SHM_ATTN = 3 * SHM_V + 3 * SHM_K + NW * 64 * 4;
#define KSWZ(row, colB) ((row) * 256 + ((colB) ^ (((row) & 7) << 4)))
#define SBAR() __builtin_amdgcn_sched_barrier(0)
__device__ __forceinline__ int crow(int r, int hi) { return (r & 3) + 8 * (r >> 2) + 4 * hi; }
__device__ __forceinline__ unsigned cvtpk(float lo, float hi) { unsigned r; asm volatile("v_cvt_pk_bf16_f32 %0, %1, %2" : "=v"(r) : "v"(lo), "v"(hi)); return r; }
__device__ __forceinline__ bf16x8 ld8(const bf16_t* p) { return *reinterpret_cast<const bf16x8*>(p); }

__device__ __forceinline__ void partialSM(f32x16& p0, f32x16& p1, float& m_reg, float& mn, float& alpha) {
  constexpr float C = SCALE * 1.4426950408889634f;
  float pmax = p0[0]; for (int r = 1; r < 16; ++r) pmax = fmaxf(pmax, p0[r]); for (int r = 0; r < 16; ++r) pmax = fmaxf(pmax, p1[r]);
  { auto rr = __builtin_amdgcn_permlane32_swap(__float_as_uint(pmax), __float_as_uint(pmax), false, false);
    pmax = fmaxf(__uint_as_float(rr[0]), __uint_as_float(rr[1])); }
  if (__builtin_expect(__all(pmax - m_reg <= THR / SCALE), 1)) { mn = m_reg; alpha = 1.f; }
  else { mn = fmaxf(m_reg, pmax); alpha = __builtin_amdgcn_exp2f((m_reg - mn) * C); m_reg = mn; }
  float mnC = -mn * C;
  for (int r = 0; r < 16; ++r) p0[r] = fmaf(p0[r], C, mnC); for (int r = 0; r < 16; ++r) p1[r] = fmaf(p1[r], C, mnC);
  for (int r = 0; r < 16; ++r) p0[r] = __builtin_amdgcn_exp2f(p0[r]);
}
__device__ __forceinline__ void finishSM(f32x16& p0, f32x16& p1, float alpha, float& l_reg, bf16x8& pa0, bf16x8& pa1, bf16x8& pa2, bf16x8& pa3) {
  for (int r = 0; r < 16; ++r) p1[r] = __builtin_amdgcn_exp2f(p1[r]);
  float ps = 0; for (int r = 0; r < 16; ++r) ps += p0[r]; for (int r = 0; r < 16; ++r) ps += p1[r];
  { auto rr = __builtin_amdgcn_permlane32_swap(__float_as_uint(ps), __float_as_uint(ps), false, false);
    ps = __uint_as_float(rr[0]) + __uint_as_float(rr[1]); }
  l_reg = l_reg * alpha + ps;
#define PK4(P, BASE, OUT) do { unsigned a0 = cvtpk(P[BASE + 0], P[BASE + 1]), a1 = cvtpk(P[BASE + 2], P[BASE + 3]);   \
    unsigned b0 = cvtpk(P[BASE + 4], P[BASE + 5]), b1 = cvtpk(P[BASE + 6], P[BASE + 7]);                              \
    auto r0 = __builtin_amdgcn_permlane32_swap(a0, b0, false, false); auto r1 = __builtin_amdgcn_permlane32_swap(a1, b1, false, false); \
    u32x4 w = {r0[0], r1[0], r0[1], r1[1]}; OUT = *reinterpret_cast<bf16x8*>(&w); } while (0)
  PK4(p0, 0, pa0); PK4(p0, 8, pa1); PK4(p1, 0, pa2); PK4(p1, 8, pa3);
#undef PK4
}
__device__ __forceinline__ void qkt(f32x16& p0, f32x16& p1, const bf16_t* Ks, const bf16x8* qr, int r32, int hi) {
  p0 = f32x16{}; p1 = f32x16{};
  for (int d0 = 0; d0 < 8; ++d0) { int cb = (d0 * 16 + hi * 8) * 2;
    bf16x8 b0 = *reinterpret_cast<const bf16x8*>((const char*)Ks + KSWZ(r32, cb));
    bf16x8 b1 = *reinterpret_cast<const bf16x8*>((const char*)Ks + KSWZ(32 + r32, cb));
    p0 = __builtin_amdgcn_mfma_f32_32x32x16_bf16(b0, qr[d0], p0, 0, 0, 0);
    p1 = __builtin_amdgcn_mfma_f32_32x32x16_bf16(b1, qr[d0], p1, 0, 0, 0); }
}
__device__ __forceinline__ int v_st(int k, int c) { const int kk = (k & ~0xC) | ((k & 4) << 1) | ((k & 8) >> 1); return ((kk >> 3) * 4 + (c >> 5)) * 512 + ((kk & 7) * 32 + (c & 31)) * 2; }
__device__ __forceinline__ int v_rd_base(int lane) { return ((lane & 3) << 3) | (((lane >> 2) & 3) << 6) | (((lane >> 4) & 1) << 5) | (((lane >> 5) & 1) << 8); }
constexpr int v_rd_off(int d0, int ks, int half) { return d0 * 512 + ks * 4096 + half * 2048; }
template <int OFF> __device__ __forceinline__ s16x4 tr_read(int vb) {
  s16x4 r; asm volatile("ds_read_b64_tr_b16 %0, %1 offset:%2" : "=&v"(r) : "v"(vb), "i"(OFF) : "memory"); return r;
}
template <int D0> __device__ __forceinline__ void pv_one(f32x16& od, int vb, bf16x8 pa0, bf16x8 pa1, bf16x8 pa2, bf16x8 pa3) {
  const s16x4 l0 = tr_read<v_rd_off(D0, 0, 0)>(vb), h0 = tr_read<v_rd_off(D0, 0, 1)>(vb), l1 = tr_read<v_rd_off(D0, 1, 0)>(vb), h1 = tr_read<v_rd_off(D0, 1, 1)>(vb);
  const s16x4 l2 = tr_read<v_rd_off(D0, 2, 0)>(vb), h2 = tr_read<v_rd_off(D0, 2, 1)>(vb), l3 = tr_read<v_rd_off(D0, 3, 0)>(vb), h3 = tr_read<v_rd_off(D0, 3, 1)>(vb);
  asm volatile("s_waitcnt lgkmcnt(0)" ::: "memory"); SBAR();
#define PK(L, H) (bf16x8){L[0], L[1], L[2], L[3], H[0], H[1], H[2], H[3]}
  od = __builtin_amdgcn_mfma_f32_32x32x16_bf16(pa0, PK(l0, h0), od, 0, 0, 0);
  od = __builtin_amdgcn_mfma_f32_32x32x16_bf16(pa1, PK(l1, h1), od, 0, 0, 0);
  od = __builtin_amdgcn_mfma_f32_32x32x16_bf16(pa2, PK(l2, h2), od, 0, 0, 0);
  od = __builtin_amdgcn_mfma_f32_32x32x16_bf16(pa3, PK(l3, h3), od, 0, 0, 0);
#undef PK
}
__device__ __forceinline__ void pv_d0(f32x16* o, int vb, bf16x8 pa0, bf16x8 pa1, bf16x8 pa2, bf16x8 pa3) {
  pv_one<0>(o[0], vb, pa0, pa1, pa2, pa3); pv_one<1>(o[1], vb, pa0, pa1, pa2, pa3); pv_one<2>(o[2], vb, pa0, pa1, pa2, pa3); pv_one<3>(o[3], vb, pa0, pa1, pa2, pa3);
}
template <int LD, int ldo, bool GATED>
__device__ __forceinline__ void attn_unit(const bf16_t* __restrict__ Qb, const bf16_t* __restrict__ Kh, const bf16_t* __restrict__ Vh,
                                          bf16_t* __restrict__ Ob, const bf16_t* __restrict__ Zb, int seq, char* lds, const int tid) {
  constexpr int SDEPTH = 2;
  const int wid = tid >> 6, lane = tid & 63, r32 = lane & 31, hi = lane >> 5;
  char* V_lds = lds; char* K_lds = lds + 3 * SHM_V;
  float* ws = (float*)(lds + 3 * SHM_V + 3 * SHM_K) + wid * 64; float* li_l = ws; float* al_l = ws + 32;
  float m_reg = -1e30f, l_reg = 0; f32x16 o[4] = {}; bf16x8 qr[8];
  { const unsigned qoff = (unsigned)((wid * QBLK + r32) * LD + hi * 8) * 2u;
#pragma unroll
    for (int d0 = 0; d0 < 8; ++d0) qr[d0] = *(const bf16x8*)((const char*)Qb + qoff + d0 * 32); }
  const int sr = tid >> 4, sc = (tid & 15) * 8, vst0 = v_st(sr, sc), vst1 = v_st(32 + sr, sc);
  const int vb0 = (int)(uintptr_t)V_lds + v_rd_base(lane);
  struct { bf16x8 vs0, vs1, ks0, ks1; } sr_[SDEPTH];
  const unsigned soff0 = (unsigned)(sr * LD + sc) * 2u, soff1 = (unsigned)((32 + sr) * LD + sc) * 2u;
#define SLOAD(i, k0) do { const char* vt_ = (const char*)Vh + (size_t)(k0) * (LD * 2); const char* kt_ = (const char*)Kh + (size_t)(k0) * (LD * 2); \
    sr_[i].vs0 = *(const bf16x8*)(vt_ + soff0); sr_[i].vs1 = *(const bf16x8*)(vt_ + soff1); sr_[i].ks0 = *(const bf16x8*)(kt_ + soff0); sr_[i].ks1 = *(const bf16x8*)(kt_ + soff1); } while (0)
#define SWRITE(so, i) do { *(bf16x8*)(V_lds + (so) + vst0) = sr_[i].vs0;          \
    *(bf16x8*)(V_lds + (so) + vst1) = sr_[i].vs1; int kc = sc * 2;               \
    *(bf16x8*)(K_lds + (so) + KSWZ(sr, kc)) = sr_[i].ks0;                       \
    *(bf16x8*)(K_lds + (so) + KSWZ(32 + sr, kc)) = sr_[i].ks1; } while (0)
#define SWAIT() do { asm volatile("s_waitcnt vmcnt(4)" ::: "memory"); } while (0)
#define RESC(a) do { if (__any((a) < 1.f)) { if (hi == 0) al_l[r32] = (a); asm volatile("s_waitcnt lgkmcnt(0)" ::: "memory"); \
    for (int d = 0; d < 4; ++d) for (int r = 0; r < 16; ++r) o[d][r] *= al_l[crow(r, hi)]; } } while (0)
#define ROT() do { const int t_ = sp; sp = sc_; sc_ = sn; sn = t_; } while (0)
  f32x16 pA0, pA1, pB0, pB1; float mnA, mnB, alA, alB; bf16x8 pa0, pa1, pa2, pa3; const int NT = seq / KVBLK;
  constexpr int SE = 0, SO = SDEPTH - 1;
  int sp = 0, sc_ = SHM_V, sn = 2 * SHM_V;
  SLOAD(SE, 0); asm volatile("s_waitcnt vmcnt(0)" ::: "memory"); SWRITE(0, SE); __syncthreads();
  qkt(pA0, pA1, (const bf16_t*)K_lds, qr, r32, hi); partialSM(pA0, pA1, m_reg, mnA, alA);
  SLOAD(SO, KVBLK); if (2 < NT) SLOAD(SE, 2 * KVBLK);
  SWAIT(); SWRITE(SHM_V, SO);
  for (int j = 1; j + 1 < NT; j += 2) {
    __syncthreads();
    SBAR(); qkt(pB0, pB1, (const bf16_t*)(K_lds + sc_), qr, r32, hi);
    finishSM(pA0, pA1, alA, l_reg, pa0, pa1, pa2, pa3); SBAR();
    SLOAD(SO, (j + SDEPTH) * KVBLK); SBAR();
    pv_d0(o, vb0 + sp, pa0, pa1, pa2, pa3); partialSM(pB0, pB1, m_reg, mnB, alB);
    SWAIT(); SWRITE(sn, SE);
    RESC(alB); ROT();
    __syncthreads();
    SBAR(); qkt(pA0, pA1, (const bf16_t*)(K_lds + sc_), qr, r32, hi);
    finishSM(pB0, pB1, alB, l_reg, pa0, pa1, pa2, pa3); SBAR();
    if (j + 3 < NT) SLOAD(SE, (j + 1 + SDEPTH) * KVBLK); SBAR();
    pv_d0(o, vb0 + sp, pa0, pa1, pa2, pa3); partialSM(pA0, pA1, m_reg, mnA, alA);
    SWAIT(); SWRITE(sn, SO);
    RESC(alA); ROT();
  }
  __syncthreads();
  SBAR(); qkt(pB0, pB1, (const bf16_t*)(K_lds + sc_), qr, r32, hi);
  finishSM(pA0, pA1, alA, l_reg, pa0, pa1, pa2, pa3); SBAR();
  pv_d0(o, vb0 + sp, pa0, pa1, pa2, pa3); partialSM(pB0, pB1, m_reg, mnB, alB);
  RESC(alB);
  finishSM(pB0, pB1, alB, l_reg, pa0, pa1, pa2, pa3); SBAR();
  pv_d0(o, vb0 + sc_, pa0, pa1, pa2, pa3); SBAR();
#define ZLD(i) (*(const u32x4*)((const char*)Zb + (unsigned)((wid * QBLK + (i) * 4 + (lane >> 4)) * LD + (lane & 15) * 8) * 2u))
  u32x4 za, zb; if constexpr (GATED) { za = ZLD(0); zb = ZLD(1); }
  if (hi == 0) li_l[r32] = l_reg; asm volatile("s_waitcnt lgkmcnt(0)" ::: "memory");
  float rli[16];
#pragma unroll
  for (int r = 0; r < 16; ++r) rli[r] = __builtin_amdgcn_rcpf(li_l[crow(r, hi)]);
  __syncthreads();
  { bf16_t* stg = (bf16_t*)lds + wid * 4096;
#pragma unroll
    for (int r = 0; r < 16; ++r) { const int orow = crow(r, hi);
#pragma unroll
      for (int d0 = 0; d0 < 4; ++d0) stg[orow * 128 + d0 * 32 + r32] = (bf16_t)f2bf(o[d0][r] * rli[r]); }
    asm volatile("s_waitcnt lgkmcnt(0)" ::: "memory");
#pragma unroll 1
    for (int i = 0; i < 8; i += 2) { u32x4 na, nb; if constexpr (GATED) { const int i2 = (i + 2) & 7; na = ZLD(i2); nb = ZLD(i2 + 1); }
#pragma unroll
      for (int q = 0; q < 2; ++q) { const int row = (i + q) * 4 + (lane >> 4), ch = lane & 15; u32x4 v = *(const u32x4*)(stg + row * 128 + ch * 8);
        if constexpr (GATED) { const u32x4 z = q ? zb : za;
          v.x = pk2(bflo(v.x) * siluf_(bflo(z.x)), bfhi(v.x) * siluf_(bfhi(z.x))); v.y = pk2(bflo(v.y) * siluf_(bflo(z.y)), bfhi(v.y) * siluf_(bfhi(z.y)));
          v.z = pk2(bflo(v.z) * siluf_(bflo(z.z)), bfhi(v.z) * siluf_(bfhi(z.z))); v.w = pk2(bflo(v.w) * siluf_(bflo(z.w)), bfhi(v.w) * siluf_(bfhi(z.w))); }
        *(u32x4*)((char*)Ob + (unsigned)((wid * QBLK + row) * ldo + ch * 8) * 2u) = v; }
      if constexpr (GATED) { za = na; zb = nb; } }
#undef ZLD
    asm volatile("s_waitcnt lgkmcnt(0)" ::: "memory"); }
  __syncthreads();
#undef SLOAD
#undef SWRITE
#undef SWAIT
#undef RESC
#undef ROT
}

template <int LD, int ldo, bool GATED>
__device__ __forceinline__ void attn_unit_dma(const bf16_t* __restrict__ Qb, const bf16_t* __restrict__ Kh, const bf16_t* __restrict__ Vh,
                                              bf16_t* __restrict__ Ob, const bf16_t* __restrict__ Zb, int seq, char* lds, const int tid) {
  const int wid = tid >> 6, lane = tid & 63, r32 = lane & 31, hi = lane >> 5;
  char* V_lds = lds; char* K_lds = lds + 65536;
  float* ws = (float*)(lds + 131072) + wid * 64; float* li_l = ws; float* al_l = ws + 32;
  float m_reg = -1e30f, l_reg = 0; f32x16 o[4] = {}; bf16x8 qr[8];
  { const unsigned qoff = (unsigned)((wid * QBLK + r32) * LD + hi * 8) * 2u;
#pragma unroll
    for (int d0 = 0; d0 < 8; ++d0) qr[d0] = *(const bf16x8*)((const char*)Qb + qoff + d0 * 32); }
  const int vb0 = (int)(uintptr_t)V_lds + v_rd_base(lane);
  unsigned kof[2], vof[2];
#pragma unroll
  for (int i = 0; i < 2; ++i) { const int ob = ((i * 8 + wid) * 64 + lane) * 16, row = ob >> 8, cb = (ob & 255) ^ ((row & 7) << 4); kof[i] = (unsigned)(row * LD * 2 + cb);
    const int st = ob >> 9, e = (ob & 511) >> 1, kk = (st >> 2) * 8 + (e >> 5), c = (st & 3) * 32 + (e & 31), k = (kk & ~0xC) | ((kk & 4) << 1) | ((kk & 8) >> 1); vof[i] = (unsigned)(k * LD * 2 + c * 2); }
#define ADMA(t) do { const size_t to_ = (size_t)((t) * KVBLK) * (LD * 2); const int so_ = ((t) & 3) * SHM_V; _Pragma("unroll") for (int i_ = 0; i_ < 2; ++i_) { \
    __builtin_amdgcn_global_load_lds((const unsigned*)((const char*)Kh + to_ + kof[i_]), (LAS unsigned*)(LAS char*)(K_lds + so_ + (i_ * 8 + wid) * 1024), 16, 0, 0); \
    __builtin_amdgcn_global_load_lds((const unsigned*)((const char*)Vh + to_ + vof[i_]), (LAS unsigned*)(LAS char*)(V_lds + so_ + (i_ * 8 + wid) * 1024), 16, 0, 0); } } while (0)
#define AWAIT(more) do { if (more) asm volatile("s_waitcnt vmcnt(4)" ::: "memory"); else asm volatile("s_waitcnt vmcnt(0)" ::: "memory"); } while (0)
#define RESC(a) do { if (__any((a) < 1.f)) { if (hi == 0) al_l[r32] = (a); asm volatile("s_waitcnt lgkmcnt(0)" ::: "memory"); \
    for (int d = 0; d < 4; ++d) for (int r = 0; r < 16; ++r) o[d][r] *= al_l[crow(r, hi)]; } } while (0)
  f32x16 pA0, pA1, pB0, pB1; float mnA, mnB, alA, alB; bf16x8 pa0, pa1, pa2, pa3; const int NT = seq / KVBLK;
  const int hf = wid >> 2;
#define AMID(more) do { if (more) asm volatile("s_waitcnt vmcnt(4)" ::: "memory"); else asm volatile("s_waitcnt vmcnt(0)" ::: "memory"); __syncthreads(); } while (0)
  ADMA(0); ADMA(1); asm volatile("s_waitcnt vmcnt(0)" ::: "memory"); __syncthreads();
  if (2 < NT) ADMA(2);
  qkt(pA0, pA1, (const bf16_t*)K_lds, qr, r32, hi); SBAR(); partialSM(pA0, pA1, m_reg, mnA, alA); SBAR();
  if (hf == 0) {
    for (int j = 1; j + 1 < NT; j += 2) {
      AWAIT(true); __syncthreads();
      if (j + 2 < NT) ADMA(j + 2);
      SBAR(); qkt(pB0, pB1, (const bf16_t*)(K_lds + (j & 3) * SHM_K), qr, r32, hi); finishSM(pA0, pA1, alA, l_reg, pa0, pa1, pa2, pa3);
      SBAR(); AMID(j + 2 < NT); SBAR();
      pv_d0(o, vb0 + ((j - 1) & 3) * SHM_V, pa0, pa1, pa2, pa3); partialSM(pB0, pB1, m_reg, mnB, alB); RESC(alB);
      AWAIT(j + 2 < NT); __syncthreads();
      if (j + 3 < NT) ADMA(j + 3);
      SBAR(); qkt(pA0, pA1, (const bf16_t*)(K_lds + ((j + 1) & 3) * SHM_K), qr, r32, hi); finishSM(pB0, pB1, alB, l_reg, pa0, pa1, pa2, pa3);
      SBAR(); AMID(j + 3 < NT); SBAR();
      pv_d0(o, vb0 + (j & 3) * SHM_V, pa0, pa1, pa2, pa3); partialSM(pA0, pA1, m_reg, mnA, alA); RESC(alA);
    }
    asm volatile("s_waitcnt vmcnt(0)" ::: "memory"); __syncthreads();
    SBAR(); qkt(pB0, pB1, (const bf16_t*)(K_lds + ((NT - 1) & 3) * SHM_K), qr, r32, hi); finishSM(pA0, pA1, alA, l_reg, pa0, pa1, pa2, pa3);
    SBAR(); __syncthreads(); SBAR();
    pv_d0(o, vb0 + ((NT - 2) & 3) * SHM_V, pa0, pa1, pa2, pa3); partialSM(pB0, pB1, m_reg, mnB, alB); RESC(alB);
  } else {
    qkt(pB0, pB1, (const bf16_t*)(K_lds + SHM_K), qr, r32, hi);
    for (int j = 1; j + 1 < NT; j += 2) {
      AWAIT(true); __syncthreads();
      if (j + 2 < NT) ADMA(j + 2);
      SBAR(); finishSM(pA0, pA1, alA, l_reg, pa0, pa1, pa2, pa3); pv_d0(o, vb0 + ((j - 1) & 3) * SHM_V, pa0, pa1, pa2, pa3);
      SBAR(); AMID(j + 2 < NT); SBAR();
      partialSM(pB0, pB1, m_reg, mnB, alB); RESC(alB); qkt(pA0, pA1, (const bf16_t*)(K_lds + ((j + 1) & 3) * SHM_K), qr, r32, hi);
      AWAIT(j + 2 < NT); __syncthreads();
      if (j + 3 < NT) ADMA(j + 3);
      SBAR(); finishSM(pB0, pB1, alB, l_reg, pa0, pa1, pa2, pa3); pv_d0(o, vb0 + (j & 3) * SHM_V, pa0, pa1, pa2, pa3);
      SBAR(); AMID(j + 3 < NT); SBAR();
      partialSM(pA0, pA1, m_reg, mnA, alA); RESC(alA); qkt(pB0, pB1, (const bf16_t*)(K_lds + ((j + 2) & 3) * SHM_K), qr, r32, hi);
    }
    asm volatile("s_waitcnt vmcnt(0)" ::: "memory"); __syncthreads();
    SBAR(); finishSM(pA0, pA1, alA, l_reg, pa0, pa1, pa2, pa3); pv_d0(o, vb0 + ((NT - 2) & 3) * SHM_V, pa0, pa1, pa2, pa3);
    SBAR(); __syncthreads(); SBAR();
    partialSM(pB0, pB1, m_reg, mnB, alB); RESC(alB);
  }
  SBAR();
  finishSM(pB0, pB1, alB, l_reg, pa0, pa1, pa2, pa3); SBAR();
  pv_d0(o, vb0 + ((NT - 1) & 3) * SHM_V, pa0, pa1, pa2, pa3); SBAR();
#undef AMID
#define ZLD(i) (*(const u32x4*)((const char*)Zb + (unsigned)((wid * QBLK + (i) * 4 + (lane >> 4)) * LD + (lane & 15) * 8) * 2u))
  u32x4 za, zb; if constexpr (GATED) { za = ZLD(0); zb = ZLD(1); }
  if (hi == 0) li_l[r32] = l_reg; asm volatile("s_waitcnt lgkmcnt(0)" ::: "memory");
  float rli[16];
#pragma unroll
  for (int r = 0; r < 16; ++r) rli[r] = __builtin_amdgcn_rcpf(li_l[crow(r, hi)]);
  __syncthreads();
  { bf16_t* stg = (bf16_t*)lds + wid * 4096;
#pragma unroll
    for (int r = 0; r < 16; ++r) { const int orow = crow(r, hi);
#pragma unroll
      for (int d0 = 0; d0 < 4; ++d0) stg[orow * 128 + d0 * 32 + r32] = (bf16_t)f2bf(o[d0][r] * rli[r]); }
    asm volatile("s_waitcnt lgkmcnt(0)" ::: "memory");
#pragma unroll 1
    for (int i = 0; i < 8; i += 2) { u32x4 na, nb; if constexpr (GATED) { const int i2 = (i + 2) & 7; na = ZLD(i2); nb = ZLD(i2 + 1); }
#pragma unroll
      for (int q = 0; q < 2; ++q) { const int row = (i + q) * 4 + (lane >> 4), ch = lane & 15; u32x4 v = *(const u32x4*)(stg + row * 128 + ch * 8);
        if constexpr (GATED) { const u32x4 z = q ? zb : za;
          v.x = pk2(bflo(v.x) * siluf_(bflo(z.x)), bfhi(v.x) * siluf_(bfhi(z.x))); v.y = pk2(bflo(v.y) * siluf_(bflo(z.y)), bfhi(v.y) * siluf_(bfhi(z.y)));
          v.z = pk2(bflo(v.z) * siluf_(bflo(z.z)), bfhi(v.z) * siluf_(bfhi(z.z))); v.w = pk2(bflo(v.w) * siluf_(bflo(z.w)), bfhi(v.w) * siluf_(bfhi(z.w))); }
        *(u32x4*)((char*)Ob + (unsigned)((wid * QBLK + row) * ldo + ch * 8) * 2u) = v; }
      if constexpr (GATED) { za = na; zb = nb; } }
#undef ZLD
    asm volatile("s_waitcnt lgkmcnt(0)" ::: "memory"); }
  __syncthreads();
#undef ADMA
#undef AWAIT
#undef RESC
}
#define PVH_PK(L, H) (bf16x8){L[0], L[1], L[2], L[3], H[0], H[1], H[2], H[3]}
template <int D0> __device__ __forceinline__ void pvh_step(f32x16* o, int vb, bf16x8 pa0, bf16x8 pa1, bf16x8 pa2, bf16x8 pa3, s16x4& l0, s16x4& h0, s16x4& l1, s16x4& h1, s16x4& l2, s16x4& h2, s16x4& l3, s16x4& h3) {
  asm volatile("s_waitcnt lgkmcnt(4)" ::: "memory"); SBAR();
  o[D0] = __builtin_amdgcn_mfma_f32_32x32x16_bf16(pa0, PVH_PK(l0, h0), o[D0], 0, 0, 0); o[D0] = __builtin_amdgcn_mfma_f32_32x32x16_bf16(pa1, PVH_PK(l1, h1), o[D0], 0, 0, 0); SBAR();
  if constexpr (D0 < 3) { l0 = tr_read<v_rd_off(D0 + 1, 0, 0)>(vb); h0 = tr_read<v_rd_off(D0 + 1, 0, 1)>(vb); l1 = tr_read<v_rd_off(D0 + 1, 1, 0)>(vb); h1 = tr_read<v_rd_off(D0 + 1, 1, 1)>(vb);
    asm volatile("s_waitcnt lgkmcnt(4)" ::: "memory"); } else asm volatile("s_waitcnt lgkmcnt(0)" ::: "memory");
  SBAR();
  o[D0] = __builtin_amdgcn_mfma_f32_32x32x16_bf16(pa2, PVH_PK(l2, h2), o[D0], 0, 0, 0); o[D0] = __builtin_amdgcn_mfma_f32_32x32x16_bf16(pa3, PVH_PK(l3, h3), o[D0], 0, 0, 0); SBAR();
  if constexpr (D0 < 3) { l2 = tr_read<v_rd_off(D0 + 1, 2, 0)>(vb); h2 = tr_read<v_rd_off(D0 + 1, 2, 1)>(vb); l3 = tr_read<v_rd_off(D0 + 1, 3, 0)>(vb); h3 = tr_read<v_rd_off(D0 + 1, 3, 1)>(vb); }
}
__device__ __forceinline__ void pv_d0p(f32x16* o, int vb, bf16x8 pa0, bf16x8 pa1, bf16x8 pa2, bf16x8 pa3) {
  s16x4 l0 = tr_read<v_rd_off(0, 0, 0)>(vb), h0 = tr_read<v_rd_off(0, 0, 1)>(vb), l1 = tr_read<v_rd_off(0, 1, 0)>(vb), h1 = tr_read<v_rd_off(0, 1, 1)>(vb);
  s16x4 l2 = tr_read<v_rd_off(0, 2, 0)>(vb), h2 = tr_read<v_rd_off(0, 2, 1)>(vb), l3 = tr_read<v_rd_off(0, 3, 0)>(vb), h3 = tr_read<v_rd_off(0, 3, 1)>(vb);
  pvh_step<0>(o, vb, pa0, pa1, pa2, pa3, l0, h0, l1, h1, l2, h2, l3, h3); pvh_step<1>(o, vb, pa0, pa1, pa2, pa3, l0, h0, l1, h1, l2, h2, l3, h3);
  pvh_step<2>(o, vb, pa0, pa1, pa2, pa3, l0, h0, l1, h1, l2, h2, l3, h3); pvh_step<3>(o, vb, pa0, pa1, pa2, pa3, l0, h0, l1, h1, l2, h2, l3, h3);
}
#undef PVH_PK
constexpr int P2_K = 65536, P2_MB = 98304, P2_SCR = 139264, P2_HSX = P2_SCR + NW * 64 * 4, SHM_PAIR = P2_HSX + 1024;
template <int LD, int ldo, int M, bool COMB>
__device__ __forceinline__ void attn_pair_map(unsigned char* const wsb, CArgsP ap, const float lam, const int qrow, const int bq, const int h, int seq, char* lds, int tid) {
  asm volatile("" : "+v"(tid));
  constexpr int m = M;
  const int wid = tid >> 6, lane = tid & 63, r32 = lane & 31, hi = lane >> 5, pr = wid & 3, g = wid >> 2;
  const bf16_t* __restrict__ Vh; const bf16_t* __restrict__ K0; const bf16_t* __restrict__ Q0;
  { unsigned char* w_ = wsb; asm volatile("" : "+s"(w_)); const bf16_t* U_ = (const bf16_t*)(w_ + WS_U);
    Q0 = U_ + (size_t)qrow * LD + h * 128; K0 = U_ + (size_t)(bq * TT) * LD + 2048 + h * 128; Vh = U_ + (size_t)(bq * TT) * LD + 4096 + h * 256; }
  char* V_lds = lds; char* K_lds = lds + P2_K; char* MB = lds + P2_MB + pr * 10240;
  float* ws = (float*)(lds + P2_SCR) + wid * 64; float* li_l = ws; float* al_l = ws + 32;
  const int vb0 = (int)(uintptr_t)V_lds + v_rd_base(lane) + g * SHM_V;
  unsigned kof[2], vof[4];
#pragma unroll
  for (int i = 0; i < 2; ++i) { const int ob = ((i * 8 + wid) * 64 + lane) * 16, row = ob >> 8, cb = (ob & 255) ^ ((row & 7) << 4); kof[i] = (unsigned)(row * LD * 2 + cb); }
#pragma unroll
  for (int i = 0; i < 4; ++i) { const int ob = ((i * 8 + wid) * 64 + lane) * 16, vh = ob >> 14, oi = ob & 16383, st = oi >> 9, e = (oi & 511) >> 1, kk = (st >> 2) * 8 + (e >> 5), c = (st & 3) * 32 + (e & 31);
    const int k = (kk & ~0xC) | ((kk & 4) << 1) | ((kk & 8) >> 1); vof[i] = (unsigned)(k * LD * 2 + (vh * 128 + c) * 2); }
#define P2_DMAK(t, slot) do { const char* kt_ = (const char*)Kh + (size_t)((t) * KVBLK) * (LD * 2); _Pragma("unroll") for (int i_ = 0; i_ < 2; ++i_) \
    __builtin_amdgcn_global_load_lds((const unsigned*)(kt_ + kof[i_]), (LAS unsigned*)(LAS char*)(K_lds + (slot) * SHM_K + (i_ * 8 + wid) * 1024), 16, 0, 0); } while (0)
#define P2_DMAV(t, slot) do { const char* vt_ = (const char*)Vh + (size_t)((t) * KVBLK) * (LD * 2); _Pragma("unroll") for (int i_ = 0; i_ < 4; ++i_) \
    __builtin_amdgcn_global_load_lds((const unsigned*)(vt_ + vof[i_]), (LAS unsigned*)(LAS char*)(V_lds + (slot) * (2 * SHM_V) + (i_ * 8 + wid) * 1024), 16, 0, 0); } while (0)
#define P2_RESC(a) do { if (__any((a) < 1.f)) { if (hi == 0) al_l[r32] = (a); asm volatile("s_waitcnt lgkmcnt(0)" ::: "memory"); \
    for (int d = 0; d < 4; ++d) for (int r = 0; r < 16; ++r) o[d][r] *= al_l[crow(r, hi)]; } } while (0)
  const int NT = seq / KVBLK;
  {
  const bf16_t* Qb = Q0 + m * 1024; const bf16_t* Kh = K0 + m * 1024;
  float m_reg = -1e30f, l_reg = 0; f32x16 o[4] = {}; bf16x8 qr[8];
  { const unsigned qoff = (unsigned)((pr * QBLK + r32) * LD + hi * 8) * 2u;
#pragma unroll
    for (int d0 = 0; d0 < 8; ++d0) qr[d0] = *(const bf16x8*)((const char*)Qb + qoff + d0 * 32); }
  f32x16 S0, S1; bf16x8 pa0, pa1, pa2, pa3;
  P2_DMAK(0, 0); P2_DMAK(1, 1); asm volatile("s_waitcnt vmcnt(0)" ::: "memory");
  __syncthreads();
  if (g == 0) qkt(S0, S1, (const bf16_t*)K_lds, qr, r32, hi);
  for (int j = 0; j <= NT; ++j) {
    const bool own = ((j & 1) == g);
    asm volatile("s_waitcnt vmcnt(0)" ::: "memory");
    __syncthreads();
    if (j + 2 < NT) P2_DMAK(j + 2, j & 1);
    if (j < NT) P2_DMAV(j, j & 1);
    SBAR();
    if (own) __builtin_amdgcn_s_setprio(2); else __builtin_amdgcn_s_setprio(0);
    if (own) {
      float alp = 1.f;
      if (j >= 1) { const char* mb = MB + ((j - 1) & 1) * 5120; alp = *(const float*)(mb + 4096 + lane * 4); m_reg = *(const float*)(mb + 4352 + lane * 4); l_reg = *(const float*)(mb + 4608 + lane * 4);
        asm volatile("s_waitcnt lgkmcnt(0)" ::: "memory"); }
      bf16x8 pn0, pn1, pn2, pn3; float al = 1.f;
      if (j < NT) { float mn; partialSM(S0, S1, m_reg, mn, al); finishSM(S0, S1, al, l_reg, pn0, pn1, pn2, pn3);
        char* mb = MB + (j & 1) * 5120;
        *(bf16x8*)(mb + lane * 16) = pn0; *(bf16x8*)(mb + 1024 + lane * 16) = pn1; *(bf16x8*)(mb + 2048 + lane * 16) = pn2; *(bf16x8*)(mb + 3072 + lane * 16) = pn3;
        *(float*)(mb + 4096 + lane * 4) = al; *(float*)(mb + 4352 + lane * 4) = m_reg; *(float*)(mb + 4608 + lane * 4) = l_reg; }
      SBAR();
      if (j >= 1) { const char* mb = MB + ((j - 1) & 1) * 5120;
        pa0 = *(const bf16x8*)(mb + lane * 16); pa1 = *(const bf16x8*)(mb + 1024 + lane * 16); pa2 = *(const bf16x8*)(mb + 2048 + lane * 16); pa3 = *(const bf16x8*)(mb + 3072 + lane * 16);
        P2_RESC(alp);
        asm volatile("s_waitcnt lgkmcnt(0)" ::: "memory"); SBAR();
        pv_d0p(o, vb0 + ((j - 1) & 1) * (2 * SHM_V), pa0, pa1, pa2, pa3); SBAR(); }
      if (j < NT) P2_RESC(al);
    } else {
      if (j >= 1) { const char* mb = MB + ((j - 1) & 1) * 5120;
        pa0 = *(const bf16x8*)(mb + lane * 16); pa1 = *(const bf16x8*)(mb + 1024 + lane * 16); pa2 = *(const bf16x8*)(mb + 2048 + lane * 16); pa3 = *(const bf16x8*)(mb + 3072 + lane * 16);
        asm volatile("s_waitcnt lgkmcnt(0)" ::: "memory"); SBAR();
        pv_d0p(o, vb0 + ((j - 1) & 1) * (2 * SHM_V), pa0, pa1, pa2, pa3); SBAR(); }
      if (j + 1 < NT) qkt(S0, S1, (const bf16_t*)(K_lds + ((j + 1) & 1) * SHM_K), qr, r32, hi);
    }
  }
  __builtin_amdgcn_s_setprio(0);
  if (hi == 0) li_l[r32] = l_reg; asm volatile("s_waitcnt lgkmcnt(0)" ::: "memory");
  float rli[16];
#pragma unroll
  for (int r = 0; r < 16; ++r) rli[r] = __builtin_amdgcn_rcpf(li_l[crow(r, hi)]);
  __syncthreads();
  { bf16_t* stg = (bf16_t*)lds + wid * 4096;
    unsigned char* w2_ = wsb; int lane_e = lane, pr_e = pr, g_e = g; asm volatile("" : "+s"(w2_), "+v"(lane_e), "+v"(pr_e), "+v"(g_e));
    bf16_t* Ob = (bf16_t*)(w2_ + WS_OD) + (size_t)qrow * ldo + h * 256; bf16_t* ObS = Ob + M * 8 * 256;
    const bf16_t* Zb = (const bf16_t*)(w2_ + WS_U) + (size_t)qrow * LD + 6144 + h * 256; bf16_t* Yb = (bf16_t*)(w2_ + WS_Y) + (size_t)qrow * DM + h * 256;
    const float* subg = ap->in[I_BSUBG];
#pragma unroll
    for (int r = 0; r < 16; ++r) { const int orow = crow(r, hi);
#pragma unroll
      for (int d0 = 0; d0 < 4; ++d0) stg[orow * 128 + d0 * 32 + r32] = (bf16_t)f2bf(o[d0][r] * rli[r]); }
    asm volatile("s_waitcnt lgkmcnt(0)" ::: "memory");
    if (!COMB) {
#pragma unroll 2
      for (int i = 0; i < 8; ++i) { const int row = i * 4 + (lane_e >> 4), ch = lane_e & 15; const u32x4 v = *(const u32x4*)(stg + row * 128 + ch * 8);
        *(u32x4*)((char*)ObS + (unsigned)((pr_e * QBLK + row) * ldo + g_e * 128 + ch * 8) * 2u) = v; }
      asm volatile("s_waitcnt lgkmcnt(0)" ::: "memory");
    } else {
      float* hsx = (float*)(lds + P2_HSX); const int ch = lane_e & 15;
#define P2_DIFF(v0, v1, od) do { od[0] = bflo(v0.x) - lam * bflo(v1.x); od[1] = bfhi(v0.x) - lam * bfhi(v1.x); od[2] = bflo(v0.y) - lam * bflo(v1.y); od[3] = bfhi(v0.y) - lam * bfhi(v1.y); \
        od[4] = bflo(v0.z) - lam * bflo(v1.z); od[5] = bfhi(v0.z) - lam * bfhi(v1.z); od[6] = bflo(v0.w) - lam * bflo(v1.w); od[7] = bfhi(v0.w) - lam * bfhi(v1.w); } while (0)
#pragma unroll 2
      for (int i = 0; i < 8; ++i) { const int row = i * 4 + (lane_e >> 4); const u32x4 v1 = *(const u32x4*)(stg + row * 128 + ch * 8);
        const u32x4 v0 = *(const u32x4*)((const char*)Ob + (unsigned)((pr_e * QBLK + row) * ldo + g_e * 128 + ch * 8) * 2u);
        float od[8]; P2_DIFF(v0, v1, od); float ss = 0.f;
#pragma unroll
        for (int k = 0; k < 8; ++k) ss += od[k] * od[k];
        ss += shx<1>(ss); ss += shx<2>(ss); ss += shx<4>(ss); ss += shx<8>(ss);
        if (ch == 0) hsx[(pr_e * QBLK + row) * 2 + g_e] = ss; }
      asm volatile("s_waitcnt lgkmcnt(0)" ::: "memory"); __syncthreads();
      const f32x4 sg0 = *(const f32x4*)(subg + g_e * 128 + ch * 8), sg1 = *(const f32x4*)(subg + g_e * 128 + ch * 8 + 4);
#pragma unroll 2
      for (int i = 0; i < 8; ++i) { const int row = i * 4 + (lane_e >> 4); const u32x4 v1 = *(const u32x4*)(stg + row * 128 + ch * 8);
        const u32x4 v0 = *(const u32x4*)((const char*)Ob + (unsigned)((pr_e * QBLK + row) * ldo + g_e * 128 + ch * 8) * 2u);
        const u32x4 zr = *(const u32x4*)((const char*)Zb + (unsigned)((pr_e * QBLK + row) * LD + g_e * 128 + ch * 8) * 2u);
        float od[8]; P2_DIFF(v0, v1, od);
        const float rstd = frsq((hsx[(pr_e * QBLK + row) * 2] + hsx[(pr_e * QBLK + row) * 2 + 1]) * (1.0f / 256.0f) + EPS);
        const float z[8] = {bflo(zr.x), bfhi(zr.x), bflo(zr.y), bfhi(zr.y), bflo(zr.z), bfhi(zr.z), bflo(zr.w), bfhi(zr.w)};
        const float sg[8] = {sg0[0], sg0[1], sg0[2], sg0[3], sg1[0], sg1[1], sg1[2], sg1[3]};
#pragma unroll
        for (int k = 0; k < 8; ++k) od[k] = (od[k] * rstd * sg[k]) * (1.0f - LAM_INIT1) * siluf_(z[k]);
        u32x4 w; w.x = pk2(od[0], od[1]); w.y = pk2(od[2], od[3]); w.z = pk2(od[4], od[5]); w.w = pk2(od[6], od[7]);
        *(u32x4*)((char*)Yb + (unsigned)((pr_e * QBLK + row) * DM + g_e * 128 + ch * 8) * 2u) = w; }
#undef P2_DIFF
      asm volatile("s_waitcnt lgkmcnt(0)" ::: "memory");
    } }
  __syncthreads();
  }
#undef P2_DMAK
#undef P2_DMAV
#undef P2_RESC
}
template <int LD, int ldo>
__device__ __forceinline__ void attn_unit_pair(unsigned char* const wsb, CArgsP ap, const float lam, const int qrow, const int bq, const int h, int seq, char* lds, const int tid) {
  attn_pair_map<LD, ldo, 0, false>(wsb, ap, lam, qrow, bq, h, seq, lds, tid);
  attn_pair_map<LD, ldo, 1, true>(wsb, ap, lam, qrow, bq, h, seq, lds, tid);
}
template <int LD, int ldo>
__device__ __forceinline__ void attn_unit_pair_one(unsigned char* const wsb, CArgsP ap, const int qrow, const int bq, const int h, const int m, int seq, char* lds, const int tid) {
  if (m == 0) attn_pair_map<LD, ldo, 0, false>(wsb, ap, 0.f, qrow, bq, h, seq, lds, tid);
  else        attn_pair_map<LD, ldo, 1, false>(wsb, ap, 0.f, qrow, bq, h, seq, lds, tid);
}
#undef KSWZ
#undef SBAR
}

constexpr int RING_BYTES = 131072, ATT_OST_OFF = 69632  , LDSCTL_OFF = 155648, MISC_OFF = LDSCTL_OFF + 320, LDS_BYTES = 163840;
static_assert(att::SHM_ATTN <= RING_BYTES && att::SHM_PAIR <= LDSCTL_OFF && MISC_OFF + 128 <= LDS_BYTES, "LDS map");
constexpr int NWAVES = 8;

typedef GAS unsigned gu32;
#define RLX_AGENT __ATOMIC_RELAXED, __HIP_MEMORY_SCOPE_AGENT
#define LDS_WAIT() asm volatile("s_waitcnt lgkmcnt(0)" ::: "memory")
#define VM_WAIT() asm volatile("s_waitcnt vmcnt(0)" ::: "memory")

#define XB_TMO      128
#define XB_XCNT(j)  (256  + 64 * (j))
#define XB_XSUB(j)  (1280 + 64 * (j))
#define XB_XGEN(j)  (2304 + 64 * (j))
#define XB_TOP      3328
#define XB_TOPGEN   3392
#define XCD_BAR_WORDS 3456
#define XB_SPIN_CAP (1u << 18)
__device__ __forceinline__ unsigned xb_ld(unsigned* p)              { return __hip_atomic_load(p, __ATOMIC_RELAXED, __HIP_MEMORY_SCOPE_AGENT); }
__device__ __forceinline__ unsigned xb_add(unsigned* p, unsigned v) { return __hip_atomic_fetch_add(p, v, __ATOMIC_RELAXED, __HIP_MEMORY_SCOPE_AGENT); }
__device__ __forceinline__ int lane_id_opaque() { int lo_, r_; asm volatile("v_mbcnt_lo_u32_b32 %0, -1, 0" : "=v"(lo_)); asm volatile("v_mbcnt_hi_u32_b32 %0, -1, %1" : "=v"(r_) : "v"(lo_)); return r_; }
__device__ __forceinline__ unsigned hw_slot() { return (unsigned)__builtin_amdgcn_s_getreg((5 << 11) | 4) & 63u; }
__device__ __forceinline__ unsigned xb_xcc_id() { return (unsigned)__builtin_amdgcn_s_getreg((3 << 11) | 20) & 0xFu; }
#define XB_SPIN(cond, bar) do { unsigned _sp = 0; while (cond) { __builtin_amdgcn_s_sleep(1); \
    if ((++_sp & 255u) == 0u) { if (xb_ld(&(bar)[XB_TMO])) break; if (_sp > XB_SPIN_CAP) { atomicAdd(&(bar)[XB_TMO], 1u); break; } } } } while (0)
struct XcdBarrier { unsigned* bar; unsigned x; volatile LAS unsigned* st; };
__device__ __forceinline__ XcdBarrier xcd_barrier_post(unsigned* bar, volatile LAS unsigned* st, bool is_t0) {
    XcdBarrier b; b.bar = bar; b.x = xb_xcc_id(); b.st = st;
    if (is_t0) (void)xb_add(&bar[XB_XCNT(b.x)], 1u);
    return b;
}
__device__ __forceinline__ void xcd_barrier_complete(unsigned* bar, unsigned x, unsigned& nloc, unsigned& nx) {
    const unsigned G = 256u;
    unsigned sum, cnt, mine, sp = 0u;
    for (;;) {
        sum = 0u; cnt = 0u; mine = 0u;
#pragma unroll
        for (unsigned j = 0; j < 16; ++j) { const unsigned c = xb_ld(&bar[XB_XCNT(j)]); sum += c; cnt += (c > 0u) ? 1u : 0u; mine = (j == x) ? c : mine; }
        if (sum == G) break;
        __builtin_amdgcn_s_sleep(1);
        if ((++sp & 255u) == 0u) { if (xb_ld(&bar[XB_TMO])) break; if (sp > XB_SPIN_CAP) { atomicAdd(&bar[XB_TMO], 1u); break; } }
    }
    nloc = mine > 0u ? mine : 1u; nx = cnt > 0u ? cnt : 1u;
}
__device__ __forceinline__ void xcd_barrier(const XcdBarrier& b, int wave_s) {
    asm volatile("s_waitcnt vmcnt(0)" ::: "memory");
    __syncthreads();
    if (wave_s == 0 && lane_id_opaque() == 0) {
        unsigned* bar = b.bar;
        __builtin_amdgcn_s_waitcnt(0);
        unsigned nloc = b.st[0], nx = b.st[1];
        if (nloc == 0u) { xcd_barrier_complete(bar, b.x, nloc, nx); b.st[0] = nloc; b.st[1] = nx; }
        const unsigned old = xb_add(&bar[XB_XSUB(b.x)], 1u);
        const unsigned gen = old / nloc;
        if (old + 1u == (gen + 1u) * nloc) {
            __builtin_amdgcn_fence(__ATOMIC_RELEASE, "agent");
            asm volatile("s_waitcnt vmcnt(0)" ::: "memory");
            const unsigned og = xb_add(&bar[XB_TOP], 1u);
            const unsigned tg = og / nx;
            if (og + 1u == (tg + 1u) * nx) xb_add(&bar[XB_TOPGEN], 1u);
            else XB_SPIN(xb_ld(&bar[XB_TOPGEN]) == tg, bar);
            __builtin_amdgcn_fence(__ATOMIC_ACQUIRE, "agent");
            xb_add(&bar[XB_XGEN(b.x)], 1u);
            asm volatile("s_waitcnt vmcnt(0)" ::: "memory");
        } else {
            XB_SPIN(xb_ld(&bar[XB_XGEN(b.x)]) == gen, bar);
            __builtin_amdgcn_fence(__ATOMIC_ACQUIRE, "agent");
            asm volatile("s_waitcnt vmcnt(0)" ::: "memory");
        }
    }
    __syncthreads();
}

__device__ __forceinline__ int p0_dst_row(int ns, int qkcols) {
    if (qkcols > 0) return (ns < qkcols) ? ((ns & ~127) | qk_pi_inv(ns & 127)) : ns;
    if (qkcols < 0) { const int code = -qkcols - 1, gate = code >> 4, dir = (code >> 3) & 1, nblk = code & 7, e = ns & 127;
        const int c = (((e >> 6) & 1) << 7) | (((e >> 4) & 3) << 5) | (((e >> 2) & 3) << 3) | (gate << 2) | (e & 3); return (nblk * 4 + dir * 2 + (ns >> 7)) * 256 + c; }
    return ns;
}
__device__ __forceinline__ void p0_transpose_item(const float* __restrict__ W, int K, int N, bf16_t* __restrict__ WT, LAS bf16_t* scr, int item, int lane, int qkcols, const float* shl = nullptr, float* shwp = nullptr) {
    const int nblk = N / 64, kb = item / nblk, nb = item % nblk, k0 = 64 * kb, n0 = 64 * nb;
    const int n4 = (lane & 15) * 4, kr = lane >> 4;
    f32x4 v[16];
#pragma unroll
    for (int i = 0; i < 16; ++i) v[i] = *(const f32x4*)(W + (size_t)(k0 + 4 * i + kr) * N + n0 + n4);
    float shv[5];
    if (shl) {
#pragma unroll
        for (int r = 0; r < 5; ++r) shv[r] = shl[(size_t)r * 6144 + k0 + lane]; }
#pragma unroll
    for (int i = 0; i < 16; ++i) { const int k = 4 * i + kr;
        scr[(n4 + 0) * 72 + k] = (bf16_t)f2bf(v[i].x); scr[(n4 + 1) * 72 + k] = (bf16_t)f2bf(v[i].y); scr[(n4 + 2) * 72 + k] = (bf16_t)f2bf(v[i].z); scr[(n4 + 3) * 72 + k] = (bf16_t)f2bf(v[i].w); }
    LAS float* shs = (LAS float*)(scr + 64 * 72);
    if (shl) {
#pragma unroll
        for (int r = 0; r < 5; ++r) shs[r * 64 + lane] = shv[r]; }
    LDS_WAIT(); asm volatile("" ::: "memory");
#pragma unroll
    for (int i = 0; i < 8; ++i) { const int n = 8 * i + (lane >> 3), kc = (lane & 7) * 8;
        const u32x4 o = *(const LAS u32x4*)(scr + n * 72 + kc);
        const int ns = n0 + n, nd = p0_dst_row(ns, qkcols);
        *(u32x4*)(WT + (size_t)nd * K + k0 + kc) = o; }
    if (shl) { float a0 = 0.f, a1 = 0.f, a2 = 0.f, a3 = 0.f, a4 = 0.f;
#pragma unroll 1
        for (int c = 0; c < 8; ++c) { const u32x4 w = *(const LAS u32x4*)(scr + lane * 72 + c * 8);
            const float wf[8] = {bflo(w.x), bfhi(w.x), bflo(w.y), bfhi(w.y), bflo(w.z), bfhi(w.z), bflo(w.w), bfhi(w.w)};
#pragma unroll
            for (int h = 0; h < 2; ++h) { const f32x4 s0 = *(const LAS f32x4*)(shs + c * 8 + h * 4), s1 = *(const LAS f32x4*)(shs + 64 + c * 8 + h * 4), s2 = *(const LAS f32x4*)(shs + 128 + c * 8 + h * 4),
                                 s3 = *(const LAS f32x4*)(shs + 192 + c * 8 + h * 4), s4 = *(const LAS f32x4*)(shs + 256 + c * 8 + h * 4);
#pragma unroll
                for (int e = 0; e < 4; ++e) { const float x = wf[h * 4 + e]; a0 += x * s0[e]; a1 += x * s1[e]; a2 += x * s2[e]; a3 += x * s3[e]; a4 += x * s4[e]; } } }
        const int nd = p0_dst_row(n0 + lane, qkcols); float* o = shwp + (size_t)kb * 5 * 8192 + nd;
        o[0] = a0; o[8192] = a1; o[2 * 8192] = a2; o[3 * 8192] = a3; o[4 * 8192] = a4; }
    LDS_WAIT(); asm volatile("" ::: "memory");
}
__device__ __forceinline__ void conv_job(const float* W, int N, bf16_t* WT, int qkcols, int shw_layer, unsigned char* ws, LAS unsigned char* ldsl, int wave, int lane, int widx, int nw) {
    LAS bf16_t* scr = (LAS bf16_t*)(ldsl + wave * 16384);
    const float* shl = shw_layer > 0 ? (const float*)(ws + WS_MODS) + (size_t)shw_layer * 5 * 6144 : nullptr;
    float* shwp = shw_layer > 0 ? (float*)(ws + WS_SHWP) + (size_t)(shw_layer - 1) * 32 * 5 * 8192 : nullptr;
    const int items = (DM / 64) * (N / 64);
    for (int it = widx; it < items; it += nw) { int l2 = lane; asm volatile("" : "+v"(l2));
        p0_transpose_item(W, DM, N, WT, scr, it, l2, qkcols, shl, shwp); }
}
__device__ __forceinline__ void sincos_d(float angf, float& s, float& c) {
    const double a = (double)angf; const double kq = rint(a * 0.63661977236758134308); const double r = a - kq * 1.57079632679489661923; const double r2 = r * r;
    const double sp = r * (1.0 + r2 * (-1.0 / 6 + r2 * (1.0 / 120 + r2 * (-1.0 / 5040 + r2 * (1.0 / 362880 + r2 * (-1.0 / 39916800 + r2 * (1.0 / 6227020800.0)))))));
    const double cp = 1.0 + r2 * (-0.5 + r2 * (1.0 / 24 + r2 * (-1.0 / 720 + r2 * (1.0 / 40320 + r2 * (-1.0 / 3628800 + r2 * (1.0 / 479001600.0))))));
    const int q = ((int)kq) & 3;
    const double ss = (q == 0) ? sp : (q == 1) ? cp : (q == 2) ? -sp : -cp;
    const double cc = (q == 0) ? cp : (q == 1) ? -sp : (q == 2) ? -cp : sp;
    s = (float)ss; c = (float)cc;
}

__device__ __forceinline__ void ada_fill_sil(CArgsP ap, LAS float* sil, int tid) {
    for (int i = tid; i < 5 * DM; i += NWAVES * 64) { const int r = i / DM, k = i - r * DM; const float v = (r < 4) ? ap->in[I_C][r * DM + k] : ap->in[I_CCTX][k]; sil[i] = siluf_(v); }
}
__device__ __forceinline__ void ada_item(CArgsP ap, unsigned char* ws, const LAS float* sil, int l, int kc, int ng, int lane) {
    const int nq = ng * 64 + lane;
    const float* wp = ap->in[I_ADAW] + ((size_t)l * DM + kc * 128) * 6144 + nq * 4;
    f32x4 a0 = {0, 0, 0, 0}, a1 = a0, a2 = a0, a3 = a0, a4 = a0;
#pragma unroll 8
    for (int k = 0; k < 128; ++k) { const f32x4 w = *(const f32x4*)(wp + (size_t)k * 6144); const int kk = kc * 128 + k;
        a0 += w * sil[kk]; a1 += w * sil[DM + kk]; a2 += w * sil[2 * DM + kk]; a3 += w * sil[3 * DM + kk]; a4 += w * sil[4 * DM + kk]; }
    if (kc == 0) { const f32x4 bv = *(const f32x4*)(ap->in[I_ADAB] + l * 6144 + nq * 4); a0 += bv; a1 += bv; a2 += bv; a3 += bv; a4 += bv; }
    float* mp = (float*)(ws + WS_AGG) + ((size_t)(kc * 4 + l) * 5) * 6144 + nq * 4;
    *(f32x4*)(mp) = a0; *(f32x4*)(mp + 6144) = a1; *(f32x4*)(mp + 2 * 6144) = a2; *(f32x4*)(mp + 3 * 6144) = a3; *(f32x4*)(mp + 4 * 6144) = a4;
}
__device__ __forceinline__ void ada_layer(CArgsP ap, unsigned char* ws, const LAS float* sil, int l, int lane, int widx, int nw) {
    for (int it = widx; it < 384; it += nw) ada_item(ap, ws, sil, l, it / 24, it % 24, lane);
}
__device__ __forceinline__ void mods_reduce(CArgsP ap, unsigned char* ws, int l, int gt_, int NGT) {
    const float* part = (const float*)(ws + WS_AGG) + (size_t)l * 5 * 6144; float* mods = (float*)(ws + WS_MODS) + (size_t)l * 5 * 6144; float* GM = (float*)(ws + WS_GM) + (size_t)l * 5 * DM;
    for (int it = gt_; it < 5 * 6144 / 4; it += NGT) { f32x4 acc = {0.f, 0.f, 0.f, 0.f};
#pragma unroll
        for (int kc = 0; kc < 16; ++kc) acc += *(const f32x4*)(part + (size_t)kc * 4 * 5 * 6144 + (size_t)it * 4);
        *(f32x4*)(mods + (size_t)it * 4) = acc;
        const int r = (it * 4) / 6144, c = it * 4 - r * 6144;
        if (l >= 1 && c >= DM && c < 2 * DM) { const f32x4 g = *(const f32x4*)(ap->in[I_NORMG] + l * DM + (c - DM)); *(f32x4*)(GM + (size_t)r * DM + (c - DM)) = g * (acc + 1.0f); } }
}

__device__ __forceinline__ void fresh_ids(LAS unsigned char* ldsl, int& bx, int& wave, int& lane) {
    bx = __builtin_amdgcn_readfirstlane((int)((volatile LAS unsigned*)(ldsl + MISC_OFF))[12]); wave = __builtin_amdgcn_readfirstlane((int)((volatile LAS unsigned*)(ldsl + LDSCTL_OFF))[hw_slot()]); lane = lane_id_opaque();
    asm volatile("" : "+s"(bx), "+s"(wave), "+v"(lane));
}

enum { K_PRO, K_MODRED, K_PRE0, K_GEMM_BF16, K_GEMM_RES, K_GEMM_GATES, K_QKPOST, K_ATT_A, K_ATT_B, K_COMBINE, K_CONV, K_SCAN_AGG, K_SCAN_APPLY, K_FINAL };
template <int KIND, int layer, int PH, bool DUPRUN = false>
__device__ __forceinline__ void run_phase(char* ldsg, int wave_s) {
    LAS unsigned char* ldsl = (LAS unsigned char*)ldsg;
    CArgsP ap = (CArgsP)__builtin_amdgcn_kernarg_segment_ptr();
    asm volatile("" : "+s"(ap));
    int G = pg8::GRID, bx = __builtin_amdgcn_readfirstlane((int)((volatile LAS unsigned*)(ldsl + MISC_OFF))[12]), wave = wave_s;
    asm volatile("" : "+s"(G)); asm volatile("" : "+s"(bx)); asm volatile("" : "+s"(wave));
    int tid = wave * 64 + lane_id_opaque();
    asm volatile("" : "+v"(tid));
    const int lane = tid & 63;
    const int vcu = (G % 8 == 0) ? (bx % 8) * (G / 8) + bx / 8 : bx;
    const int gw = vcu * NWAVES + wave, NGW = G * NWAVES;
    const int gt_ = vcu * NWAVES * 64 + tid, NGT = G * NWAVES * 64;
    unsigned char* ws = ap->ws;
    float* mods = (float*)(ws + WS_MODS);
    float* tabc = (float*)(ws + WS_TAB); float* tabs = tabc + 96 * 32; float* c8t = (float*)(ws + WS_TAB + 65536);
    bf16_t* WA_IN = (bf16_t*)(ws + WS_WA_IN); bf16_t* WA_OUT = (bf16_t*)(ws + WS_WA_OUT); bf16_t* WB_IN = (bf16_t*)(ws + WS_WB_IN); bf16_t* WB_OUT = (bf16_t*)(ws + WS_WB_OUT);
    bf16_t* WR_IN = (bf16_t*)(ws + WS_WR_IN); bf16_t* WR_OUT = (bf16_t*)(ws + WS_WR_OUT); bf16_t* WG = (bf16_t*)(ws + WS_WG);
    float* X = (float*)(ws + WS_X); bf16_t* H = (bf16_t*)(ws + WS_H); bf16_t* Y = (bf16_t*)(ws + WS_Y); bf16_t* U = (bf16_t*)(ws + WS_U); bf16_t* OD = (bf16_t*)(ws + WS_OD);
    unsigned* SAB = (unsigned*)(ws + WS_SA); float* AGG = (float*)(ws + WS_AGG);
    bf16_t* UP = (bf16_t*)(ws + WS_UP); float* GM = (float*)(ws + WS_GM); float* SHW = (float*)(ws + WS_SHW); float* SSQ = (float*)(ws + WS_SSQ);
    (void)GM; (void)SHW; (void)SSQ; (void)mods; (void)tabc; (void)tabs; (void)c8t; (void)WA_IN; (void)WA_OUT; (void)WB_IN; (void)WB_OUT; (void)WR_IN; (void)WR_OUT; (void)WG; (void)X; (void)H; (void)Y; (void)U; (void)OD; (void)SAB; (void)AGG; (void)UP;
    (void)gw; (void)NGW; (void)gt_; (void)NGT; (void)lane; (void)ldsl;

    if constexpr (KIND == K_PRO) {
        {
            LAS float* sil = (LAS float*)ldsl;
            LAS int* ctr = (LAS int*)(ldsl + 40960 + NWAVES * 9216);
            if (tid == 0) *ctr = 0;
            ada_fill_sil(ap, sil, tid); __syncthreads();
            if (wave < 3) { const int it = bx + 256 * wave; ada_item(ap, ws, sil, it / 384, (it % 384) / 24, it % 24, lane); }
            LAS bf16_t* scr = (LAS bf16_t*)(ldsl + 40960 + wave * 9216);
            constexpr int I_AIN = (DM / 64) * (A_IN / 64), I_SQ = (DM / 64) * (DM / 64), I_BIN = (DM / 64) * (B_IN / 64);
            constexpr int NITEMS = I_AIN + I_SQ + I_BIN;
            static_assert(NITEMS % pg8::GRID == 0, "item list per workgroup");
            for (;;) {
                int k = 0; if (lane == 0) k = __hip_atomic_fetch_add(ctr, 1, __ATOMIC_RELAXED, __HIP_MEMORY_SCOPE_WORKGROUP);
                k = __builtin_amdgcn_readfirstlane(k); if (k >= NITEMS / pg8::GRID) break;
                int r = vcu + pg8::GRID * k;
                if (r < I_AIN) { p0_transpose_item(ap->in[I_AWIN], DM, A_IN, WA_IN, scr, r, lane, 2560); continue; } r -= I_AIN;
                if (r < I_SQ) { p0_transpose_item(ap->in[I_AWOUT], DM, DM, WA_OUT, scr, r, lane, 0); continue; } r -= I_SQ;
                p0_transpose_item(ap->in[I_BWIN], DM, B_IN, WB_IN, scr, r, lane, 4096);
            }
        }
        for (int it = gt_; it < 96 * 32; it += NGT) { const int pos = it >> 5, j = it & 31; const float freq = powf(10000.0f, -(float)j / 32.0f); const float p = (float)(pos < 32 ? pos : pos - 32);
            float s, c; sincos_d(p * freq, s, c); tabc[it] = c; tabs[it] = s; }
        for (int it = gt_; it < 2 * DM; it += NGT) { const float lam = ap->in[I_RLAM][it]; const float z = -lam; const float sp = fmaxf(z, 0.f) + log1pf(__expf(-fabsf(z))); c8t[it] = 8.0f * sp; }
    }
    else if constexpr (KIND == K_MODRED) {
        mods_reduce(ap, ws, 0, gt_, NGT); mods_reduce(ap, ws, 1, gt_, NGT);
    }
    else if constexpr (KIND == K_PRE0) {
        { const float* gsrc = ap->in[I_NORMG];
          for (int row = gw; row < MROWS; row += NGW) {
            const int b = row / TT, t = row - b * TT; const float* mrow = mods + (size_t)(t < CTXL ? 4 : b) * 6144;
            const float* xsrc = (t < CTXL) ? ap->in[I_CTX] + (size_t)(b * CTXL + t) * DM : ap->in[I_X] + (size_t)(b * SEQ + t - CTXL) * DM;
            const f32x4* xr = (const f32x4*)xsrc + lane; f32x4 v[8]; float s = 0.f;
#pragma unroll
            for (int j = 0; j < 8; ++j) { v[j] = xr[64 * j]; s += (v[j].x * v[j].x + v[j].y * v[j].y) + (v[j].z * v[j].z + v[j].w * v[j].w); }
            s = wave_sum(s);
            if (lane < 32) SSQ[(size_t)row * 32 + lane] = (lane == 0) ? s : 0.f;
            u32x2* o8 = (u32x2*)(H + (size_t)row * DM) + lane;
#pragma unroll
            for (int j = 0; j < 8; ++j) { const int c = 4 * lane + 256 * j; const f32x4 g = *(const f32x4*)(gsrc + c), sc = *(const f32x4*)(mrow + DM + c);
                const f32x4 y = v[j] * g * (sc + 1.0f); u32x2 w; w.x = pk2(y.x, y.y); w.y = pk2(y.z, y.w); o8[64 * j] = w; }
          } }
        for (int l = 0; l < 2; ++l) {
            LAS float* shl = (LAS float*)ldsl;
            __syncthreads();
            for (int i = tid; i < 5 * DM; i += NWAVES * 64) { const int r = i >> 11, k = i & (DM - 1); shl[i] = mods[(size_t)(l * 5 + r) * 6144 + k]; }
            __syncthreads();
            const bf16_t* Wt = (l == 0) ? WA_IN : (l == 3) ? WA_IN + (size_t)A_IN * DM : (l == 1) ? WB_IN : WR_IN; const int N = (l == 1) ? B_IN : (l == 2) ? R_IN : A_IN;
            for (int n = gw; n < N; n += NGW) { float a0 = 0.f, a1 = 0.f, a2 = 0.f, a3 = 0.f, a4 = 0.f;
#pragma unroll
                for (int j = 0; j < 4; ++j) { const int k0 = j * 512 + lane * 8; const u32x4 w = *(const u32x4*)(Wt + (size_t)n * DM + k0);
                    const float wf[8] = {bflo(w.x), bfhi(w.x), bflo(w.y), bfhi(w.y), bflo(w.z), bfhi(w.z), bflo(w.w), bfhi(w.w)};
#pragma unroll
                    for (int e = 0; e < 8; ++e) { a0 += wf[e] * shl[k0 + e]; a1 += wf[e] * shl[DM + k0 + e]; a2 += wf[e] * shl[2 * DM + k0 + e]; a3 += wf[e] * shl[3 * DM + k0 + e]; a4 += wf[e] * shl[4 * DM + k0 + e]; } }
                a0 = wave_sum(a0); a1 = wave_sum(a1); a2 = wave_sum(a2); a3 = wave_sum(a3); a4 = wave_sum(a4);
                if (lane == 0) { float* o = SHW + (size_t)l * 5 * 8192 + n; o[0] = a0; o[8192] = a1; o[2 * 8192] = a2; o[3 * 8192] = a3; o[4 * 8192] = a4; } }
        }
    }
    else if constexpr (KIND == K_GEMM_BF16) {
        constexpr size_t OB = (layer == 0) ? WS_WA_IN : (layer == 3) ? WS_WA_IN + (size_t)A_IN * DM * 2 : (layer == 1) ? WS_WB_IN : WS_WR_IN;
        constexpr int N = (layer == 1) ? B_IN : (layer == 2) ? R_IN : A_IN;
        pg8::EpiBf16<layer, N> E{ws, ap};
        if constexpr (layer == 0) {
            typedef pg8::Sched<MROWS / 256, N / 256, DM / 64, 0, 0, TAIL_SPLIT> SchedT; SchedT S; S.init(bx, vcu);
            pg8::gemm_phase<pg8::EpiBf16<layer, N>, SchedT, DM / 64, PH, WS_H, OB>(ldsl, tid, S, E);
            if constexpr (!DUPRUN && SchedT::F == 1 && SchedT::T > 0) { int bx, wave, lane; fresh_ids(ldsl, bx, wave, lane); const int tid = wave * 64 + lane; if (bx >= SchedT::T) {
                CArgsP ap2 = (CArgsP)__builtin_amdgcn_kernarg_segment_ptr(); asm volatile("" : "+s"(ap2)); const CArgsP ap = ap2; unsigned char* const ws = ap2->ws;
                const int widx = (bx - SchedT::T) * NWAVES + wave, nw = (pg8::GRID - SchedT::T) * NWAVES;
                LAS float* sil = (LAS float*)ldsl; ada_fill_sil(ap, sil, tid); __syncthreads(); ada_layer(ap, ws, sil, 2, lane, widx, nw); ada_layer(ap, ws, sil, 3, lane, widx, nw); } }
        } else {
            constexpr int CLO = (layer == 3) ? 8 : 0, CHI = (layer == 3) ? 12 : N / 256;
            typedef pg8::SchedM<N / 256, DM / 64, CLO, CHI> SchedT; SchedT S; S.init(bx, vcu);
            constexpr size_t OB0 = (layer == 1) ? WS_WA_OUT : (layer == 2) ? WS_WB_OUT : WS_WR_OUT;
            pg8::EpiResid<layer - 1, false> E0{ws, ap};
            pg8::gemm_phase<pg8::EpiBf16<layer, N>, SchedT, DM / 64, PH, WS_H, OB, pg8::EpiResid<layer - 1, false>, WS_Y, OB0>(ldsl, tid, S, E, E0);
            if constexpr (!DUPRUN && SchedT::T > 0) { int bx, wave, lane; fresh_ids(ldsl, bx, wave, lane); const int tid = wave * 64 + lane; (void)tid; if (bx < SchedT::SH || bx >= SchedT::SH + SchedT::T) {
                CArgsP ap2 = (CArgsP)__builtin_amdgcn_kernarg_segment_ptr(); asm volatile("" : "+s"(ap2)); const CArgsP ap = ap2; unsigned char* const ws = ap2->ws;
                const int widx = ((bx < SchedT::SH) ? bx : bx - SchedT::T) * NWAVES + wave, nw = (pg8::GRID - SchedT::T) * NWAVES;
                if constexpr (layer == 1) { conv_job(ap->in[I_BWOUT], DM, (bf16_t*)(ws + WS_WB_OUT), 0, 0, ws, ldsl, wave, lane, widx, nw); conv_job(ap->in[I_RWIN], R_IN, (bf16_t*)(ws + WS_WR_IN), 0, 2, ws, ldsl, wave, lane, widx, nw); }
                if constexpr (layer == 2) { conv_job(ap->in[I_RWOUT], DM, (bf16_t*)(ws + WS_WR_OUT), 0, 0, ws, ldsl, wave, lane, widx, nw); conv_job(ap->in[I_AWIN] + (size_t)DM * A_IN, A_IN, (bf16_t*)(ws + WS_WA_IN) + (size_t)A_IN * DM, 2560, 3, ws, ldsl, wave, lane, widx, nw);
                    conv_job(ap->in[I_AWOUT] + (size_t)DM * DM, DM, (bf16_t*)(ws + WS_WA_OUT) + (size_t)DM * DM, 0, 0, ws, ldsl, wave, lane, widx, nw);
                    LAS bf16_t* scr = (LAS bf16_t*)(ldsl + wave * 16384);
                    for (int it = widx; it < 32 * 16; it += nw) { const int mtx = it >> 4, sub = it & 15; const int gate = mtx >> 4, dir = (mtx >> 3) & 1, nblk = mtx & 7;
                        p0_transpose_item((gate ? ap->in[I_RWX] : ap->in[I_RWA]) + (size_t)(dir * 8 + nblk) * 65536, 256, 256, (bf16_t*)(ws + WS_WG), scr, sub, lane, -(mtx + 1)); } } } }
        }
    }
    else if constexpr (KIND == K_GEMM_RES) {
        constexpr size_t OB = (layer == 0) ? WS_WA_OUT : (layer == 3) ? WS_WA_OUT + (size_t)DM * DM * 2 : (layer == 1) ? WS_WB_OUT : WS_WR_OUT;
        if constexpr ((layer == 1 || layer == 2) && !DUPRUN) {
            constexpr int LN = layer + 1, NN_ = (LN == 2) ? R_IN : A_IN;
            const float* pp = (const float*)(ws + WS_SHWP) + (size_t)(LN - 1) * 32 * 5 * 8192; float* dst = SHW + (size_t)LN * 5 * 8192;
            for (int i = gt_; i < 5 * NN_; i += NGT) { const int r = i / NN_, n = i - r * NN_; float pv[32];
#pragma unroll
                for (int kb = 0; kb < 32; ++kb) pv[kb] = pp[(size_t)kb * 5 * 8192 + (size_t)r * 8192 + n];
                float sv = 0.f;
#pragma unroll
                for (int kb = 0; kb < 32; ++kb) sv += pv[kb];
                dst[(size_t)r * 8192 + n] = sv; }
        }
        if constexpr (layer == 1 && !DUPRUN) {
            float s1 = ap->in[I_BLAM][lane] * ap->in[I_BLAM][128 + lane] + ap->in[I_BLAM][64 + lane] * ap->in[I_BLAM][192 + lane];
            float s2 = ap->in[I_BLAM][256 + lane] * ap->in[I_BLAM][384 + lane] + ap->in[I_BLAM][320 + lane] * ap->in[I_BLAM][448 + lane];
            s1 = wave_sum(s1); s2 = wave_sum(s2);
            const float lam = expf(s1) - expf(s2) + LAM_INIT1;
            const int hsel = lane >> 5, j = lane & 31;
            for (int it = gw; it < NB * CTXL * 4; it += NGW) { const int cr = it >> 2, row = (cr >> 8) * TT + (cr & 255), h = (it & 3) * 2 + hsel;
                const u32x4 r0 = *(const u32x4*)(OD + (size_t)row * 4096 + h * 256 + j * 8), r1 = *(const u32x4*)(OD + (size_t)row * 4096 + (8 + h) * 256 + j * 8), zr = *(const u32x4*)(U + (size_t)row * B_IN + 6144 + h * 256 + j * 8);
                float o[8] = {bflo(r0.x) - lam * bflo(r1.x), bfhi(r0.x) - lam * bfhi(r1.x), bflo(r0.y) - lam * bflo(r1.y), bfhi(r0.y) - lam * bfhi(r1.y),
                              bflo(r0.z) - lam * bflo(r1.z), bfhi(r0.z) - lam * bfhi(r1.z), bflo(r0.w) - lam * bflo(r1.w), bfhi(r0.w) - lam * bfhi(r1.w)};
                const float z[8] = {bflo(zr.x), bfhi(zr.x), bflo(zr.y), bfhi(zr.y), bflo(zr.z), bfhi(zr.z), bflo(zr.w), bfhi(zr.w)};
                float ss = 0.f;
#pragma unroll
                for (int k = 0; k < 8; ++k) ss += o[k] * o[k];
                ss += shx<1>(ss); ss += shx<2>(ss); ss += shx<4>(ss); ss += shx<8>(ss); ss += shx<16>(ss);
                const float rstd = frsq(ss * (1.0f / 256.0f) + EPS); const float* sg = ap->in[I_BSUBG] + j * 8;
#pragma unroll
                for (int k = 0; k < 8; ++k) o[k] = (o[k] * rstd * sg[k]) * (1.0f - LAM_INIT1) * siluf_(z[k]);
                u32x4 w; w.x = pk2(o[0], o[1]); w.y = pk2(o[2], o[3]); w.z = pk2(o[4], o[5]); w.w = pk2(o[6], o[7]);
                *(u32x4*)(Y + (size_t)row * DM + h * 256 + j * 8) = w; }
        }
        typedef pg8::Sched<32, DM / 256, DM / 64, 1, 0, TAIL_SPLIT> SchedT; SchedT S; S.init(bx, vcu);
        pg8::EpiResid<layer, DUPRUN> E{ws, ap};
        pg8::gemm_phase<pg8::EpiResid<layer, DUPRUN>, SchedT, DM / 64, PH, WS_Y, OB>(ldsl, tid, S, E);
    }
    else if constexpr (KIND == K_GEMM_GATES) {
        typedef pg8::Sched<MROWS / 256, 32, 4, 0, 1, false> SchedT; SchedT S; S.init(bx, vcu);
        pg8::EpiGates E{ws, ap};
        pg8::gemm_phase<pg8::EpiGates, SchedT, 4, PH, WS_UP, WS_WG>(ldsl, tid, S, E);
    }
    else if constexpr (KIND == K_ATT_A) {
        if constexpr (layer == 0 && !DUPRUN) { mods_reduce(ap, ws, 2, gt_, NGT); mods_reduce(ap, ws, 3, gt_, NGT); }
        const int nlat = 512, ntot = (layer == 0) ? 576 : 512;
        for (int u = vcu; u < ntot; u += G) {
            int b, h, qrow, seq;
            if (u < nlat) { const int qb = u & 7, hh = (u >> 3) & 15; b = u >> 7; h = hh; qrow = b * TT + CTXL + qb * 256; seq = TT; }
            else { const int v = u - nlat; b = v >> 4; h = v & 15; qrow = b * TT; seq = CTXL; }
            const int g4 = h >> 2;
            const bf16_t* Qb = U + (size_t)qrow * A_IN + h * 128;
            const bf16_t* Kh = U + (size_t)(b * TT) * A_IN + 2048 + g4 * 128;
            const bf16_t* Vh = U + (size_t)(b * TT) * A_IN + 2560 + g4 * 128;
            const bf16_t* Zb = U + (size_t)qrow * A_IN + 3072 + h * 128;
            att::attn_unit_dma<A_IN, DM, true>(Qb, Kh, Vh, Y + (size_t)qrow * DM + h * 128, Zb, seq, ldsg, tid);
        }
    }
    else if constexpr (KIND == K_ATT_B) {
        float s1 = ap->in[I_BLAM][lane] * ap->in[I_BLAM][128 + lane] + ap->in[I_BLAM][64 + lane] * ap->in[I_BLAM][192 + lane];
        float s2 = ap->in[I_BLAM][256 + lane] * ap->in[I_BLAM][384 + lane] + ap->in[I_BLAM][320 + lane] * ap->in[I_BLAM][448 + lane];
        s1 = wave_sum(s1); s2 = wave_sum(s2);
        const float lam = expf(s1) - expf(s2) + LAM_INIT1;
        for (int u = vcu; u < 640; u += G) {
            if (u < 512) { const int qb = u & 15, h = (u >> 4) & 7, b = u >> 7; att::attn_unit_pair<B_IN, 4096>(ws, ap, lam, b * TT + CTXL + qb * 128, b, h, TT, ldsg, tid); }
            else { const int v = u - 512; const int m = v & 1, qh = (v >> 1) & 1, h = (v >> 2) & 7, b = v >> 5; att::attn_unit_pair_one<B_IN, 4096>(ws, ap, b * TT + qh * 128, b, h, m, CTXL, ldsg, tid); }
        }
    }
    else if constexpr (KIND == K_COMBINE) {
        float s1 = ap->in[I_BLAM][lane] * ap->in[I_BLAM][128 + lane] + ap->in[I_BLAM][64 + lane] * ap->in[I_BLAM][192 + lane];
        float s2 = ap->in[I_BLAM][256 + lane] * ap->in[I_BLAM][384 + lane] + ap->in[I_BLAM][320 + lane] * ap->in[I_BLAM][448 + lane];
        s1 = wave_sum(s1); s2 = wave_sum(s2);
        const float lam = expf(s1) - expf(s2) + LAM_INIT1;
        const int hsel = lane >> 5, j = lane & 31;
        for (int it0 = gw; it0 < MROWS * 4; it0 += 2 * NGW) {
            u32x4 r0v[2], r1v[2], zrv[2]; bool ok[2];
#pragma unroll
            for (int q = 0; q < 2; ++q) { const int it = it0 + q * NGW; ok[q] = it < MROWS * 4; const int itc = ok[q] ? it : 0; const int row = itc >> 2, h = (itc & 3) * 2 + hsel;
                r0v[q] = *(const u32x4*)(OD + (size_t)row * 4096 + h * 256 + j * 8); r1v[q] = *(const u32x4*)(OD + (size_t)row * 4096 + (8 + h) * 256 + j * 8); zrv[q] = *(const u32x4*)(U + (size_t)row * B_IN + 6144 + h * 256 + j * 8); }
#pragma unroll
            for (int q = 0; q < 2; ++q) if (ok[q]) { const int it = it0 + q * NGW; const int row = it >> 2, h = (it & 3) * 2 + hsel; const u32x4 r0 = r0v[q], r1 = r1v[q], zr = zrv[q];
                float o[8] = {bflo(r0.x) - lam * bflo(r1.x), bfhi(r0.x) - lam * bfhi(r1.x), bflo(r0.y) - lam * bflo(r1.y), bfhi(r0.y) - lam * bfhi(r1.y),
                              bflo(r0.z) - lam * bflo(r1.z), bfhi(r0.z) - lam * bfhi(r1.z), bflo(r0.w) - lam * bflo(r1.w), bfhi(r0.w) - lam * bfhi(r1.w)};
                const float z[8] = {bflo(zr.x), bfhi(zr.x), bflo(zr.y), bfhi(zr.y), bflo(zr.z), bfhi(zr.z), bflo(zr.w), bfhi(zr.w)};
                float ss = 0.f;
#pragma unroll
                for (int k = 0; k < 8; ++k) ss += o[k] * o[k];
                ss += shx<1>(ss); ss += shx<2>(ss); ss += shx<4>(ss); ss += shx<8>(ss); ss += shx<16>(ss);
                const float rstd = frsq(ss * (1.0f / 256.0f) + EPS); const float* sg = ap->in[I_BSUBG] + j * 8;
#pragma unroll
                for (int k = 0; k < 8; ++k) o[k] = (o[k] * rstd * sg[k]) * (1.0f - LAM_INIT1) * siluf_(z[k]);
                u32x4 w; w.x = pk2(o[0], o[1]); w.y = pk2(o[2], o[3]); w.z = pk2(o[4], o[5]); w.w = pk2(o[6], o[7]);
                *(u32x4*)(Y + (size_t)row * DM + h * 256 + j * 8) = w; }
        }
    }
    else if constexpr (KIND == K_CONV) {
        const int c8 = (gt_ & 255) * 8;
        f32x4 wv[4][2], bv[2];
#pragma unroll
        for (int jj = 0; jj < 4; ++jj) { wv[jj][0] = *(const f32x4*)(ap->in[I_RCONVW] + jj * DM + c8); wv[jj][1] = *(const f32x4*)(ap->in[I_RCONVW] + jj * DM + c8 + 4); }
        bv[0] = *(const f32x4*)(ap->in[I_RCONVB] + c8); bv[1] = *(const f32x4*)(ap->in[I_RCONVB] + c8 + 4);
        for (int it = gt_; it < (MROWS / 4) * 256; it += NGT) {
            const int row0 = (it >> 8) * 4; const int b = row0 / TT, t0 = row0 - b * TT; const int lo = (t0 < CTXL) ? 0 : CTXL, hi_ = (t0 < CTXL) ? CTXL : TT;
            u32x4 rv[7];
#pragma unroll
            for (int q = 0; q < 7; ++q) { const int ts = t0 + q - 2; rv[q] = (ts >= lo && ts < hi_) ? *(const u32x4*)(U + (size_t)(b * TT + ts) * R_IN + c8) : (u32x4){0u, 0u, 0u, 0u}; }
#pragma unroll
            for (int r = 0; r < 4; ++r) { f32x4 a0 = bv[0], a1 = bv[1];
#pragma unroll
                for (int jj = 0; jj < 4; ++jj) { const u32x4 x = rv[r + jj]; a0 += (f32x4){bflo(x.x), bfhi(x.x), bflo(x.y), bfhi(x.y)} * wv[jj][0]; a1 += (f32x4){bflo(x.z), bfhi(x.z), bflo(x.w), bfhi(x.w)} * wv[jj][1]; }
                u32x4 o; o.x = pk2(a0.x, a0.y); o.y = pk2(a0.z, a0.w); o.z = pk2(a1.x, a1.y); o.w = pk2(a1.z, a1.w);
                *(u32x4*)(UP + (size_t)(row0 + r) * DM + c8) = o; }
        }
    }
    else if constexpr (KIND == K_SCAN_AGG) {
        const float* __restrict__ AGA = (const float*)(ws + WS_AG16); const float* __restrict__ AGB = AGA + (size_t)576 * 2 * DM; float* __restrict__ CAR = (float*)(ws + WS_CARRY);
        if (wave == 0 && vcu < 256) { const int b = vcu >> 6, dir = (vcu >> 5) & 1, ch = (vcu & 31) * 64 + lane; float h = 0.f;
            for (int k = 0; k < 9; ++k) {
                float av[16], bv[16]; unsigned off[16];
#pragma unroll
                for (int j = 0; j < 16; ++j) { const int q = 16 * k + j; const int c = dir ? (q < 16 ? 15 - q : 159 - q) : q; off[j] = (unsigned)(((b * 144 + c) * 2 + dir) * DM + ch); av[j] = AGA[off[j]]; bv[j] = AGB[off[j]]; }
#pragma unroll
                for (int j = 0; j < 16; ++j) { CAR[off[j]] = h; h = fmaf(av[j], h, bv[j]); }
            } }
    }
    else if constexpr (KIND == K_SCAN_APPLY) {
        const float* __restrict__ CAR = (const float*)(ws + WS_CARRY); const unsigned* __restrict__ SABr = SAB; const bf16_t* __restrict__ Ur = U; bf16_t* __restrict__ Yr = Y;
        for (int it = gt_; it < 576 * 512; it += NGT) {
            const int c4 = it & 511, g = it >> 9; const unsigned r0 = (unsigned)g * 16u;
            f32x4 hf = *(const f32x4*)(CAR + ((size_t)g * 2) * DM + c4 * 4), hr = *(const f32x4*)(CAR + ((size_t)g * 2 + 1) * DM + c4 * 4);
            u32x4 wf[16], wrv[16]; u32x2 zr[16];
#pragma unroll
            for (int s = 0; s < 16; ++s) { wf[s] = *(const u32x4*)(SABr + ((size_t)(r0 + s) * 2) * DM + c4 * 4); wrv[s] = *(const u32x4*)(SABr + ((size_t)(r0 + s) * 2 + 1) * DM + c4 * 4); zr[s] = *(const u32x2*)(Ur + (size_t)(r0 + s) * R_IN + DM + c4 * 4); }
            f32x4 hfv[16];
#pragma unroll
            for (int s = 0; s < 16; ++s) { const u32x4 w = wf[s];
                const f32x4 a = {__expf(bflo(w.x)), __expf(bflo(w.y)), __expf(bflo(w.z)), __expf(bflo(w.w))}, bb = {bfhi(w.x), bfhi(w.y), bfhi(w.z), bfhi(w.w)}; hf = a * hf + bb; hfv[s] = hf; }
#pragma unroll
            for (int s = 15; s >= 0; --s) { const u32x4 w = wrv[s];
                const f32x4 a = {__expf(bflo(w.x)), __expf(bflo(w.y)), __expf(bflo(w.z)), __expf(bflo(w.w))}, bb = {bfhi(w.x), bfhi(w.y), bfhi(w.z), bfhi(w.w)}; hr = a * hr + bb;
                const f32x4 y = hfv[s] + hr;
                u32x2 o; o.x = pk2(y.x * siluf_(bflo(zr[s].x)), y.y * siluf_(bfhi(zr[s].x))); o.y = pk2(y.z * siluf_(bflo(zr[s].y)), y.w * siluf_(bfhi(zr[s].y)));
                *(u32x2*)(Yr + (size_t)(r0 + s) * DM + c4 * 4) = o; }
        }
    }
    else {
        const float* gsrc = ap->in[I_NORMF];
        for (int r = gw; r < NB * SEQ; r += NGW) {
            const int b = r >> 11, t = r & (SEQ - 1); const size_t row = (size_t)b * TT + CTXL + t;
            const f32x4* xr = (const f32x4*)(X + row * DM) + lane; f32x4 v[8]; float s = 0.f;
#pragma unroll
            for (int j = 0; j < 8; ++j) { v[j] = xr[64 * j]; s += (v[j].x * v[j].x + v[j].y * v[j].y) + (v[j].z * v[j].z + v[j].w * v[j].w); }
            const float rstd = 1.0f / sqrtf(wave_sum(s) * (1.0f / DM) + EPS);
            f32x4* o = (f32x4*)(ap->out + (size_t)r * DM) + lane;
#pragma unroll
            for (int j = 0; j < 8; ++j) { const f32x4 g = *(const f32x4*)(gsrc + 4 * lane + 256 * j); o[64 * j] = (v[j] * rstd) * g; }
        }
    }
}

constexpr int N_PHASES_C = 19;
__global__ void __launch_bounds__(NWAVES * 64, 2) fwd_mega(Args args) {
    extern __shared__ __attribute__((aligned(16))) unsigned char lds[];
    LAS unsigned char* ldsl0 = (LAS unsigned char*)lds;
    for (int u = threadIdx.x; u < (LDS_BYTES - LDSCTL_OFF) / 4; u += NWAVES * 64) ((LAS unsigned*)(ldsl0 + LDSCTL_OFF))[u] = 0u;
    __syncthreads();
    { const int wv = __builtin_amdgcn_readfirstlane((int)threadIdx.x >> 6); if ((threadIdx.x & 63) == 0) ((volatile LAS unsigned*)(ldsl0 + LDSCTL_OFF))[hw_slot()] = (unsigned)wv;
      if (threadIdx.x == 0) ((volatile LAS unsigned*)(ldsl0 + MISC_OFF))[12] = blockIdx.x;
      if (!MK_PER_PHASE) (void)xcd_barrier_post((unsigned*)((gu32*)(args.ws + WS_CTL) + CW_BAR), (volatile LAS unsigned*)(ldsl0 + MISC_OFF) + 8, threadIdx.x == 0); }
    __syncthreads();
#define WAVE_IDX() ((int)__builtin_amdgcn_readfirstlane((int)((volatile LAS unsigned*)((LAS unsigned char*)lds + LDSCTL_OFF))[hw_slot()]))
#define KARG() ({ CArgsP ap_ = (CArgsP)__builtin_amdgcn_kernarg_segment_ptr(); asm volatile("" : "+s"(ap_)); ap_; })
#define GRID_BAR() do { CArgsP ap_ = KARG(); XcdBarrier b_; b_.bar = (unsigned*)((gu32*)(ap_->ws + WS_CTL) + CW_BAR); b_.x = xb_xcc_id(); b_.st = (volatile LAS unsigned*)((LAS unsigned char*)lds + MISC_OFF) + 8; xcd_barrier(b_, WAVE_IDX()); } while (0)
#if MK_PER_PHASE
#define PHASE(k, KIND, LAYER) if constexpr ((PH_MASK >> (k)) & 1) { CArgsP apq_ = KARG(); const int lo = apq_->ph_lo, hi = apq_->ph_hi; if (lo <= (k) && (k) < hi) { run_phase<KIND, LAYER, (k)>((char*)lds, WAVE_IDX()); } }
#else
#define PHASE(k, KIND, LAYER) if constexpr ((PH_MASK >> (k)) & 1) { run_phase<KIND, LAYER, (k)>((char*)lds, WAVE_IDX()); \
        if constexpr ((DUP_MASK >> (k)) & 1) { GRID_BAR(); run_phase<KIND, LAYER, 24 + ((k) & 7), true>((char*)lds, WAVE_IDX()); } \
        if constexpr ((k) + 1 < N_PHASES_C) { GRID_BAR(); if (DUP_BAR) GRID_BAR(); } }
#endif
    PHASE(0, K_PRO, 0) PHASE(1, K_MODRED, 0) PHASE(2, K_PRE0, 0)
    PHASE(3, K_GEMM_BF16, 0) PHASE(4, K_ATT_A, 0) PHASE(5, K_GEMM_RES, 0)
    PHASE(6, K_GEMM_BF16, 1) PHASE(7, K_ATT_B, 1) PHASE(9, K_GEMM_RES, 1)
    PHASE(10, K_GEMM_BF16, 2) PHASE(11, K_CONV, 2) PHASE(12, K_GEMM_GATES, 2) PHASE(13, K_SCAN_AGG, 2) PHASE(14, K_SCAN_APPLY, 2) PHASE(15, K_GEMM_RES, 2)
    PHASE(16, K_GEMM_BF16, 3) PHASE(17, K_ATT_A, 3) PHASE(18, K_GEMM_RES, 3)
#undef PHASE
#undef GRID_BAR
#undef KARG
#undef WAVE_IDX
}

constexpr int N_PHASES = N_PHASES_C;
extern "C" void kernel_launch(void* const* d_in, const int* in_sizes, int n_in, void* d_out, int out_size, void* d_ws, size_t ws_size, hipStream_t stream) {
    static int grid = 0;
    if (grid == 0) {
        if (n_in != 25 || in_sizes[0] != NB * SEQ * DM || out_size != NB * SEQ * DM || ws_size < WS_END) {
            fprintf(stderr, "kernel_launch: unexpected shapes: n_in %d in0 %d out %d ws %zu (need %zu)\n", n_in, n_in > 0 ? in_sizes[0] : -1, out_size, ws_size, (size_t)WS_END); grid = -1; return; }
        int dev = 0, cus = 0, per_cu = 0;
        if (hipGetDevice(&dev) != hipSuccess || hipDeviceGetAttribute(&cus, hipDeviceAttributeMultiprocessorCount, dev) != hipSuccess) { fprintf(stderr, "kernel_launch: device query failed\n"); grid = -1; return; }
        if (hipFuncSetAttribute((const void*)fwd_mega, hipFuncAttributeMaxDynamicSharedMemorySize, LDS_BYTES) != hipSuccess) { fprintf(stderr, "kernel_launch: hipFuncSetAttribute failed\n"); grid = -1; return; }
        if (hipOccupancyMaxActiveBlocksPerMultiprocessor(&per_cu, (const void*)fwd_mega, NWAVES * 64, LDS_BYTES) != hipSuccess || per_cu < 1) { fprintf(stderr, "kernel_launch: occupancy query says %d blocks/CU\n", per_cu); grid = -1; (void)hipGetLastError(); return; }
        if (cus != 256) { fprintf(stderr, "kernel_launch: built for a 256-CU device (MI355X), found %d CUs; nothing launched\n", cus); grid = -1; return; }
        grid = cus;
    }
    if (grid < 0) return;
    (void)hipMemsetAsync((char*)d_ws + WS_CTL, 0, CTL_ZERO_BYTES, stream);
    Args a{};
    for (int i = 0; i < 25; ++i) a.in[i] = (const float*)d_in[i];
    a.out = (float*)d_out; a.ws = (unsigned char*)d_ws;
#if MK_PER_PHASE
    for (int p = 0; p < N_PHASES; ++p) { a.ph_lo = p; a.ph_hi = p + 1; hipLaunchKernelGGL(fwd_mega, dim3(grid), dim3(NWAVES * 64), LDS_BYTES, stream, a); }
#else
    a.ph_lo = 0; a.ph_hi = N_PHASES;
    void* kargs[] = {&a};
    hipError_t e = hipLaunchCooperativeKernel((const void*)fwd_mega, dim3(grid), dim3(NWAVES * 64), kargs, LDS_BYTES, stream);
    if (e != hipSuccess) fprintf(stderr, "kernel_launch: cooperative launch failed: %s (grid %d)\n", hipGetErrorString(e), grid);
#endif
}
```

```cpp
#include <hip/hip_runtime.h>
#include <cstdio>
#include <cstdint>
#include <cmath>

#ifndef PH_MASK
#define PH_MASK 0x7ffff
#endif
#ifndef DUP_MASK
#define DUP_MASK 0
#endif
#ifndef DUP_SUB
#define DUP_SUB 0
#endif
#ifndef DUP_BAR
#define DUP_BAR 0
#endif
#ifndef TAIL_SPLIT
#define TAIL_SPLIT false
#endif
#ifndef MK_PER_PHASE
#define MK_PER_PHASE 0
#endif

constexpr int NB = 4, SEQ = 2048, CTXL = 256, DM = 2048, TT = SEQ + CTXL  , MROWS = NB * TT  ;
constexpr int A_IN = 5120, B_IN = 8192, R_IN = 4096;
constexpr float EPS = 1e-6f;
constexpr int CH = 32, NCH = TT / CH  , NCC = CTXL / CH  ;
constexpr float LAM_INIT1 = 0.35550906759096927f;

typedef unsigned short bf16_t;
typedef short bf16x8 __attribute__((ext_vector_type(8)));
typedef short s16x4 __attribute__((ext_vector_type(4)));
typedef float f32x4 __attribute__((ext_vector_type(4)));
typedef float f32x8 __attribute__((ext_vector_type(8)));
typedef float f32x16 __attribute__((ext_vector_type(16)));
typedef unsigned u32x4 __attribute__((ext_vector_type(4)));
typedef unsigned u32x2 __attribute__((ext_vector_type(2)));
#define LAS __attribute__((address_space(3)))
#define GAS __attribute__((address_space(1)))

__device__ __forceinline__ unsigned pk2(float lo, float hi) { unsigned r; asm("v_cvt_pk_bf16_f32 %0, %1, %2" : "=v"(r) : "v"(lo), "v"(hi)); return r; }
__device__ __forceinline__ unsigned f2bf(float f) { return pk2(f, 0.f) & 0xffffu; }
__device__ __forceinline__ float bflo(unsigned w) { return __uint_as_float(w << 16); }
__device__ __forceinline__ float bfhi(unsigned w) { return __uint_as_float(w & 0xffff0000u); }
__device__ __forceinline__ float bf1(bf16_t v) { return __uint_as_float((unsigned)v << 16); }
__device__ __forceinline__ unsigned cvt_pk_bf16(float lo, float hi) { unsigned r; asm volatile("v_cvt_pk_bf16_f32 %0, %1, %2" : "=v"(r) : "v"(lo), "v"(hi)); return r; }
__device__ __forceinline__ float frcp(float x) { return __builtin_amdgcn_rcpf(x); }
__device__ __forceinline__ float frsq(float x) { return __builtin_amdgcn_rsqf(x); }
__device__ __forceinline__ float fsqrt_(float x) { return __builtin_amdgcn_sqrtf(x); }
__device__ __forceinline__ float sigmoidf_(float x) { return frcp(1.0f + __expf(-x)); }
__device__ __forceinline__ float siluf_(float x) { return x * frcp(1.0f + __expf(-x)); }
template <int M> __device__ __forceinline__ float shx(float v) { return __int_as_float(__builtin_amdgcn_ds_swizzle(__float_as_int(v), (M << 10) | 0x1f)); }
__device__ __forceinline__ float wave_sum(float v) {
    v += shx<1>(v); v += shx<2>(v); v += shx<4>(v); v += shx<8>(v); v += shx<16>(v);
    auto rr = __builtin_amdgcn_permlane32_swap(__float_as_uint(v), __float_as_uint(v), false, false);
    return __uint_as_float(rr[0]) + __uint_as_float(rr[1]);
}

constexpr size_t MiB = 1u << 20;
constexpr size_t WS_CTL = 0, WS_MODS = 1 * MiB, CTL_ZERO_BYTES = 2 * MiB;
constexpr size_t WS_GM = 2 * MiB + 128 * 1024;
constexpr size_t WS_SHW = 2 * MiB + 512 * 1024;
constexpr size_t WS_SSQ = 282 * MiB;
constexpr size_t WS_FSQ = 281 * MiB;
constexpr size_t WS_SHWP = 568 * MiB;
constexpr size_t WS_TAB = 2 * MiB;
constexpr size_t WS_WA_IN = 4 * MiB, WS_WA_OUT = 44 * MiB, WS_WB_IN = 60 * MiB, WS_WB_OUT = 92 * MiB, WS_WR_IN = 100 * MiB, WS_WR_OUT = 116 * MiB, WS_WG = 124 * MiB;
constexpr size_t WS_X = 128 * MiB;
constexpr size_t WS_H = 200 * MiB;
constexpr size_t WS_Y = 236 * MiB;
constexpr size_t WS_AGG = 272 * MiB;
constexpr size_t WS_U = 284 * MiB;
constexpr size_t WS_OD = 428 * MiB;
constexpr size_t WS_UP = 356 * MiB;
constexpr size_t WS_SA = 392 * MiB;
constexpr size_t WS_AG16 = 536 * MiB;
constexpr size_t WS_CARRY = 556 * MiB;
constexpr size_t WS_SLAB = 568 * MiB;
constexpr size_t WS_DUMMY = 632 * MiB;
constexpr size_t WS_END = 584 * MiB;
constexpr int CW_BAR = 4096, CW_SEAM = 16384;

struct Args { const float* in[25]; float* out; unsigned char* ws; int ph_lo, ph_hi; };
typedef const __attribute__((address_space(4))) Args* CArgsP;
enum { I_X = 0, I_C, I_CTX, I_CCTX, I_ADAW, I_ADAB, I_NORMG, I_NORMF, I_AWIN, I_AQG, I_AKG, I_AWOUT, I_BWIN, I_BLAM, I_BSUBG, I_BWOUT,
       I_RWIN, I_RCONVW, I_RCONVB, I_RWA, I_RBA, I_RWX, I_RBX, I_RLAM, I_RWOUT };


__host__ __device__ __forceinline__ int qk_pi(int c) { return (c & 64) | (((c >> 2) & 1) << 5) | (((c >> 3) & 7) << 2) | (c & 3); }
__host__ __device__ __forceinline__ int qk_pi_inv(int e) { return (e & 64) | (((e >> 2) & 7) << 3) | (((e >> 5) & 1) << 2) | (e & 3); }

namespace pg8 {
constexpr int BM = 256, BK = 64, HALF = 128, HTB = HALF * BK * 2, STAGE_BYTES = 8 * HTB, NXCD = 8, WGM = 8;
__host__ __device__ __forceinline__ int lds_byte(int r, int c) { const int st = (r >> 4) * 2 + (c >> 5), rr = r & 15, cc = c & 31, ob = rr * 64 + cc * 2; return st * 1024 + (ob ^ (((ob >> 9) & 1) << 5)); }
__host__ __device__ __forceinline__ void stage_rc(int b, int& R, int& C) { const int st = b / 1024, sb = b % 1024, swz = sb ^ (((sb >> 9) & 1) << 5); R = (st >> 1) * 16 + swz / 64; C = (st & 1) * 32 + (swz % 64) / 2; }
__host__ __device__ __forceinline__ int perm32(int rho) { const int n = rho >> 4, i = rho & 15; return 8 * (i >> 2) + 4 * n + (i & 3); }

struct Unit { int pm, pn, acol, kofs, nt, kind; };

constexpr int GRID = 256;
template <int NM, int NN, int KT, int ROWMODE, int GATES, bool SPLIT> struct Sched {
    static constexpr int nM = NM, nN = NN, nwg = NM * NN, G = GRID, R = nwg / G, T = nwg - R * G;
    static constexpr int F0 = (!SPLIT || T == 0 || R == 0) ? 1 : (G / T >= 8 ? 8 : G / T >= 4 ? 4 : G / T >= 2 ? 2 : 1);
    static constexpr int F = (KT / F0 >= 4) ? F0 : (KT / (F0 / 2 > 0 ? F0 / 2 : 1) >= 4 ? (F0 / 2 > 0 ? F0 / 2 : 1) : 1);
    int c, v;
    __device__ void init(int c_, int v_) { c = c_; v = v_; }
    __device__ bool is_slice(int i) const { return F > 1 && i == R; }
    __device__ bool next(int i, Unit& u) const {
        long L; u.kofs = 0; u.nt = KT; u.kind = 0;
        if (GATES && T > 0 && 2 * T <= G && i == R) { if (c >= 2 * T) return false; L = (long)R * G + (c >> 1); u.kind = 1 + (c & 1); }
        else
        if (i < R) L = (long)i * G + c;
        else if (i == R && T > 0) { if (F == 1) { L = (long)R * G + c; if (L >= nwg) return false; } else { if (v >= T * F) return false; const int tt = v / F, sj = v - tt * F; u.nt = KT / F; u.kofs = sj * u.nt * BK; L = (long)R * G + tt; } }
        else return false;
        int wgid = (int)L; { const int q = nwg / NXCD, r = nwg % NXCD, xcd = wgid % NXCD, off = wgid / NXCD; wgid = (xcd < r ? xcd * (q + 1) : r * (q + 1) + (xcd - r) * q) + off; }
        const int nig = WGM * nN, gid = wgid / nig, fm = gid * WGM, gsz = (nM - fm) < WGM ? (nM - fm) : WGM;
        int pm = fm + ((wgid % nig) % gsz); u.pn = (wgid % nig) / gsz;
        if (ROWMODE == 1) pm = 9 * (pm >> 3) + 1 + (pm & 7);
        u.pm = pm; u.acol = GATES ? 256 * (u.pn >> 2) : 0; return true;
    }
};

template <int NN, int KT, int CLO, int CHI> struct SchedM {
    static constexpr int G = GRID, NLAT = 32 * NN, NCX = 4 * (CHI - CLO), TOT = 32 + NLAT + NCX, R = TOT / G, T = TOT - R * G, F = 1;
    static constexpr int SH = (T > 0 && T + 32 <= G) ? 32 : 0;
    int c;
    __device__ void init(int c_, int) { c = c_; }
    __device__ bool is_slice(int) const { return false; }
    __device__ bool next(int i, Unit& u) const {
        int L = i * G + c; if (i == R && T > 0) { const int cc = c - SH; if (cc < 0 || cc >= T) return false; L = R * G + cc; }
        if (L >= TOT) return false; u.kofs = 0; u.nt = KT; u.acol = 0;
        if (L < 32) { u.kind = 0; u.pm = 9 * (L >> 3); u.pn = L & 7; return true; }
        if (L < 32 + NLAT) { u.kind = 1; constexpr int nwg = NLAT; int wgid = L - 32; { constexpr int q = nwg / NXCD; const int xcd = wgid % NXCD, off = wgid / NXCD; wgid = xcd * q + off; }
            constexpr int nig = WGM * NN; const int gid = wgid / nig, fm = gid * WGM; const int pmi = fm + ((wgid % nig) % WGM); u.pn = (wgid % nig) / WGM; u.pm = 9 * (pmi >> 3) + 1 + (pmi & 7); return true; }
        const int r = L - 32 - NLAT; u.kind = 2; u.pm = 9 * (r / (CHI - CLO)); u.pn = CLO + r % (CHI - CLO); return true;
    }
};

__device__ __forceinline__ int opq(int x) { asm volatile("" : "+s"(x)); return x; }
constexpr int RSTD_OFF = 131072;
constexpr int SHWT_OFF = 147456;
constexpr int HSQ_OFF = 139264;
template <int LAYER, int N> struct EpiBf16 {
    unsigned char* ws; CArgsP ap;
    static constexpr int QKT = (LAYER == 1) ? 16 : (LAYER == 2) ? 0 : 10; static constexpr bool RMS = (LAYER != 1);
    template <class SchedT> __device__ __forceinline__ void prep(LAS unsigned char* lds, const SchedT& S, int tid) const {
        const float* ssq = (const float*)(ws + WS_SSQ); Unit u;
        for (int i = 0; i < 8 && S.next(i, u); ++i) if (tid < 256) { const f32x4* p4 = (const f32x4*)(ssq + (size_t)(u.pm * BM + tid) * 32); float s = 0.f;
#pragma unroll
            for (int j = 0; j < 8; ++j) { const f32x4 v = p4[j]; s += (v.x + v.y) + (v.z + v.w); }
            ((LAS float*)(lds + opq(RSTD_OFF)))[i * 256 + tid] = frsq(s * (1.0f / DM) + EPS); }
        else { const int t2 = tid - 256; const int bq = u.pm / 9, mr = (u.pm - 9 * bq) == 0 ? 4 : bq; float sv;
            sv = ((const float*)(ws + WS_SHW))[(size_t)(LAYER * 5 + mr) * 8192 + u.pn * BM + t2];
            ((LAS float*)(lds + opq(SHWT_OFF)))[i * 256 + t2] = sv; }
    }
    __device__ __forceinline__ void operator()(f32x4 (&acc)[2][2][4][2], const Unit& u, int ui, LAS unsigned char* lds, int wr, int wc, int tl_, unsigned gmask) const {
        unsigned char* w_ = ws; asm volatile("" : "+v"(tl_), "+s"(w_)); const int lane = tl_ & 63, fr = lane & 15, fq = lane >> 4;
        const int bq = u.pm / 9, pr_ = u.pm - 9 * bq, isctx = pr_ == 0;
        bf16_t* O = (bf16_t*)(w_ + WS_U);
        const int rl0 = wr * 64 + fr, row0 = u.pm * BM + rl0, col0 = u.pn * BM + wc * 32 + 8 * fq;
        const LAS float* rt = (const LAS float*)(lds + opq(RSTD_OFF)) + ui * 256 + rl0;
        f32x4 sv[2][2];
#pragma unroll
        for (int bj = 0; bj < 2; ++bj)
#pragma unroll
            for (int n = 0; n < 2; ++n) sv[bj][n] = *(const LAS f32x4*)((const LAS float*)(lds + opq(SHWT_OFF)) + ui * 256 + wc * 32 + 8 * fq + bj * HALF + 4 * n);
        if (QKT == 0 || u.pn >= QKT) {
#pragma unroll
            for (int ai = 0; ai < 2; ++ai)
#pragma unroll
                for (int m = 0; m < 4; ++m) { if (!((gmask >> (ai * 4 + m)) & 1u)) continue; bf16_t* rowp = O + (size_t)(row0 + ai * HALF + m * 16) * N + col0; const float rs = rt[ai * HALF + m * 16];
#pragma unroll
                    for (int bj = 0; bj < 2; ++bj) { const f32x4 v0 = acc[ai][bj][m][0] * rs + sv[bj][0], v1 = acc[ai][bj][m][1] * rs + sv[bj][1];
                        u32x4 w; w.x = cvt_pk_bf16(v0[0], v0[1]); w.y = cvt_pk_bf16(v0[2], v0[3]); w.z = cvt_pk_bf16(v1[0], v1[1]); w.w = cvt_pk_bf16(v1[2], v1[3]);
                        *(u32x4*)(rowp + bj * HALF) = w; } }
            return;
        }
        LAS float* hs = (LAS float*)(lds + opq(HSQ_OFF));
        if constexpr (RMS) {
#pragma unroll
            for (int ai = 0; ai < 2; ++ai)
#pragma unroll
                for (int m = 0; m < 4; ++m) { const int rl = rl0 + ai * HALF + m * 16; const float rs = rt[ai * HALF + m * 16];
#pragma unroll
                    for (int bj = 0; bj < 2; ++bj) { const f32x4 v0 = acc[ai][bj][m][0] * rs + sv[bj][0], v1 = acc[ai][bj][m][1] * rs + sv[bj][1];
                        float q = ((v0[0] * v0[0] + v0[1] * v0[1]) + (v0[2] * v0[2] + v0[3] * v0[3])) + ((v1[0] * v1[0] + v1[1] * v1[1]) + (v1[2] * v1[2] + v1[3] * v1[3]));
                        q += shx<16>(q); { auto rr = __builtin_amdgcn_permlane32_swap(__float_as_uint(q), __float_as_uint(q), false, false); q = __uint_as_float(rr[0]) + __uint_as_float(rr[1]); }
                        if (fq == 0) hs[rl * 8 + bj * 4 + wc] = q; } }
            asm volatile("s_waitcnt lgkmcnt(0)" ::: "memory"); __builtin_amdgcn_s_barrier(); asm volatile("" ::: "memory");
        }
        const int i16 = 4 * (wc & 1) + fq, hf = wc >> 1;
        f32x4 g0 = {1.f, 1.f, 1.f, 1.f}, g1 = g0;
        if constexpr (RMS) { const float* gg = ((u.pn < 8) ? ap->in[I_AQG] : ap->in[I_AKG]) + (LAYER == 3 ? 128 : 0) + 64 * hf + 4 * i16; g0 = *(const f32x4*)gg; g1 = *(const f32x4*)(gg + 32); }
        const float* tc = (const float*)(w_ + WS_TAB) + 4 * i16; const float* ts = tc + 96 * 32;
#pragma unroll
        for (int ai = 0; ai < 2; ++ai)
#pragma unroll
            for (int m = 0; m < 4; ++m) { if (!((gmask >> (ai * 4 + m)) & 1u)) continue; const int rl = rl0 + ai * HALF + m * 16; const float rs = rt[ai * HALF + m * 16];
                bf16_t* rowp = O + (size_t)(u.pm * BM + rl) * N + col0;
                f32x4 cs = {1.f, 1.f, 1.f, 1.f}, sn = {0.f, 0.f, 0.f, 0.f};
                if (!isctx) { const int tl = (pr_ - 1) * 256 + rl; const int pos = hf ? 32 + (tl & 63) : (tl >> 6); cs = *(const f32x4*)(tc + pos * 32); sn = *(const f32x4*)(ts + pos * 32); }
#pragma unroll
                for (int bj = 0; bj < 2; ++bj) { f32x4 x1 = acc[ai][bj][m][0] * rs + sv[bj][0], x2 = acc[ai][bj][m][1] * rs + sv[bj][1];
                    if constexpr (RMS) { const f32x4 pq = *(const LAS f32x4*)(hs + rl * 8 + bj * 4); const float rh = frsq(((pq[0] + pq[1]) + (pq[2] + pq[3])) * (1.0f / 128.0f) + EPS); x1 = x1 * rh * g0; x2 = x2 * rh * g1; }
                    const f32x4 y1 = x1 * cs - x2 * sn, y2 = x1 * sn + x2 * cs;
                    u32x4 w; w.x = cvt_pk_bf16(y1[0], y1[1]); w.y = cvt_pk_bf16(y1[2], y1[3]); w.z = cvt_pk_bf16(y2[0], y2[1]); w.w = cvt_pk_bf16(y2[2], y2[3]);
                    *(u32x4*)(rowp + bj * HALF) = w; } }
    }
};
template <int LAYER, bool DUP> struct EpiResid {
    unsigned char* ws; CArgsP ap;
    static constexpr bool NEXT = LAYER < 3;
    template <class SchedT> __device__ __forceinline__ void prep(LAS unsigned char*, const SchedT&, int) const {}
    __device__ __forceinline__ void operator()(f32x4 (&acc)[2][2][4][2], const Unit& u, int, LAS unsigned char* lds, int wr, int wc, int tl_, unsigned gmask) const {
        unsigned char* w_ = ws; asm volatile("" : "+v"(tl_), "+s"(w_)); const int lane = tl_ & 63, fr = lane & 15, fq = lane >> 4;
        const int bq = u.pm / 9, pr_ = u.pm - 9 * bq, isctx = pr_ == 0, mr = isctx ? 4 : bq;
        if constexpr (LAYER == 3 && !DUP) {
            const float* gt = (const float*)(w_ + WS_MODS) + (size_t)(LAYER * 5 + mr) * 6144 + 4096;
            const bf16_t* xbin = (const bf16_t*)(w_ + WS_X) + (size_t)u.pm * BM * DM;
            const int rl0 = wr * 64 + fr, col0 = u.pn * BM + wc * 32 + 8 * fq, lrow0 = bq * SEQ + (pr_ - 1) * 256;
            float* fsq = (float*)(w_ + WS_FSQ);
            f32x4 gv[2][2];
#pragma unroll
            for (int bj = 0; bj < 2; ++bj)
#pragma unroll
                for (int n = 0; n < 2; ++n) gv[bj][n] = *(const f32x4*)(gt + col0 + bj * HALF + 4 * n);
#pragma unroll
            for (int ai = 0; ai < 2; ++ai)
#pragma unroll
                for (int m = 0; m < 4; ++m) { const int rl = rl0 + ai * HALF + m * 16; const unsigned ro = (unsigned)(rl * DM + col0) * 4u; float sq = 0.f;
#pragma unroll
                    for (int bj = 0; bj < 2; ++bj) { const u32x4 bw = *(const u32x4*)((const char*)xbin + (ro >> 1) + bj * HALF * 2);
                        const f32x4 bs[2] = {(f32x4){bflo(bw.x), bfhi(bw.x), bflo(bw.y), bfhi(bw.y)}, (f32x4){bflo(bw.z), bfhi(bw.z), bflo(bw.w), bfhi(bw.w)}};
#pragma unroll
                        for (int n = 0; n < 2; ++n) { const f32x4 xn = bs[n] + gv[bj][n] * acc[ai][bj][m][n]; acc[ai][bj][m][n] = xn;
                            sq += (xn[0] * xn[0] + xn[1] * xn[1]) + (xn[2] * xn[2] + xn[3] * xn[3]); } }
                    sq += shx<16>(sq); { auto rr = __builtin_amdgcn_permlane32_swap(__float_as_uint(sq), __float_as_uint(sq), false, false); sq = __uint_as_float(rr[0]) + __uint_as_float(rr[1]); }
                    if (fq == 0) __hip_atomic_store(fsq + (size_t)(lrow0 + rl) * 32 + u.pn * 4 + wc, sq, __ATOMIC_RELAXED, __HIP_MEMORY_SCOPE_AGENT);
                    if (m & 1) asm volatile("" ::: "memory"); }
            asm volatile("s_waitcnt vmcnt(0)" ::: "memory"); __builtin_amdgcn_s_barrier(); asm volatile("" ::: "memory");
            const int tid = (wr * 4 + wc) * 64 + lane; const int panel = bq * 8 + pr_ - 1;
            if (tid == 0) { unsigned* cw = (unsigned*)(w_ + WS_CTL) + CW_SEAM + panel * 16;
                __hip_atomic_fetch_add(cw, 1u, __ATOMIC_RELAXED, __HIP_MEMORY_SCOPE_AGENT);
                unsigned sp = 0; while (__hip_atomic_load(cw, __ATOMIC_RELAXED, __HIP_MEMORY_SCOPE_AGENT) < 8u) { __builtin_amdgcn_s_sleep(1); if (++sp > (1u << 22)) break; }
                __builtin_amdgcn_fence(__ATOMIC_ACQUIRE, "agent"); asm volatile("s_waitcnt vmcnt(0)" ::: "memory"); }
            asm volatile("" ::: "memory"); __builtin_amdgcn_s_barrier(); asm volatile("" ::: "memory");
            LAS float* rt = (LAS float*)(lds + opq(HSQ_OFF));
            if (tid < 256) { const f32x4* p4 = (const f32x4*)(fsq + (size_t)(lrow0 + tid) * 32); float sa = 0.f;
#pragma unroll
                for (int j = 0; j < 8; ++j) { const f32x4 v = p4[j]; sa += (v.x + v.y) + (v.z + v.w); }
                rt[tid] = frsq(sa * (1.0f / DM) + EPS); }
            asm volatile("s_waitcnt lgkmcnt(0)" ::: "memory"); __builtin_amdgcn_s_barrier(); asm volatile("" ::: "memory");
            const float* nf = ap->in[I_NORMF] + col0; float* outp = ap->out + (size_t)lrow0 * DM;
#pragma unroll
            for (int bj = 0; bj < 2; ++bj)
#pragma unroll
                for (int n = 0; n < 2; ++n) gv[bj][n] = *(const f32x4*)(nf + bj * HALF + 4 * n);
#pragma unroll
            for (int ai = 0; ai < 2; ++ai)
#pragma unroll
                for (int m = 0; m < 4; ++m) { const int rl = rl0 + ai * HALF + m * 16; const float rs = rt[rl]; const unsigned ro = (unsigned)(rl * DM + col0) * 4u;
#pragma unroll
                    for (int bj = 0; bj < 2; ++bj)
#pragma unroll
                        for (int n = 0; n < 2; ++n) *(f32x4*)((char*)outp + ro + (bj * HALF + 4 * n) * 4) = acc[ai][bj][m][n] * rs * gv[bj][n]; }
            return;
        }
        const float* gt = (const float*)(w_ + WS_MODS) + (size_t)(LAYER * 5 + mr) * 6144 + 4096;
        const float* gmN = (const float*)(w_ + WS_GM) + (size_t)((LAYER + 1) * 5 + mr) * DM;
        const float* basep = (LAYER == 0) ? (isctx ? ap->in[I_CTX] + (size_t)(bq * CTXL) * DM : ap->in[I_X] + (size_t)(bq * SEQ + (pr_ - 1) * 256) * DM) : nullptr;
        const bf16_t* xbin = (const bf16_t*)(w_ + WS_X) + (size_t)u.pm * BM * DM;
        bf16_t* outp = (bf16_t*)(w_ + (DUP ? WS_DUMMY : WS_X)) + (size_t)u.pm * BM * DM; bf16_t* hp = (bf16_t*)(w_ + (DUP ? WS_DUMMY + 72 * MiB : WS_H)) + (size_t)u.pm * BM * DM;
        float* ssq = (float*)(w_ + (DUP ? WS_DUMMY + 108 * MiB : WS_SSQ));
        const int rl0 = wr * 64 + fr, col0 = u.pn * BM + wc * 32 + 8 * fq;
        f32x4 gv[2][2], mv[2][2];
#pragma unroll
        for (int bj = 0; bj < 2; ++bj)
#pragma unroll
            for (int n = 0; n < 2; ++n) { gv[bj][n] = *(const f32x4*)(gt + col0 + bj * HALF + 4 * n); if (NEXT) mv[bj][n] = *(const f32x4*)(gmN + col0 + bj * HALF + 4 * n); }
#pragma unroll
        for (int ai = 0; ai < 2; ++ai)
#pragma unroll
            for (int m = 0; m < 4; ++m) { if (!((gmask >> (ai * 4 + m)) & 1u)) continue; const int rl = rl0 + ai * HALF + m * 16; const unsigned ro = (unsigned)(rl * DM + col0) * 4u; float sq = 0.f;
#pragma unroll
                for (int bj = 0; bj < 2; ++bj) { f32x4 xn[2], bs[2];
                    if constexpr (LAYER == 0) { bs[0] = *(const f32x4*)((const char*)basep + ro + bj * HALF * 4); bs[1] = *(const f32x4*)((const char*)basep + ro + bj * HALF * 4 + 16); }
                    else { const u32x4 bw = *(const u32x4*)((const char*)xbin + (ro >> 1) + bj * HALF * 2); bs[0] = (f32x4){bflo(bw.x), bfhi(bw.x), bflo(bw.y), bfhi(bw.y)}; bs[1] = (f32x4){bflo(bw.z), bfhi(bw.z), bflo(bw.w), bfhi(bw.w)}; }
#pragma unroll
                    for (int n = 0; n < 2; ++n) { xn[n] = bs[n] + gv[bj][n] * acc[ai][bj][m][n];
                        if (NEXT) sq += (xn[n][0] * xn[n][0] + xn[n][1] * xn[n][1]) + (xn[n][2] * xn[n][2] + xn[n][3] * xn[n][3]); }
                    { u32x4 xw; xw.x = cvt_pk_bf16(xn[0][0], xn[0][1]); xw.y = cvt_pk_bf16(xn[0][2], xn[0][3]); xw.z = cvt_pk_bf16(xn[1][0], xn[1][1]); xw.w = cvt_pk_bf16(xn[1][2], xn[1][3]);
                        *(u32x4*)((char*)outp + (ro >> 1) + bj * HALF * 2) = xw; }
                    if (NEXT) { const f32x4 h0 = xn[0] * mv[bj][0], h1 = xn[1] * mv[bj][1]; u32x4 w; w.x = cvt_pk_bf16(h0[0], h0[1]); w.y = cvt_pk_bf16(h0[2], h0[3]); w.z = cvt_pk_bf16(h1[0], h1[1]); w.w = cvt_pk_bf16(h1[2], h1[3]);
                        *(u32x4*)((char*)hp + (ro >> 1) + bj * HALF * 2) = w; } }
                if (NEXT) { sq += shx<16>(sq); { auto rr = __builtin_amdgcn_permlane32_swap(__float_as_uint(sq), __float_as_uint(sq), false, false); sq = __uint_as_float(rr[0]) + __uint_as_float(rr[1]); }
                    if (fq == 0) ssq[(size_t)(u.pm * BM + rl) * 32 + u.pn * 4 + wc] = sq; }
                if (m & 1) asm volatile("" ::: "memory"); }
    }
};
template <int CTRL> __device__ __forceinline__ float dpp_f(float oldv, float src) { return __int_as_float(__builtin_amdgcn_update_dpp(__float_as_int(oldv), __float_as_int(src), CTRL, 0xf, 0xf, false)); }
struct EpiGates {
    unsigned char* ws; CArgsP ap;
    template <class SchedT> __device__ __forceinline__ void prep(LAS unsigned char*, const SchedT&, int) const {}
    __device__ __forceinline__ void operator()(f32x4 (&acc)[2][2][4][2], const Unit& u, int, LAS unsigned char*, int wr, int wc, int tl_, unsigned gmask) const {
        unsigned char* w_ = ws; asm volatile("" : "+v"(tl_), "+s"(w_)); const int lane = tl_ & 63, fr = lane & 15, fq = lane >> 4;
        const bf16_t* UP = (const bf16_t*)(w_ + WS_UP); const float* ba = ap->in[I_RBA]; const float* bx = ap->in[I_RBX]; const float* c8 = (const float*)(w_ + WS_TAB + 65536);
        unsigned* AB = (unsigned*)(w_ + WS_SA); float* AGA = (float*)(w_ + WS_AG16); float* AGB = AGA + (size_t)576 * 2 * DM;
        const int nblk = u.pn >> 2, dir = (u.pn >> 1) & 1, jt = u.pn & 1;
        const int row0 = u.pm * BM + wr * 64 + fr, chb = nblk * 256 + jt * 128 + 16 * wc + 4 * fq;
#pragma unroll
        for (int bj = 0; bj < 2; ++bj) { if (u.kind != 0 && u.kind - 1 != bj) continue; const int ch = chb + 64 * bj;
            const f32x4 bav = *(const f32x4*)(ba + dir * DM + ch), bxv = *(const f32x4*)(bx + dir * DM + ch), cv = *(const f32x4*)(c8 + dir * DM + ch);
#pragma unroll
            for (int ai = 0; ai < 2; ++ai)
#pragma unroll
                for (int m = 0; m < 4; ++m) { if (!((gmask >> (ai * 4 + m)) & 1u)) continue; const int row = row0 + ai * HALF + m * 16;
                    const u32x2 upw = *(const u32x2*)((const char*)UP + (unsigned)(row * DM + ch) * 2u);
                    const float up[4] = {bflo(upw.x), bfhi(upw.x), bflo(upw.y), bfhi(upw.y)};
                    const f32x4 pr = acc[ai][bj][m][0] + bav, pi = acc[ai][bj][m][1] + bxv; u32x4 w; f32x4 A, Bv;
#pragma unroll
                    for (int j = 0; j < 4; ++j) { const float r = sigmoidf_(pr[j]), ig = sigmoidf_(pi[j]); const float la = -r * cv[j]; const float a = __expf(la);
                        const float om = fmaf(-a, a, 1.0f);
                        w[j] = cvt_pk_bf16(la, fsqrt_(om) * (ig * up[j]));
                        A[j] = __expf(bflo(w[j])); Bv[j] = bfhi(w[j]); }
                    *(u32x4*)((char*)AB + (unsigned)((row * 2 + dir) * DM + ch) * 4u) = w;
#define GSTEP(CT) asm volatile("s_nop 1\n\tv_fmac_f32_dpp %0, %0, %4 " CT " row_mask:0xf bank_mask:0xf\n\tv_fmac_f32_dpp %1, %1, %5 " CT " row_mask:0xf bank_mask:0xf\n\tv_fmac_f32_dpp %2, %2, %6 " CT " row_mask:0xf bank_mask:0xf\n\tv_fmac_f32_dpp %3, %3, %7 " CT " row_mask:0xf bank_mask:0xf\n\t" \
                                   "v_mul_f32_dpp %4, %4, %4 " CT " row_mask:0xf bank_mask:0xf\n\tv_mul_f32_dpp %5, %5, %5 " CT " row_mask:0xf bank_mask:0xf\n\tv_mul_f32_dpp %6, %6, %6 " CT " row_mask:0xf bank_mask:0xf\n\tv_mul_f32_dpp %7, %7, %7 " CT " row_mask:0xf bank_mask:0xf" \
                                   : "+v"(Bv[0]), "+v"(Bv[1]), "+v"(Bv[2]), "+v"(Bv[3]), "+v"(A[0]), "+v"(A[1]), "+v"(A[2]), "+v"(A[3]));
                    if (dir == 0) { GSTEP("row_shr:1") GSTEP("row_shr:2") GSTEP("row_shr:4") GSTEP("row_shr:8") } else { GSTEP("row_shl:1") GSTEP("row_shl:2") GSTEP("row_shl:4") GSTEP("row_shl:8") }
#undef GSTEP
                    if (fr == (dir ? 0 : 15)) { const unsigned ao = (unsigned)((((u.pm * 16 + ai * 8 + wr * 4 + m) * 2 + dir) * DM + ch) * 4u); *(f32x4*)((char*)AGA + ao) = A; *(f32x4*)((char*)AGB + ao) = Bv; }
                    asm volatile("" ::: "memory"); __builtin_amdgcn_sched_barrier(0); } }
    }
};

struct NoEpi { unsigned char* ws; template <class SchedT> __device__ __forceinline__ void prep(LAS unsigned char*, const SchedT&, int) const {}
    __device__ __forceinline__ void operator()(f32x4 (&)[2][2][4][2], const Unit&, int, LAS unsigned char*, int, int, int, unsigned) const {} };
template <class Epi, class SchedT, int KT, int BANK, size_t OA, size_t OB, class Epi0 = NoEpi, size_t OA0 = 0, size_t OB0 = 0>
__device__ __forceinline__ void gemm_phase(LAS unsigned char* lds, const int tid, const SchedT& S, const Epi& E, const Epi0& E0 = Epi0{}) {
    constexpr bool MERGED = !__is_same(Epi0, NoEpi);
    constexpr bool SP2 = true, ALIGN_EPI = true;
    const int wid = __builtin_amdgcn_readfirstlane(tid >> 6), lane = tid & 63, wr = wid >> 2, wc = wid & 3, fr = lane & 15, fq = lane >> 4;
    constexpr int K = KT * BK, lda = DM;
    unsigned voffA[2], voffB[2];
#pragma unroll
    for (int i = 0; i < 2; ++i) { int R, C; stage_rc(tid * 16 + i * 8192, R, C); const int Rb = (R & ~31) + perm32(R & 31);
        voffA[i] = (unsigned)(R * lda + C) * 2u; voffB[i] = (unsigned)(Rb * K + C) * 2u; }
    constexpr unsigned kstep = (unsigned)(BK * 2);
    constexpr unsigned hstepA = (unsigned)HALF * lda * 2, hstepB = (unsigned)HALF * K * 2;
    constexpr unsigned tstepA = 2 * hstepA, tstepB = 2 * hstepB;
    const unsigned ldsw = (unsigned)wid * 1024u;
    const int aoff = lds_byte(wr * 64 + fr, fq * 8), boff = lds_byte(wc * 32 + fr, fq * 8);
#define PG8_SA(b, h) (((b) * 2 + (h)) * HTB)
#define PG8_SB(b, h) ((4 + (b) * 2 + (h)) * HTB)
#define PG8_STAGE(bufoff, goff, voff) do { _Pragma("unroll") for (int _i = 0; _i < 2; ++_i) \
        __builtin_amdgcn_global_load_lds((const unsigned*)((const char*)E.ws + (unsigned)((goff) + (voff)[_i])), (LAS unsigned*)(lds + (bufoff) + ldsw + _i * 8192), 16, 0, 0); } while (0)
#define PG8_LDA(dst, b, h) do { _Pragma("unroll") for (int m = 0; m < 4; ++m) _Pragma("unroll") for (int k = 0; k < 2; ++k) dst[m][k] = *(const LAS bf16x8*)(lds + PG8_SA(b, h) + aoff + m * 2048 + k * 1024); } while (0)
#define PG8_LDB(dst, b, h) do { _Pragma("unroll") for (int n = 0; n < 2; ++n) _Pragma("unroll") for (int k = 0; k < 2; ++k) dst[n][k] = *(const LAS bf16x8*)(lds + PG8_SB(b, h) + boff + n * 2048 + k * 1024); } while (0)
#define PG8_MMA(ai, bj, At, Bt) do { __builtin_amdgcn_s_setprio(1); _Pragma("unroll") for (int m = 0; m < 4; ++m) _Pragma("unroll") for (int n = 0; n < 2; ++n) _Pragma("unroll") for (int k = 0; k < 2; ++k) \
        acc[ai][bj][m][n] = __builtin_amdgcn_mfma_f32_16x16x32_bf16(Bt[n][k], At[m][k], acc[ai][bj][m][n], 0, 0, 0); __builtin_amdgcn_s_setprio(0); } while (0)
#define PG8_WAIT_V(n) asm volatile("s_waitcnt vmcnt(" #n ")" ::: "memory")
#define PG8_WAIT_L(n) asm volatile("s_waitcnt lgkmcnt(" #n ")" ::: "memory")
#define PG8_BAR __builtin_amdgcn_s_barrier()
#define PG8_SCHED __builtin_amdgcn_sched_barrier(0)
    Unit cur, nxt; int ui = 0;
    if (!S.next(0, cur)) return;
    E.prep(lds, S, tid); __syncthreads();
    f32x4 acc[2][2][4][2];
#pragma unroll
    for (int a = 0; a < 2; ++a)
#pragma unroll
        for (int b = 0; b < 2; ++b)
#pragma unroll
            for (int m = 0; m < 4; ++m)
#pragma unroll
                for (int n = 0; n < 2; ++n) acc[a][b][m][n] = (f32x4){0.f, 0.f, 0.f, 0.f};
    bf16x8 At[4][2], B0[2][2], B1[2][2];
#define PG8_UA(u) ((unsigned)((MERGED && (u).kind == 0) ? OA0 : OA) + (unsigned)(u).pm * tstepA + (unsigned)((u).acol + (u).kofs) * 2u)
#define PG8_UB(u) ((unsigned)((MERGED && (u).kind == 0) ? OB0 : OB) + (unsigned)(u).pn * tstepB + (unsigned)(u).kofs * 2u)
    unsigned cA = PG8_UA(cur), cB = PG8_UB(cur);
    {
        PG8_STAGE(PG8_SB(0, 0), cB, voffB); PG8_STAGE(PG8_SB(0, 1), cB + hstepB, voffB); PG8_STAGE(PG8_SA(0, 0), cA, voffA); PG8_STAGE(PG8_SA(0, 1), cA + hstepA, voffA);
        if (wr == 1) PG8_BAR;
        PG8_WAIT_V(2); PG8_BAR;
        PG8_STAGE(PG8_SB(1, 0), cB + kstep, voffB); PG8_STAGE(PG8_SA(1, 0), cA + kstep, voffA); PG8_STAGE(PG8_SB(1, 1), cB + hstepB + kstep, voffB);
        PG8_WAIT_V(6); PG8_BAR;
    }
    for (;;) {
        const bool has_next = S.next(ui + 1, nxt);
        const unsigned nA = has_next ? PG8_UA(nxt) : cA, nB = has_next ? PG8_UB(nxt) : cB;
        const int nt = cur.nt;
        for (int t = 0; t < nt; t += 2) {
            const bool last = (t == nt - 2);
            if constexpr (MERGED) if (last && has_next && nxt.kind == 2) {
                unsigned char* w0_ = E.ws; asm volatile("" : "+s"(w0_));
                if (wid == 0) { unsigned* cw = (unsigned*)(w0_ + WS_CTL) + CW_SEAM + 1024 + BANK * 64 + (nxt.pm / 9) * 16; unsigned sp_ = 0;
                    while ((unsigned)__builtin_amdgcn_readfirstlane((int)__hip_atomic_load(cw, __ATOMIC_RELAXED, __HIP_MEMORY_SCOPE_AGENT)) < 8u) { __builtin_amdgcn_s_sleep(2); if (++sp_ > (1u << 22)) break; }
                    __builtin_amdgcn_fence(__ATOMIC_ACQUIRE, "agent"); asm volatile("s_waitcnt vmcnt(0)" ::: "memory"); }
                asm volatile("" ::: "memory"); PG8_BAR; asm volatile("" ::: "memory");
                if (tid < 256) { const f32x4* p4 = (const f32x4*)((const float*)(w0_ + WS_SSQ) + (size_t)(nxt.pm * BM + tid) * 32); float s_ = 0.f;
#pragma unroll
                    for (int j = 0; j < 8; ++j) { const f32x4 v_ = p4[j]; s_ += (v_.x + v_.y) + (v_.z + v_.w); }
                    ((LAS float*)(lds + opq(RSTD_OFF)))[(ui + 1) * 256 + tid] = frsq(s_ * (1.0f / DM) + EPS); }
            }
            const unsigned a1 = cA + (unsigned)(t + 1) * kstep;
            const unsigned a2 = last ? nA : cA + (unsigned)(t + 2) * kstep, b2 = last ? nB : cB + (unsigned)(t + 2) * kstep;
            const unsigned a3 = a2 + kstep, b3 = b2 + kstep;
            PG8_LDB(B0, 0, 0); PG8_LDB(B1, 0, 1); PG8_SCHED; PG8_LDA(At, 0, 0); PG8_STAGE(PG8_SA(1, 1), a1 + hstepA, voffA);
            PG8_WAIT_V(8); PG8_WAIT_L(0); PG8_BAR; PG8_MMA(0, 0, At, B0); PG8_MMA(0, 1, At, B1); PG8_BAR; PG8_SCHED;
            PG8_LDA(At, 0, 1); PG8_STAGE(PG8_SB(0, 0), b2, voffB); PG8_STAGE(PG8_SB(0, 1), b2 + hstepB, voffB); PG8_STAGE(PG8_SA(0, 0), a2, voffA);
            PG8_WAIT_V(8); PG8_WAIT_L(0); PG8_BAR; PG8_MMA(1, 0, At, B0); PG8_MMA(1, 1, At, B1); PG8_BAR; PG8_SCHED;
            PG8_LDB(B0, 1, 0); PG8_LDB(B1, 1, 1); PG8_SCHED; PG8_LDA(At, 1, 0); PG8_STAGE(PG8_SA(0, 1), a2 + hstepA, voffA);
            PG8_WAIT_V(8); PG8_WAIT_L(0); PG8_BAR; PG8_MMA(0, 0, At, B0); PG8_MMA(0, 1, At, B1); PG8_BAR; PG8_SCHED;
            PG8_LDA(At, 1, 1); PG8_STAGE(PG8_SB(1, 0), b3, voffB); PG8_STAGE(PG8_SB(1, 1), b3 + hstepB, voffB); PG8_STAGE(PG8_SA(1, 0), a3, voffA);
            PG8_WAIT_V(8); PG8_WAIT_L(0); PG8_BAR; PG8_MMA(1, 0, At, B0); PG8_MMA(1, 1, At, B1); PG8_BAR; PG8_SCHED;
        }
        if constexpr (ALIGN_EPI) { if (wr == 0) PG8_BAR; }
        if (MERGED && cur.kind == 0) {
            E0(acc, cur, ui, lds, wr, wc, tid, 0xffu);
            asm volatile("s_waitcnt vmcnt(0)" ::: "memory"); PG8_BAR; asm volatile("" ::: "memory");
            if (tid == 0) { unsigned char* w0_ = E.ws; asm volatile("" : "+s"(w0_)); unsigned* cw = (unsigned*)(w0_ + WS_CTL) + CW_SEAM + 1024 + BANK * 64 + (cur.pm / 9) * 16;
                __builtin_amdgcn_fence(__ATOMIC_RELEASE, "agent"); asm volatile("s_waitcnt vmcnt(0)" ::: "memory");
                __hip_atomic_fetch_add(cw, 1u, __ATOMIC_RELAXED, __HIP_MEMORY_SCOPE_AGENT); }
        } else
        if (!S.is_slice(ui)) E(acc, cur, ui, lds, wr, wc, tid, 0xffu);
        if (!has_next) break;
#pragma unroll
        for (int a = 0; a < 2; ++a)
#pragma unroll
            for (int b = 0; b < 2; ++b)
#pragma unroll
                for (int m = 0; m < 4; ++m)
#pragma unroll
                    for (int n = 0; n < 2; ++n) acc[a][b][m][n] = (f32x4){0.f, 0.f, 0.f, 0.f};
        cur = nxt; cA = nA; cB = nB; ++ui;
        if constexpr (ALIGN_EPI) { if (wr == 1) PG8_BAR; }
    }
    PG8_WAIT_V(0);
    if constexpr (!ALIGN_EPI) { if (wr == 0) PG8_BAR; }
    PG8_BAR;
    if constexpr (SchedT::F > 1) if (S.is_slice(ui)) {
        unsigned char* w_ = E.ws; asm volatile("" : "+s"(w_)); float* slab = (float*)(w_ + WS_SLAB); unsigned* cnt = (unsigned*)(w_ + WS_CTL) + CW_SEAM + BANK * 4096;
        constexpr int F = SchedT::F; const int tt = S.v / F, sj = S.v - tt * F; float* my = slab + ((size_t)(tt * F + sj) * 32) * 2048;
#pragma unroll
        for (int a = 0; a < 2; ++a)
#pragma unroll
            for (int b = 0; b < 2; ++b)
#pragma unroll
                for (int m = 0; m < 4; ++m)
#pragma unroll
                    for (int n = 0; n < 2; ++n) { float* sp_ = my + (size_t)((((a * 2 + b) * 4 + m) * 2 + n) * 512 + tid) * 4;
                        asm volatile("global_store_dwordx4 %0, %1, off sc1\n\ts_nop 1" :: "v"(sp_), "v"(acc[a][b][m][n]) : "memory"); }
        asm volatile("s_waitcnt vmcnt(0)" ::: "memory"); __syncthreads();
        if (tid == 0) { unsigned* cw = cnt + tt * 16;
            __hip_atomic_fetch_add(cw, 1u, __ATOMIC_RELAXED, __HIP_MEMORY_SCOPE_AGENT);
            unsigned sp = 0; while (__hip_atomic_load(cw, __ATOMIC_RELAXED, __HIP_MEMORY_SCOPE_AGENT) < (unsigned)F) { __builtin_amdgcn_s_sleep(1); if (++sp > (1u << 22)) break; }
            __builtin_amdgcn_fence(__ATOMIC_ACQUIRE, "agent"); asm volatile("s_waitcnt vmcnt(0)" ::: "memory"); }
        __syncthreads();
        constexpr int per = 8 / F; const unsigned gmask = ((1u << per) - 1u) << (sj * per);
        const float* t0 = slab + ((size_t)(tt * F) * 32) * 2048;
#pragma unroll
        for (int a = 0; a < 2; ++a)
#pragma unroll
            for (int m = 0; m < 4; ++m) if ((gmask >> (a * 4 + m)) & 1u) {
#pragma unroll
                for (int b = 0; b < 2; ++b)
#pragma unroll
                    for (int n = 0; n < 2; ++n) { const float* fp = t0 + (size_t)((((a * 2 + b) * 4 + m) * 2 + n) * 512 + tid) * 4; f32x4 sm = *(const f32x4*)fp;
#pragma unroll
                        for (int sl = 1; sl < F; ++sl) sm += *(const f32x4*)(fp + (size_t)sl * 32 * 2048);
                        acc[a][b][m][n] = sm; } }
        E(acc, cur, ui, lds, wr, wc, tid, gmask);
        asm volatile("s_waitcnt vmcnt(0)" ::: "memory"); __syncthreads();
    }
#undef PG8_UA
#undef PG8_UB
#undef PG8_SA
#undef PG8_SB
#undef PG8_STAGE
#undef PG8_LDA
#undef PG8_LDB
#undef PG8_MMA
#undef PG8_WAIT_V
#undef PG8_WAIT_L
#undef PG8_BAR
#undef PG8_SCHED
}
}

namespace att {
constexpr int D = 128, NW = 8, QBLK = 32, KVBLK = 64;
constexpr float SCALE = 0.088388347648318440f;
constexpr float THR = 8.f;
constexpr int SHM_V = KVBLK * D * 2, SHM_K = KVBLK * D * 2, SHM_ATTN = 3 * SHM_V + 3 * SHM_K + NW * 64 * 4;
#define KSWZ(row, colB) ((row) * 256 + ((colB) ^ (((row) & 7) << 4)))
#define SBAR() __builtin_amdgcn_sched_barrier(0)
__device__ __forceinline__ int crow(int r, int hi) { return (r & 3) + 8 * (r >> 2) + 4 * hi; }
__device__ __forceinline__ unsigned cvtpk(float lo, float hi) { unsigned r; asm volatile("v_cvt_pk_bf16_f32 %0, %1, %2" : "=v"(r) : "v"(lo), "v"(hi)); return r; }
__device__ __forceinline__ bf16x8 ld8(const bf16_t* p) { return *reinterpret_cast<const bf16x8*>(p); }

__device__ __forceinline__ void partialSM(f32x16& p0, f32x16& p1, float& m_reg, float& mn, float& alpha) {
  constexpr float C = SCALE * 1.4426950408889634f;
  float pmax = p0[0]; for (int r = 1; r < 16; ++r) pmax = fmaxf(pmax, p0[r]); for (int r = 0; r < 16; ++r) pmax = fmaxf(pmax, p1[r]);
  { auto rr = __builtin_amdgcn_permlane32_swap(__float_as_uint(pmax), __float_as_uint(pmax), false, false);
    pmax = fmaxf(__uint_as_float(rr[0]), __uint_as_float(rr[1])); }
  if (__builtin_expect(__all(pmax - m_reg <= THR / SCALE), 1)) { mn = m_reg; alpha = 1.f; }
  else { mn = fmaxf(m_reg, pmax); alpha = __builtin_amdgcn_exp2f((m_reg - mn) * C); m_reg = mn; }
  float mnC = -mn * C;
  for (int r = 0; r < 16; ++r) p0[r] = fmaf(p0[r], C, mnC); for (int r = 0; r < 16; ++r) p1[r] = fmaf(p1[r], C, mnC);
  for (int r = 0; r < 16; ++r) p0[r] = __builtin_amdgcn_exp2f(p0[r]);
}
__device__ __forceinline__ void finishSM(f32x16& p0, f32x16& p1, float alpha, float& l_reg, bf16x8& pa0, bf16x8& pa1, bf16x8& pa2, bf16x8& pa3) {
  for (int r = 0; r < 16; ++r) p1[r] = __builtin_amdgcn_exp2f(p1[r]);
  float ps = 0; for (int r = 0; r < 16; ++r) ps += p0[r]; for (int r = 0; r < 16; ++r) ps += p1[r];
  { auto rr = __builtin_amdgcn_permlane32_swap(__float_as_uint(ps), __float_as_uint(ps), false, false);
    ps = __uint_as_float(rr[0]) + __uint_as_float(rr[1]); }
  l_reg = l_reg * alpha + ps;
#define PK4(P, BASE, OUT) do { unsigned a0 = cvtpk(P[BASE + 0], P[BASE + 1]), a1 = cvtpk(P[BASE + 2], P[BASE + 3]);   \
    unsigned b0 = cvtpk(P[BASE + 4], P[BASE + 5]), b1 = cvtpk(P[BASE + 6], P[BASE + 7]);                              \
    auto r0 = __builtin_amdgcn_permlane32_swap(a0, b0, false, false); auto r1 = __builtin_amdgcn_permlane32_swap(a1, b1, false, false); \
    u32x4 w = {r0[0], r1[0], r0[1], r1[1]}; OUT = *reinterpret_cast<bf16x8*>(&w); } while (0)
  PK4(p0, 0, pa0); PK4(p0, 8, pa1); PK4(p1, 0, pa2); PK4(p1, 8, pa3);
#undef PK4
}
__device__ __forceinline__ void qkt(f32x16& p0, f32x16& p1, const bf16_t* Ks, const bf16x8* qr, int r32, int hi) {
  p0 = f32x16{}; p1 = f32x16{};
  for (int d0 = 0; d0 < 8; ++d0) { int cb = (d0 * 16 + hi * 8) * 2;
    bf16x8 b0 = *reinterpret_cast<const bf16x8*>((const char*)Ks + KSWZ(r32, cb));
    bf16x8 b1 = *reinterpret_cast<const bf16x8*>((const char*)Ks + KSWZ(32 + r32, cb));
    p0 = __builtin_amdgcn_mfma_f32_32x32x16_bf16(b0, qr[d0], p0, 0, 0, 0);
    p1 = __builtin_amdgcn_mfma_f32_32x32x16_bf16(b1, qr[d0], p1, 0, 0, 0); }
}
template <int OFF> __device__ __forceinline__ bf16x8 k_read(int a) { bf16x8 r; asm volatile("ds_read_b128 %0, %1 offset:%2" : "=&v"(r) : "v"(a), "i"(OFF) : "memory"); return r; }
__device__ __forceinline__ void qkt_pipe(f32x16& p0, f32x16& p1, const int kbase, const bf16x8* qr, int r32, int hi) {
  const int x = (r32 & 7) << 4, rb = kbase + r32 * 256, h16 = hi * 16;
#define KA(d) (rb + ((((d) * 32) + h16) ^ x))
  p0 = f32x16{}; p1 = f32x16{};
  asm volatile("s_waitcnt lgkmcnt(0)" ::: "memory"); SBAR();
  bf16x8 A0 = k_read<0>(KA(0)), A1 = k_read<8192>(KA(0)), B0 = k_read<0>(KA(1)), B1 = k_read<8192>(KA(1));
#define QSTEP(F0, F1, d, NW) asm volatile("s_waitcnt lgkmcnt(" #NW ")" ::: "memory"); SBAR(); \
    p0 = __builtin_amdgcn_mfma_f32_32x32x16_bf16(F0, qr[d], p0, 0, 0, 0); p1 = __builtin_amdgcn_mfma_f32_32x32x16_bf16(F1, qr[d], p1, 0, 0, 0); SBAR();
  QSTEP(A0, A1, 0, 2) A0 = k_read<0>(KA(2)); A1 = k_read<8192>(KA(2));
  QSTEP(B0, B1, 1, 2) B0 = k_read<0>(KA(3)); B1 = k_read<8192>(KA(3));
  QSTEP(A0, A1, 2, 2) A0 = k_read<0>(KA(4)); A1 = k_read<8192>(KA(4));
  QSTEP(B0, B1, 3, 2) B0 = k_read<0>(KA(5)); B1 = k_read<8192>(KA(5));
  QSTEP(A0, A1, 4, 2) A0 = k_read<0>(KA(6)); A1 = k_read<8192>(KA(6));
  QSTEP(B0, B1, 5, 2) B0 = k_read<0>(KA(7)); B1 = k_read<8192>(KA(7));
  QSTEP(A0, A1, 6, 2)
  QSTEP(B0, B1, 7, 0)
#undef QSTEP
#undef KA
}
__device__ __forceinline__ int v_st(int k, int c) { const int kk = (k & ~0xC) | ((k & 4) << 1) | ((k & 8) >> 1); return ((kk >> 3) * 4 + (c >> 5)) * 512 + ((kk & 7) * 32 + (c & 31)) * 2; }
__device__ __forceinline__ int v_rd_base(int lane) { return ((lane & 3) << 3) | (((lane >> 2) & 3) << 6) | (((lane >> 4) & 1) << 5) | (((lane >> 5) & 1) << 8); }
constexpr int v_rd_off(int d0, int ks, int half) { return d0 * 512 + ks * 4096 + half * 2048; }
template <int OFF> __device__ __forceinline__ s16x4 tr_read(int vb) {
  s16x4 r; asm volatile("ds_read_b64_tr_b16 %0, %1 offset:%2" : "=&v"(r) : "v"(vb), "i"(OFF) : "memory"); return r;
}
template <int D0> __device__ __forceinline__ void pv_one(f32x16& od, int vb, bf16x8 pa0, bf16x8 pa1, bf16x8 pa2, bf16x8 pa3) {
  const s16x4 l0 = tr_read<v_rd_off(D0, 0, 0)>(vb), h0 = tr_read<v_rd_off(D0, 0, 1)>(vb), l1 = tr_read<v_rd_off(D0, 1, 0)>(vb), h1 = tr_read<v_rd_off(D0, 1, 1)>(vb);
  const s16x4 l2 = tr_read<v_rd_off(D0, 2, 0)>(vb), h2 = tr_read<v_rd_off(D0, 2, 1)>(vb), l3 = tr_read<v_rd_off(D0, 3, 0)>(vb), h3 = tr_read<v_rd_off(D0, 3, 1)>(vb);
  asm volatile("s_waitcnt lgkmcnt(0)" ::: "memory"); SBAR();
#define PK(L, H) (bf16x8){L[0], L[1], L[2], L[3], H[0], H[1], H[2], H[3]}
  od = __builtin_amdgcn_mfma_f32_32x32x16_bf16(pa0, PK(l0, h0), od, 0, 0, 0);
  od = __builtin_amdgcn_mfma_f32_32x32x16_bf16(pa1, PK(l1, h1), od, 0, 0, 0);
  od = __builtin_amdgcn_mfma_f32_32x32x16_bf16(pa2, PK(l2, h2), od, 0, 0, 0);
  od = __builtin_amdgcn_mfma_f32_32x32x16_bf16(pa3, PK(l3, h3), od, 0, 0, 0);
#undef PK
}
__device__ __forceinline__ void pv_d0(f32x16* o, int vb, bf16x8 pa0, bf16x8 pa1, bf16x8 pa2, bf16x8 pa3) {
  pv_one<0>(o[0], vb, pa0, pa1, pa2, pa3); pv_one<1>(o[1], vb, pa0, pa1, pa2, pa3); pv_one<2>(o[2], vb, pa0, pa1, pa2, pa3); pv_one<3>(o[3], vb, pa0, pa1, pa2, pa3);
}
template <int LD, int ldo, bool GATED>
__device__ __forceinline__ void attn_unit(const bf16_t* __restrict__ Qb, const bf16_t* __restrict__ Kh, const bf16_t* __restrict__ Vh,
                                          bf16_t* __restrict__ Ob, const bf16_t* __restrict__ Zb, int seq, char* lds, const int tid) {
  constexpr int SDEPTH = 2;
  const int wid = tid >> 6, lane = tid & 63, r32 = lane & 31, hi = lane >> 5;
  char* V_lds = lds; char* K_lds = lds + 3 * SHM_V;
  float* ws = (float*)(lds + 3 * SHM_V + 3 * SHM_K) + wid * 64; float* li_l = ws; float* al_l = ws + 32;
  float m_reg = -1e30f, l_reg = 0; f32x16 o[4] = {}; bf16x8 qr[8];
  { const unsigned qoff = (unsigned)((wid * QBLK + r32) * LD + hi * 8) * 2u;
#pragma unroll
    for (int d0 = 0; d0 < 8; ++d0) qr[d0] = *(const bf16x8*)((const char*)Qb + qoff + d0 * 32); }
  const int sr = tid >> 4, sc = (tid & 15) * 8, vst0 = v_st(sr, sc), vst1 = v_st(32 + sr, sc);
  const int vb0 = (int)(uintptr_t)V_lds + v_rd_base(lane);
  struct { bf16x8 vs0, vs1, ks0, ks1; } sr_[SDEPTH];
  const unsigned soff0 = (unsigned)(sr * LD + sc) * 2u, soff1 = (unsigned)((32 + sr) * LD + sc) * 2u;
#define SLOAD(i, k0) do { const char* vt_ = (const char*)Vh + (size_t)(k0) * (LD * 2); const char* kt_ = (const char*)Kh + (size_t)(k0) * (LD * 2); \
    sr_[i].vs0 = *(const bf16x8*)(vt_ + soff0); sr_[i].vs1 = *(const bf16x8*)(vt_ + soff1); sr_[i].ks0 = *(const bf16x8*)(kt_ + soff0); sr_[i].ks1 = *(const bf16x8*)(kt_ + soff1); } while (0)
#define SWRITE(so, i) do { *(bf16x8*)(V_lds + (so) + vst0) = sr_[i].vs0;          \
    *(bf16x8*)(V_lds + (so) + vst1) = sr_[i].vs1; int kc = sc * 2;               \
    *(bf16x8*)(K_lds + (so) + KSWZ(sr, kc)) = sr_[i].ks0;                       \
    *(bf16x8*)(K_lds + (so) + KSWZ(32 + sr, kc)) = sr_[i].ks1; } while (0)
#define SWAIT() do { asm volatile("s_waitcnt vmcnt(4)" ::: "memory"); } while (0)
#define RESC(a) do { if (__any((a) < 1.f)) { if (hi == 0) al_l[r32] = (a); asm volatile("s_waitcnt lgkmcnt(0)" ::: "memory"); \
    for (int d = 0; d < 4; ++d) for (int r = 0; r < 16; ++r) o[d][r] *= al_l[crow(r, hi)]; } } while (0)
#define ROT() do { const int t_ = sp; sp = sc_; sc_ = sn; sn = t_; } while (0)
  f32x16 pA0, pA1, pB0, pB1; float mnA, mnB, alA, alB; bf16x8 pa0, pa1, pa2, pa3; const int NT = seq / KVBLK;
  constexpr int SE = 0, SO = SDEPTH - 1;
  int sp = 0, sc_ = SHM_V, sn = 2 * SHM_V;
  SLOAD(SE, 0); asm volatile("s_waitcnt vmcnt(0)" ::: "memory"); SWRITE(0, SE); __syncthreads();
  qkt(pA0, pA1, (const bf16_t*)K_lds, qr, r32, hi); partialSM(pA0, pA1, m_reg, mnA, alA);
  SLOAD(SO, KVBLK); if (2 < NT) SLOAD(SE, 2 * KVBLK);
  SWAIT(); SWRITE(SHM_V, SO);
  for (int j = 1; j + 1 < NT; j += 2) {
    __syncthreads();
    SBAR(); qkt(pB0, pB1, (const bf16_t*)(K_lds + sc_), qr, r32, hi);
    finishSM(pA0, pA1, alA, l_reg, pa0, pa1, pa2, pa3); SBAR();
    SLOAD(SO, (j + SDEPTH) * KVBLK); SBAR();
    pv_d0(o, vb0 + sp, pa0, pa1, pa2, pa3); partialSM(pB0, pB1, m_reg, mnB, alB);
    SWAIT(); SWRITE(sn, SE);
    RESC(alB); ROT();
    __syncthreads();
    SBAR(); qkt(pA0, pA1, (const bf16_t*)(K_lds + sc_), qr, r32, hi);
    finishSM(pB0, pB1, alB, l_reg, pa0, pa1, pa2, pa3); SBAR();
    if (j + 3 < NT) SLOAD(SE, (j + 1 + SDEPTH) * KVBLK); SBAR();
    pv_d0(o, vb0 + sp, pa0, pa1, pa2, pa3); partialSM(pA0, pA1, m_reg, mnA, alA);
    SWAIT(); SWRITE(sn, SO);
    RESC(alA); ROT();
  }
  __syncthreads();
  SBAR(); qkt(pB0, pB1, (const bf16_t*)(K_lds + sc_), qr, r32, hi);
  finishSM(pA0, pA1, alA, l_reg, pa0, pa1, pa2, pa3); SBAR();
  pv_d0(o, vb0 + sp, pa0, pa1, pa2, pa3); partialSM(pB0, pB1, m_reg, mnB, alB);
  RESC(alB);
  finishSM(pB0, pB1, alB, l_reg, pa0, pa1, pa2, pa3); SBAR();
  pv_d0(o, vb0 + sc_, pa0, pa1, pa2, pa3); SBAR();
#define ZLD(i) (*(const u32x4*)((const char*)Zb + (unsigned)((wid * QBLK + (i) * 4 + (lane >> 4)) * LD + (lane & 15) * 8) * 2u))
  u32x4 za, zb; if constexpr (GATED) { za = ZLD(0); zb = ZLD(1); }
  if (hi == 0) li_l[r32] = l_reg; asm volatile("s_waitcnt lgkmcnt(0)" ::: "memory");
  float rli[16];
#pragma unroll
  for (int r = 0; r < 16; ++r) rli[r] = __builtin_amdgcn_rcpf(li_l[crow(r, hi)]);
  __syncthreads();
  { bf16_t* stg = (bf16_t*)lds + wid * 4096;
#pragma unroll
    for (int r = 0; r < 16; ++r) { const int orow = crow(r, hi);
#pragma unroll
      for (int d0 = 0; d0 < 4; ++d0) stg[orow * 128 + d0 * 32 + r32] = (bf16_t)f2bf(o[d0][r] * rli[r]); }
    asm volatile("s_waitcnt lgkmcnt(0)" ::: "memory");
#pragma unroll 1
    for (int i = 0; i < 8; i += 2) { u32x4 na, nb; if constexpr (GATED) { const int i2 = (i + 2) & 7; na = ZLD(i2); nb = ZLD(i2 + 1); }
#pragma unroll
      for (int q = 0; q < 2; ++q) { const int row = (i + q) * 4 + (lane >> 4), ch = lane & 15; u32x4 v = *(const u32x4*)(stg + row * 128 + ch * 8);
        if constexpr (GATED) { const u32x4 z = q ? zb : za;
          v.x = pk2(bflo(v.x) * siluf_(bflo(z.x)), bfhi(v.x) * siluf_(bfhi(z.x))); v.y = pk2(bflo(v.y) * siluf_(bflo(z.y)), bfhi(v.y) * siluf_(bfhi(z.y)));
          v.z = pk2(bflo(v.z) * siluf_(bflo(z.z)), bfhi(v.z) * siluf_(bfhi(z.z))); v.w = pk2(bflo(v.w) * siluf_(bflo(z.w)), bfhi(v.w) * siluf_(bfhi(z.w))); }
        *(u32x4*)((char*)Ob + (unsigned)((wid * QBLK + row) * ldo + ch * 8) * 2u) = v; }
      if constexpr (GATED) { za = na; zb = nb; } }
#undef ZLD
    asm volatile("s_waitcnt lgkmcnt(0)" ::: "memory"); }
  __syncthreads();
#undef SLOAD
#undef SWRITE
#undef SWAIT
#undef RESC
#undef ROT
}

template <int LD, int ldo, bool GATED>
__device__ __forceinline__ void attn_unit_dma(const bf16_t* __restrict__ Qb, const bf16_t* __restrict__ Kh, const bf16_t* __restrict__ Vh,
                                              bf16_t* __restrict__ Ob, const bf16_t* __restrict__ Zb, int seq, char* lds, const int tid) {
  const int wid = tid >> 6, lane = tid & 63, r32 = lane & 31, hi = lane >> 5;
  char* V_lds = lds; char* K_lds = lds + 65536;
  float* ws = (float*)(lds + 131072) + wid * 64; float* li_l = ws; float* al_l = ws + 32;
  float m_reg = -1e30f, l_reg = 0; f32x16 o[4] = {}; bf16x8 qr[8];
  { const unsigned qoff = (unsigned)((wid * QBLK + r32) * LD + hi * 8) * 2u;
#pragma unroll
    for (int d0 = 0; d0 < 8; ++d0) qr[d0] = *(const bf16x8*)((const char*)Qb + qoff + d0 * 32); }
  const int vb0 = (int)(uintptr_t)V_lds + v_rd_base(lane);
  unsigned kof[2], vof[2];
#pragma unroll
  for (int i = 0; i < 2; ++i) { const int ob = ((i * 8 + wid) * 64 + lane) * 16, row = ob >> 8, cb = (ob & 255) ^ ((row & 7) << 4); kof[i] = (unsigned)(row * LD * 2 + cb);
    const int st = ob >> 9, e = (ob & 511) >> 1, kk = (st >> 2) * 8 + (e >> 5), c = (st & 3) * 32 + (e & 31), k = (kk & ~0xC) | ((kk & 4) << 1) | ((kk & 8) >> 1); vof[i] = (unsigned)(k * LD * 2 + c * 2); }
#define ADMA(t) do { const size_t to_ = (size_t)((t) * KVBLK) * (LD * 2); const int so_ = ((t) & 3) * SHM_V; _Pragma("unroll") for (int i_ = 0; i_ < 2; ++i_) { \
    __builtin_amdgcn_global_load_lds((const unsigned*)((const char*)Kh + to_ + kof[i_]), (LAS unsigned*)(LAS char*)(K_lds + so_ + (i_ * 8 + wid) * 1024), 16, 0, 0); \
    __builtin_amdgcn_global_load_lds((const unsigned*)((const char*)Vh + to_ + vof[i_]), (LAS unsigned*)(LAS char*)(V_lds + so_ + (i_ * 8 + wid) * 1024), 16, 0, 0); } } while (0)
#define AWAIT(more) do { if (more) asm volatile("s_waitcnt vmcnt(4)" ::: "memory"); else asm volatile("s_waitcnt vmcnt(0)" ::: "memory"); } while (0)
#define RESC(a) do { if (__any((a) < 1.f)) { if (hi == 0) al_l[r32] = (a); asm volatile("s_waitcnt lgkmcnt(0)" ::: "memory"); \
    for (int d = 0; d < 4; ++d) for (int r = 0; r < 16; ++r) o[d][r] *= al_l[crow(r, hi)]; } } while (0)
  f32x16 pA0, pA1, pB0, pB1; float mnA, mnB, alA, alB; bf16x8 pa0, pa1, pa2, pa3; const int NT = seq / KVBLK;
  const int hf = wid >> 2;
#define AMID(more) do { if (more) asm volatile("s_waitcnt vmcnt(4)" ::: "memory"); else asm volatile("s_waitcnt vmcnt(0)" ::: "memory"); __syncthreads(); } while (0)
  ADMA(0); ADMA(1); asm volatile("s_waitcnt vmcnt(0)" ::: "memory"); __syncthreads();
  if (2 < NT) ADMA(2);
  qkt_pipe(pA0, pA1, (int)(uintptr_t)K_lds, qr, r32, hi); SBAR(); partialSM(pA0, pA1, m_reg, mnA, alA); SBAR();
  if (hf == 0) {
    for (int j = 1; j + 1 < NT; j += 2) {
      AWAIT(true); __syncthreads();
      if (j + 2 < NT) ADMA(j + 2);
      SBAR(); qkt_pipe(pB0, pB1, (int)(uintptr_t)K_lds + (j & 3) * SHM_K, qr, r32, hi); SBAR(); finishSM(pA0, pA1, alA, l_reg, pa0, pa1, pa2, pa3);
      SBAR(); AMID(j + 2 < NT); SBAR();
      pv_d0(o, vb0 + ((j - 1) & 3) * SHM_V, pa0, pa1, pa2, pa3); SBAR(); partialSM(pB0, pB1, m_reg, mnB, alB); RESC(alB);
      AWAIT(j + 2 < NT); __syncthreads();
      if (j + 3 < NT) ADMA(j + 3);
      SBAR(); qkt_pipe(pA0, pA1, (int)(uintptr_t)K_lds + ((j + 1) & 3) * SHM_K, qr, r32, hi); SBAR(); finishSM(pB0, pB1, alB, l_reg, pa0, pa1, pa2, pa3);
      SBAR(); AMID(j + 3 < NT); SBAR();
      pv_d0(o, vb0 + (j & 3) * SHM_V, pa0, pa1, pa2, pa3); SBAR(); partialSM(pA0, pA1, m_reg, mnA, alA); RESC(alA);
    }
    asm volatile("s_waitcnt vmcnt(0)" ::: "memory"); __syncthreads();
    SBAR(); qkt_pipe(pB0, pB1, (int)(uintptr_t)K_lds + ((NT - 1) & 3) * SHM_K, qr, r32, hi); SBAR(); finishSM(pA0, pA1, alA, l_reg, pa0, pa1, pa2, pa3);
    SBAR(); __syncthreads(); SBAR();
    pv_d0(o, vb0 + ((NT - 2) & 3) * SHM_V, pa0, pa1, pa2, pa3); SBAR(); partialSM(pB0, pB1, m_reg, mnB, alB); RESC(alB);
  } else {
    qkt_pipe(pB0, pB1, (int)(uintptr_t)K_lds + SHM_K, qr, r32, hi);
    for (int j = 1; j + 1 < NT; j += 2) {
      AWAIT(true); __syncthreads();
      if (j + 2 < NT) ADMA(j + 2);
      SBAR(); finishSM(pA0, pA1, alA, l_reg, pa0, pa1, pa2, pa3); SBAR(); pv_d0(o, vb0 + ((j - 1) & 3) * SHM_V, pa0, pa1, pa2, pa3);
      SBAR(); AMID(j + 2 < NT); SBAR();
      partialSM(pB0, pB1, m_reg, mnB, alB); RESC(alB); SBAR(); qkt_pipe(pA0, pA1, (int)(uintptr_t)K_lds + ((j + 1) & 3) * SHM_K, qr, r32, hi);
      AWAIT(j + 2 < NT); __syncthreads();
      if (j + 3 < NT) ADMA(j + 3);
      SBAR(); finishSM(pB0, pB1, alB, l_reg, pa0, pa1, pa2, pa3); SBAR(); pv_d0(o, vb0 + (j & 3) * SHM_V, pa0, pa1, pa2, pa3);
      SBAR(); AMID(j + 3 < NT); SBAR();
      partialSM(pA0, pA1, m_reg, mnA, alA); RESC(alA); SBAR(); qkt_pipe(pB0, pB1, (int)(uintptr_t)K_lds + ((j + 2) & 3) * SHM_K, qr, r32, hi);
    }
    asm volatile("s_waitcnt vmcnt(0)" ::: "memory"); __syncthreads();
    SBAR(); finishSM(pA0, pA1, alA, l_reg, pa0, pa1, pa2, pa3); SBAR(); pv_d0(o, vb0 + ((NT - 2) & 3) * SHM_V, pa0, pa1, pa2, pa3);
    SBAR(); __syncthreads(); SBAR();
    partialSM(pB0, pB1, m_reg, mnB, alB); RESC(alB);
  }
  SBAR();
  finishSM(pB0, pB1, alB, l_reg, pa0, pa1, pa2, pa3); SBAR();
  pv_d0(o, vb0 + ((NT - 1) & 3) * SHM_V, pa0, pa1, pa2, pa3); SBAR();
#undef AMID
#define ZLD(i) (*(const u32x4*)((const char*)Zb + (unsigned)((wid * QBLK + (i) * 4 + (lane >> 4)) * LD + (lane & 15) * 8) * 2u))
  u32x4 za, zb; if constexpr (GATED) { za = ZLD(0); zb = ZLD(1); }
  if (hi == 0) li_l[r32] = l_reg; asm volatile("s_waitcnt lgkmcnt(0)" ::: "memory");
  float rli[16];
#pragma unroll
  for (int r = 0; r < 16; ++r) rli[r] = __builtin_amdgcn_rcpf(li_l[crow(r, hi)]);
  __syncthreads();
  { bf16_t* stg = (bf16_t*)lds + wid * 4096;
#pragma unroll
    for (int r = 0; r < 16; ++r) { const int orow = crow(r, hi);
#pragma unroll
      for (int d0 = 0; d0 < 4; ++d0) stg[orow * 128 + d0 * 32 + r32] = (bf16_t)f2bf(o[d0][r] * rli[r]); }
    asm volatile("s_waitcnt lgkmcnt(0)" ::: "memory");
#pragma unroll 1
    for (int i = 0; i < 8; i += 2) { u32x4 na, nb; if constexpr (GATED) { const int i2 = (i + 2) & 7; na = ZLD(i2); nb = ZLD(i2 + 1); }
#pragma unroll
      for (int q = 0; q < 2; ++q) { const int row = (i + q) * 4 + (lane >> 4), ch = lane & 15; u32x4 v = *(const u32x4*)(stg + row * 128 + ch * 8);
        if constexpr (GATED) { const u32x4 z = q ? zb : za;
          v.x = pk2(bflo(v.x) * siluf_(bflo(z.x)), bfhi(v.x) * siluf_(bfhi(z.x))); v.y = pk2(bflo(v.y) * siluf_(bflo(z.y)), bfhi(v.y) * siluf_(bfhi(z.y)));
          v.z = pk2(bflo(v.z) * siluf_(bflo(z.z)), bfhi(v.z) * siluf_(bfhi(z.z))); v.w = pk2(bflo(v.w) * siluf_(bflo(z.w)), bfhi(v.w) * siluf_(bfhi(z.w))); }
        *(u32x4*)((char*)Ob + (unsigned)((wid * QBLK + row) * ldo + ch * 8) * 2u) = v; }
      if constexpr (GATED) { za = na; zb = nb; } }
#undef ZLD
    asm volatile("s_waitcnt lgkmcnt(0)" ::: "memory"); }
  __syncthreads();
#undef ADMA
#undef AWAIT
#undef RESC
}
#define PVH_PK(L, H) (bf16x8){L[0], L[1], L[2], L[3], H[0], H[1], H[2], H[3]}
template <int D0> __device__ __forceinline__ void pvh_step(f32x16* o, int vb, bf16x8 pa0, bf16x8 pa1, bf16x8 pa2, bf16x8 pa3, s16x4& l0, s16x4& h0, s16x4& l1, s16x4& h1, s16x4& l2, s16x4& h2, s16x4& l3, s16x4& h3) {
  asm volatile("s_waitcnt lgkmcnt(4)" ::: "memory"); SBAR();
  o[D0] = __builtin_amdgcn_mfma_f32_32x32x16_bf16(pa0, PVH_PK(l0, h0), o[D0], 0, 0, 0); o[D0] = __builtin_amdgcn_mfma_f32_32x32x16_bf16(pa1, PVH_PK(l1, h1), o[D0], 0, 0, 0); SBAR();
  if constexpr (D0 < 3) { l0 = tr_read<v_rd_off(D0 + 1, 0, 0)>(vb); h0 = tr_read<v_rd_off(D0 + 1, 0, 1)>(vb); l1 = tr_read<v_rd_off(D0 + 1, 1, 0)>(vb); h1 = tr_read<v_rd_off(D0 + 1, 1, 1)>(vb);
    asm volatile("s_waitcnt lgkmcnt(4)" ::: "memory"); } else asm volatile("s_waitcnt lgkmcnt(0)" ::: "memory");
  SBAR();
  o[D0] = __builtin_amdgcn_mfma_f32_32x32x16_bf16(pa2, PVH_PK(l2, h2), o[D0], 0, 0, 0); o[D0] = __builtin_amdgcn_mfma_f32_32x32x16_bf16(pa3, PVH_PK(l3, h3), o[D0], 0, 0, 0); SBAR();
  if constexpr (D0 < 3) { l2 = tr_read<v_rd_off(D0 + 1, 2, 0)>(vb); h2 = tr_read<v_rd_off(D0 + 1, 2, 1)>(vb); l3 = tr_read<v_rd_off(D0 + 1, 3, 0)>(vb); h3 = tr_read<v_rd_off(D0 + 1, 3, 1)>(vb); }
}
__device__ __forceinline__ void pv_d0p(f32x16* o, int vb, bf16x8 pa0, bf16x8 pa1, bf16x8 pa2, bf16x8 pa3) {
  s16x4 l0 = tr_read<v_rd_off(0, 0, 0)>(vb), h0 = tr_read<v_rd_off(0, 0, 1)>(vb), l1 = tr_read<v_rd_off(0, 1, 0)>(vb), h1 = tr_read<v_rd_off(0, 1, 1)>(vb);
  s16x4 l2 = tr_read<v_rd_off(0, 2, 0)>(vb), h2 = tr_read<v_rd_off(0, 2, 1)>(vb), l3 = tr_read<v_rd_off(0, 3, 0)>(vb), h3 = tr_read<v_rd_off(0, 3, 1)>(vb);
  pvh_step<0>(o, vb, pa0, pa1, pa2, pa3, l0, h0, l1, h1, l2, h2, l3, h3); pvh_step<1>(o, vb, pa0, pa1, pa2, pa3, l0, h0, l1, h1, l2, h2, l3, h3);
  pvh_step<2>(o, vb, pa0, pa1, pa2, pa3, l0, h0, l1, h1, l2, h2, l3, h3); pvh_step<3>(o, vb, pa0, pa1, pa2, pa3, l0, h0, l1, h1, l2, h2, l3, h3);
}
#undef PVH_PK
constexpr int P2_K = 65536, P2_MB = 98304, P2_SCR = 139264, P2_HSX = P2_SCR + NW * 64 * 4, SHM_PAIR = P2_HSX + 1024;
template <int LD, int ldo, int M, bool COMB>
__device__ __forceinline__ void attn_pair_map(unsigned char* const wsb, CArgsP ap, const float lam, const int qrow, const int bq, const int h, int seq, char* lds, int tid) {
  asm volatile("" : "+v"(tid));
  constexpr int m = M;
  const int wid = tid >> 6, lane = tid & 63, r32 = lane & 31, hi = lane >> 5, pr = wid & 3, g = wid >> 2;
  const bf16_t* __restrict__ Vh; const bf16_t* __restrict__ K0; const bf16_t* __restrict__ Q0;
  { unsigned char* w_ = wsb; asm volatile("" : "+s"(w_)); const bf16_t* U_ = (const bf16_t*)(w_ + WS_U);
    Q0 = U_ + (size_t)qrow * LD + h * 128; K0 = U_ + (size_t)(bq * TT) * LD + 2048 + h * 128; Vh = U_ + (size_t)(bq * TT) * LD + 4096 + h * 256; }
  char* V_lds = lds; char* K_lds = lds + P2_K; char* MB = lds + P2_MB + pr * 10240;
  float* ws = (float*)(lds + P2_SCR) + wid * 64; float* li_l = ws; float* al_l = ws + 32;
  const int vb0 = (int)(uintptr_t)V_lds + v_rd_base(lane) + g * SHM_V;
  unsigned kof[2], vof[4];
#pragma unroll
  for (int i = 0; i < 2; ++i) { const int ob = ((i * 8 + wid) * 64 + lane) * 16, row = ob >> 8, cb = (ob & 255) ^ ((row & 7) << 4); kof[i] = (unsigned)(row * LD * 2 + cb); }
#pragma unroll
  for (int i = 0; i < 4; ++i) { const int ob = ((i * 8 + wid) * 64 + lane) * 16, vh = ob >> 14, oi = ob & 16383, st = oi >> 9, e = (oi & 511) >> 1, kk = (st >> 2) * 8 + (e >> 5), c = (st & 3) * 32 + (e & 31);
    const int k = (kk & ~0xC) | ((kk & 4) << 1) | ((kk & 8) >> 1); vof[i] = (unsigned)(k * LD * 2 + (vh * 128 + c) * 2); }
#define P2_DMAK(t, slot) do { const char* kt_ = (const char*)Kh + (size_t)((t) * KVBLK) * (LD * 2); _Pragma("unroll") for (int i_ = 0; i_ < 2; ++i_) \
    __builtin_amdgcn_global_load_lds((const unsigned*)(kt_ + kof[i_]), (LAS unsigned*)(LAS char*)(K_lds + (slot) * SHM_K + (i_ * 8 + wid) * 1024), 16, 0, 0); } while (0)
#define P2_DMAV(t, slot) do { const char* vt_ = (const char*)Vh + (size_t)((t) * KVBLK) * (LD * 2); _Pragma("unroll") for (int i_ = 0; i_ < 4; ++i_) \
    __builtin_amdgcn_global_load_lds((const unsigned*)(vt_ + vof[i_]), (LAS unsigned*)(LAS char*)(V_lds + (slot) * (2 * SHM_V) + (i_ * 8 + wid) * 1024), 16, 0, 0); } while (0)
#define P2_RESC(a) do { if (__any((a) < 1.f)) { if (hi == 0) al_l[r32] = (a); asm volatile("s_waitcnt lgkmcnt(0)" ::: "memory"); \
    for (int d = 0; d < 4; ++d) for (int r = 0; r < 16; ++r) o[d][r] *= al_l[crow(r, hi)]; } } while (0)
  const int NT = seq / KVBLK;
  {
  const bf16_t* Qb = Q0 + m * 1024; const bf16_t* Kh = K0 + m * 1024;
  float m_reg = -1e30f, l_reg = 0; f32x16 o[4] = {}; bf16x8 qr[8];
  { const unsigned qoff = (unsigned)((pr * QBLK + r32) * LD + hi * 8) * 2u;
#pragma unroll
    for (int d0 = 0; d0 < 8; ++d0) qr[d0] = *(const bf16x8*)((const char*)Qb + qoff + d0 * 32); }
  f32x16 S0, S1; bf16x8 pa0, pa1, pa2, pa3;
  P2_DMAK(0, 0); P2_DMAK(1, 1); asm volatile("s_waitcnt vmcnt(0)" ::: "memory");
  __syncthreads();
  if (g == 0) qkt(S0, S1, (const bf16_t*)K_lds, qr, r32, hi);
  for (int j = 0; j <= NT; ++j) {
    const bool own = ((j & 1) == g);
    asm volatile("s_waitcnt vmcnt(0)" ::: "memory");
    __syncthreads();
    if (j + 2 < NT) P2_DMAK(j + 2, j & 1);
    if (j < NT) P2_DMAV(j, j & 1);
    SBAR();
    if (own) __builtin_amdgcn_s_setprio(2); else __builtin_amdgcn_s_setprio(0);
    if (own) {
      float alp = 1.f;
      if (j >= 1) { const char* mb = MB + ((j - 1) & 1) * 5120; alp = *(const float*)(mb + 4096 + lane * 4); m_reg = *(const float*)(mb + 4352 + lane * 4); l_reg = *(const float*)(mb + 4608 + lane * 4);
        asm volatile("s_waitcnt lgkmcnt(0)" ::: "memory"); }
      bf16x8 pn0, pn1, pn2, pn3; float al = 1.f;
      if (j < NT) { float mn; partialSM(S0, S1, m_reg, mn, al); finishSM(S0, S1, al, l_reg, pn0, pn1, pn2, pn3);
        char* mb = MB + (j & 1) * 5120;
        *(bf16x8*)(mb + lane * 16) = pn0; *(bf16x8*)(mb + 1024 + lane * 16) = pn1; *(bf16x8*)(mb + 2048 + lane * 16) = pn2; *(bf16x8*)(mb + 3072 + lane * 16) = pn3;
        *(float*)(mb + 4096 + lane * 4) = al; *(float*)(mb + 4352 + lane * 4) = m_reg; *(float*)(mb + 4608 + lane * 4) = l_reg; }
      SBAR();
      if (j >= 1) { const char* mb = MB + ((j - 1) & 1) * 5120;
        pa0 = *(const bf16x8*)(mb + lane * 16); pa1 = *(const bf16x8*)(mb + 1024 + lane * 16); pa2 = *(const bf16x8*)(mb + 2048 + lane * 16); pa3 = *(const bf16x8*)(mb + 3072 + lane * 16);
        P2_RESC(alp);
        asm volatile("s_waitcnt lgkmcnt(0)" ::: "memory"); SBAR();
        pv_d0p(o, vb0 + ((j - 1) & 1) * (2 * SHM_V), pa0, pa1, pa2, pa3); SBAR(); }
      if (j < NT) P2_RESC(al);
    } else {
      if (j >= 1) { const char* mb = MB + ((j - 1) & 1) * 5120;
        pa0 = *(const bf16x8*)(mb + lane * 16); pa1 = *(const bf16x8*)(mb + 1024 + lane * 16); pa2 = *(const bf16x8*)(mb + 2048 + lane * 16); pa3 = *(const bf16x8*)(mb + 3072 + lane * 16);
        asm volatile("s_waitcnt lgkmcnt(0)" ::: "memory"); SBAR();
        pv_d0p(o, vb0 + ((j - 1) & 1) * (2 * SHM_V), pa0, pa1, pa2, pa3); SBAR(); }
      if (j + 1 < NT) qkt(S0, S1, (const bf16_t*)(K_lds + ((j + 1) & 1) * SHM_K), qr, r32, hi);
    }
  }
  __builtin_amdgcn_s_setprio(0);
  if (hi == 0) li_l[r32] = l_reg; asm volatile("s_waitcnt lgkmcnt(0)" ::: "memory");
  float rli[16];
#pragma unroll
  for (int r = 0; r < 16; ++r) rli[r] = __builtin_amdgcn_rcpf(li_l[crow(r, hi)]);
  __syncthreads();
  { bf16_t* stg = (bf16_t*)lds + wid * 4096;
    unsigned char* w2_ = wsb; int lane_e = lane, pr_e = pr, g_e = g; asm volatile("" : "+s"(w2_), "+v"(lane_e), "+v"(pr_e), "+v"(g_e));
    bf16_t* Ob = (bf16_t*)(w2_ + WS_OD) + (size_t)qrow * ldo + h * 256; bf16_t* ObS = Ob + M * 8 * 256;
    const bf16_t* Zb = (const bf16_t*)(w2_ + WS_U) + (size_t)qrow * LD + 6144 + h * 256; bf16_t* Yb = (bf16_t*)(w2_ + WS_Y) + (size_t)qrow * DM + h * 256;
    const float* subg = ap->in[I_BSUBG];
#pragma unroll
    for (int r = 0; r < 16; ++r) { const int orow = crow(r, hi);
#pragma unroll
      for (int d0 = 0; d0 < 4; ++d0) stg[orow * 128 + d0 * 32 + r32] = (bf16_t)f2bf(o[d0][r] * rli[r]); }
    asm volatile("s_waitcnt lgkmcnt(0)" ::: "memory");
    if (!COMB) {
#pragma unroll 2
      for (int i = 0; i < 8; ++i) { const int row = i * 4 + (lane_e >> 4), ch = lane_e & 15; const u32x4 v = *(const u32x4*)(stg + row * 128 + ch * 8);
        *(u32x4*)((char*)ObS + (unsigned)((pr_e * QBLK + row) * ldo + g_e * 128 + ch * 8) * 2u) = v; }
      asm volatile("s_waitcnt lgkmcnt(0)" ::: "memory");
    } else {
      float* hsx = (float*)(lds + P2_HSX); const int ch = lane_e & 15;
#define P2_DIFF(v0, v1, od) do { od[0] = bflo(v0.x) - lam * bflo(v1.x); od[1] = bfhi(v0.x) - lam * bfhi(v1.x); od[2] = bflo(v0.y) - lam * bflo(v1.y); od[3] = bfhi(v0.y) - lam * bfhi(v1.y); \
        od[4] = bflo(v0.z) - lam * bflo(v1.z); od[5] = bfhi(v0.z) - lam * bfhi(v1.z); od[6] = bflo(v0.w) - lam * bflo(v1.w); od[7] = bfhi(v0.w) - lam * bfhi(v1.w); } while (0)
#pragma unroll 2
      for (int i = 0; i < 8; ++i) { const int row = i * 4 + (lane_e >> 4); const u32x4 v1 = *(const u32x4*)(stg + row * 128 + ch * 8);
        const u32x4 v0 = *(const u32x4*)((const char*)Ob + (unsigned)((pr_e * QBLK + row) * ldo + g_e * 128 + ch * 8) * 2u);
        float od[8]; P2_DIFF(v0, v1, od); float ss = 0.f;
#pragma unroll
        for (int k = 0; k < 8; ++k) ss += od[k] * od[k];
        ss += shx<1>(ss); ss += shx<2>(ss); ss += shx<4>(ss); ss += shx<8>(ss);
        if (ch == 0) hsx[(pr_e * QBLK + row) * 2 + g_e] = ss; }
      asm volatile("s_waitcnt lgkmcnt(0)" ::: "memory"); __syncthreads();
      const f32x4 sg0 = *(const f32x4*)(subg + g_e * 128 + ch * 8), sg1 = *(const f32x4*)(subg + g_e * 128 + ch * 8 + 4);
#pragma unroll 2
      for (int i = 0; i < 8; ++i) { const int row = i * 4 + (lane_e >> 4); const u32x4 v1 = *(const u32x4*)(stg + row * 128 + ch * 8);
        const u32x4 v0 = *(const u32x4*)((const char*)Ob + (unsigned)((pr_e * QBLK + row) * ldo + g_e * 128 + ch * 8) * 2u);
        const u32x4 zr = *(const u32x4*)((const char*)Zb + (unsigned)((pr_e * QBLK + row) * LD + g_e * 128 + ch * 8) * 2u);
        float od[8]; P2_DIFF(v0, v1, od);
        const float rstd = frsq((hsx[(pr_e * QBLK + row) * 2] + hsx[(pr_e * QBLK + row) * 2 + 1]) * (1.0f / 256.0f) + EPS);
        const float z[8] = {bflo(zr.x), bfhi(zr.x), bflo(zr.y), bfhi(zr.y), bflo(zr.z), bfhi(zr.z), bflo(zr.w), bfhi(zr.w)};
        const float sg[8] = {sg0[0], sg0[1], sg0[2], sg0[3], sg1[0], sg1[1], sg1[2], sg1[3]};
#pragma unroll
        for (int k = 0; k < 8; ++k) od[k] = (od[k] * rstd * sg[k]) * (1.0f - LAM_INIT1) * siluf_(z[k]);
        u32x4 w; w.x = pk2(od[0], od[1]); w.y = pk2(od[2], od[3]); w.z = pk2(od[4], od[5]); w.w = pk2(od[6], od[7]);
        *(u32x4*)((char*)Yb + (unsigned)((pr_e * QBLK + row) * DM + g_e * 128 + ch * 8) * 2u) = w; }
#undef P2_DIFF
      asm volatile("s_waitcnt lgkmcnt(0)" ::: "memory");
    } }
  __syncthreads();
  }
#undef P2_DMAK
#undef P2_DMAV
#undef P2_RESC
}
template <int LD, int ldo>
__device__ __forceinline__ void attn_unit_pair(unsigned char* const wsb, CArgsP ap, const float lam, const int qrow, const int bq, const int h, int seq, char* lds, const int tid) {
  attn_pair_map<LD, ldo, 0, false>(wsb, ap, lam, qrow, bq, h, seq, lds, tid);
  attn_pair_map<LD, ldo, 1, true>(wsb, ap, lam, qrow, bq, h, seq, lds, tid);
}
template <int LD, int ldo>
__device__ __forceinline__ void attn_unit_pair_one(unsigned char* const wsb, CArgsP ap, const int qrow, const int bq, const int h, const int m, int seq, char* lds, const int tid) {
  if (m == 0) attn_pair_map<LD, ldo, 0, false>(wsb, ap, 0.f, qrow, bq, h, seq, lds, tid);
  else        attn_pair_map<LD, ldo, 1, false>(wsb, ap, 0.f, qrow, bq, h, seq, lds, tid);
}
#undef KSWZ
#undef SBAR
}

constexpr int RING_BYTES = 131072, ATT_OST_OFF = 69632  , LDSCTL_OFF = 155648, MISC_OFF = LDSCTL_OFF + 320, LDS_BYTES = 163840;
static_assert(att::SHM_ATTN <= RING_BYTES && att::SHM_PAIR <= LDSCTL_OFF && MISC_OFF + 128 <= LDS_BYTES, "LDS map");
constexpr int NWAVES = 8;

typedef GAS unsigned gu32;
#define RLX_AGENT __ATOMIC_RELAXED, __HIP_MEMORY_SCOPE_AGENT
#define LDS_WAIT() asm volatile("s_waitcnt lgkmcnt(0)" ::: "memory")
#define VM_WAIT() asm volatile("s_waitcnt vmcnt(0)" ::: "memory")

#define XB_TMO      128
#define XB_XCNT(j)  (256  + 64 * (j))
#define XB_XSUB(j)  (1280 + 64 * (j))
#define XB_XGEN(j)  (2304 + 64 * (j))
#define XB_TOP      3328
#define XB_TOPGEN   3392
#define XCD_BAR_WORDS 3456
#define XB_SPIN_CAP (1u << 18)
__device__ __forceinline__ unsigned xb_ld(unsigned* p)              { return __hip_atomic_load(p, __ATOMIC_RELAXED, __HIP_MEMORY_SCOPE_AGENT); }
__device__ __forceinline__ unsigned xb_add(unsigned* p, unsigned v) { return __hip_atomic_fetch_add(p, v, __ATOMIC_RELAXED, __HIP_MEMORY_SCOPE_AGENT); }
__device__ __forceinline__ int lane_id_opaque() { int lo_, r_; asm volatile("v_mbcnt_lo_u32_b32 %0, -1, 0" : "=v"(lo_)); asm volatile("v_mbcnt_hi_u32_b32 %0, -1, %1" : "=v"(r_) : "v"(lo_)); return r_; }
__device__ __forceinline__ unsigned hw_slot() { return (unsigned)__builtin_amdgcn_s_getreg((5 << 11) | 4) & 63u; }
__device__ __forceinline__ unsigned xb_xcc_id() { return (unsigned)__builtin_amdgcn_s_getreg((3 << 11) | 20) & 0xFu; }
#define XB_SPIN(cond, bar) do { unsigned _sp = 0; while (cond) { __builtin_amdgcn_s_sleep(1); \
    if ((++_sp & 255u) == 0u) { if (xb_ld(&(bar)[XB_TMO])) break; if (_sp > XB_SPIN_CAP) { atomicAdd(&(bar)[XB_TMO], 1u); break; } } } } while (0)
struct XcdBarrier { unsigned* bar; unsigned x; volatile LAS unsigned* st; };
__device__ __forceinline__ XcdBarrier xcd_barrier_post(unsigned* bar, volatile LAS unsigned* st, bool is_t0) {
    XcdBarrier b; b.bar = bar; b.x = xb_xcc_id(); b.st = st;
    if (is_t0) (void)xb_add(&bar[XB_XCNT(b.x)], 1u);
    return b;
}
__device__ __forceinline__ void xcd_barrier_complete(unsigned* bar, unsigned x, unsigned& nloc, unsigned& nx) {
    const unsigned G = 256u;
    unsigned sum, cnt, mine, sp = 0u;
    for (;;) {
        sum = 0u; cnt = 0u; mine = 0u;
#pragma unroll
        for (unsigned j = 0; j < 16; ++j) { const unsigned c = xb_ld(&bar[XB_XCNT(j)]); sum += c; cnt += (c > 0u) ? 1u : 0u; mine = (j == x) ? c : mine; }
        if (sum == G) break;
        __builtin_amdgcn_s_sleep(1);
        if ((++sp & 255u) == 0u) { if (xb_ld(&bar[XB_TMO])) break; if (sp > XB_SPIN_CAP) { atomicAdd(&bar[XB_TMO], 1u); break; } }
    }
    nloc = mine > 0u ? mine : 1u; nx = cnt > 0u ? cnt : 1u;
}
__device__ __forceinline__ void xcd_barrier(const XcdBarrier& b, int wave_s) {
    asm volatile("s_waitcnt vmcnt(0)" ::: "memory");
    __syncthreads();
    if (wave_s == 0 && lane_id_opaque() == 0) {
        unsigned* bar = b.bar;
        __builtin_amdgcn_s_waitcnt(0);
        unsigned nloc = b.st[0], nx = b.st[1];
        if (nloc == 0u) { xcd_barrier_complete(bar, b.x, nloc, nx); b.st[0] = nloc; b.st[1] = nx; }
        const unsigned old = xb_add(&bar[XB_XSUB(b.x)], 1u);
        const unsigned gen = old / nloc;
        if (old + 1u == (gen + 1u) * nloc) {
            __builtin_amdgcn_fence(__ATOMIC_RELEASE, "agent");
            asm volatile("s_waitcnt vmcnt(0)" ::: "memory");
            const unsigned og = xb_add(&bar[XB_TOP], 1u);
            const unsigned tg = og / nx;
            if (og + 1u == (tg + 1u) * nx) xb_add(&bar[XB_TOPGEN], 1u);
            else XB_SPIN(xb_ld(&bar[XB_TOPGEN]) == tg, bar);
            __builtin_amdgcn_fence(__ATOMIC_ACQUIRE, "agent");
            xb_add(&bar[XB_XGEN(b.x)], 1u);
            asm volatile("s_waitcnt vmcnt(0)" ::: "memory");
        } else {
            XB_SPIN(xb_ld(&bar[XB_XGEN(b.x)]) == gen, bar);
            __builtin_amdgcn_fence(__ATOMIC_ACQUIRE, "agent");
            asm volatile("s_waitcnt vmcnt(0)" ::: "memory");
        }
    }
    __syncthreads();
}

__device__ __forceinline__ int p0_dst_row(int ns, int qkcols) {
    if (qkcols > 0) return (ns < qkcols) ? ((ns & ~127) | qk_pi_inv(ns & 127)) : ns;
    if (qkcols < 0) { const int code = -qkcols - 1, gate = code >> 4, dir = (code >> 3) & 1, nblk = code & 7, e = ns & 127;
        const int c = (((e >> 6) & 1) << 7) | (((e >> 4) & 3) << 5) | (((e >> 2) & 3) << 3) | (gate << 2) | (e & 3); return (nblk * 4 + dir * 2 + (ns >> 7)) * 256 + c; }
    return ns;
}
__device__ __forceinline__ void p0_transpose_item(const float* __restrict__ W, int K, int N, bf16_t* __restrict__ WT, LAS bf16_t* scr, int item, int lane, int qkcols, const float* shl = nullptr, float* shwp = nullptr) {
    const int nblk = N / 64, kb = item / nblk, nb = item % nblk, k0 = 64 * kb, n0 = 64 * nb;
    const int n4 = (lane & 15) * 4, kr = lane >> 4;
    f32x4 v[16];
#pragma unroll
    for (int i = 0; i < 16; ++i) v[i] = *(const f32x4*)(W + (size_t)(k0 + 4 * i + kr) * N + n0 + n4);
    float shv[5];
    if (shl) {
#pragma unroll
        for (int r = 0; r < 5; ++r) shv[r] = shl[(size_t)r * 6144 + k0 + lane]; }
#pragma unroll
    for (int i = 0; i < 16; ++i) { const int k = 4 * i + kr;
        scr[(n4 + 0) * 72 + k] = (bf16_t)f2bf(v[i].x); scr[(n4 + 1) * 72 + k] = (bf16_t)f2bf(v[i].y); scr[(n4 + 2) * 72 + k] = (bf16_t)f2bf(v[i].z); scr[(n4 + 3) * 72 + k] = (bf16_t)f2bf(v[i].w); }
    LAS float* shs = (LAS float*)(scr + 64 * 72);
    if (shl) {
#pragma unroll
        for (int r = 0; r < 5; ++r) shs[r * 64 + lane] = shv[r]; }
    LDS_WAIT(); asm volatile("" ::: "memory");
#pragma unroll
    for (int i = 0; i < 8; ++i) { const int n = 8 * i + (lane >> 3), kc = (lane & 7) * 8;
        const u32x4 o = *(const LAS u32x4*)(scr + n * 72 + kc);
        const int ns = n0 + n, nd = p0_dst_row(ns, qkcols);
        *(u32x4*)(WT + (size_t)nd * K + k0 + kc) = o; }
    if (shl) { float a0 = 0.f, a1 = 0.f, a2 = 0.f, a3 = 0.f, a4 = 0.f;
#pragma unroll 1
        for (int c = 0; c < 8; ++c) { const u32x4 w = *(const LAS u32x4*)(scr + lane * 72 + c * 8);
            const float wf[8] = {bflo(w.x), bfhi(w.x), bflo(w.y), bfhi(w.y), bflo(w.z), bfhi(w.z), bflo(w.w), bfhi(w.w)};
#pragma unroll
            for (int h = 0; h < 2; ++h) { const f32x4 s0 = *(const LAS f32x4*)(shs + c * 8 + h * 4), s1 = *(const LAS f32x4*)(shs + 64 + c * 8 + h * 4), s2 = *(const LAS f32x4*)(shs + 128 + c * 8 + h * 4),
                                 s3 = *(const LAS f32x4*)(shs + 192 + c * 8 + h * 4), s4 = *(const LAS f32x4*)(shs + 256 + c * 8 + h * 4);
#pragma unroll
                for (int e = 0; e < 4; ++e) { const float x = wf[h * 4 + e]; a0 += x * s0[e]; a1 += x * s1[e]; a2 += x * s2[e]; a3 += x * s3[e]; a4 += x * s4[e]; } } }
        const int nd = p0_dst_row(n0 + lane, qkcols); float* o = shwp + (size_t)kb * 5 * 8192 + nd;
        o[0] = a0; o[8192] = a1; o[2 * 8192] = a2; o[3 * 8192] = a3; o[4 * 8192] = a4; }
    LDS_WAIT(); asm volatile("" ::: "memory");
}
__device__ __forceinline__ void conv_job(const float* W, int N, bf16_t* WT, int qkcols, int shw_layer, unsigned char* ws, LAS unsigned char* ldsl, int wave, int lane, int widx, int nw) {
    LAS bf16_t* scr = (LAS bf16_t*)(ldsl + wave * 16384);
    const float* shl = shw_layer > 0 ? (const float*)(ws + WS_MODS) + (size_t)shw_layer * 5 * 6144 : nullptr;
    float* shwp = shw_layer > 0 ? (float*)(ws + WS_SHWP) + (size_t)(shw_layer - 1) * 32 * 5 * 8192 : nullptr;
    const int items = (DM / 64) * (N / 64);
    for (int it = widx; it < items; it += nw) { int l2 = lane; asm volatile("" : "+v"(l2));
        p0_transpose_item(W, DM, N, WT, scr, it, l2, qkcols, shl, shwp); }
}
__device__ __forceinline__ void sincos_d(float angf, float& s, float& c) {
    const double a = (double)angf; const double kq = rint(a * 0.63661977236758134308); const double r = a - kq * 1.57079632679489661923; const double r2 = r * r;
    const double sp = r * (1.0 + r2 * (-1.0 / 6 + r2 * (1.0 / 120 + r2 * (-1.0 / 5040 + r2 * (1.0 / 362880 + r2 * (-1.0 / 39916800 + r2 * (1.0 / 6227020800.0)))))));
    const double cp = 1.0 + r2 * (-0.5 + r2 * (1.0 / 24 + r2 * (-1.0 / 720 + r2 * (1.0 / 40320 + r2 * (-1.0 / 3628800 + r2 * (1.0 / 479001600.0))))));
    const int q = ((int)kq) & 3;
    const double ss = (q == 0) ? sp : (q == 1) ? cp : (q == 2) ? -sp : -cp;
    const double cc = (q == 0) ? cp : (q == 1) ? -sp : (q == 2) ? -cp : sp;
    s = (float)ss; c = (float)cc;
}

__device__ __forceinline__ void ada_fill_sil(CArgsP ap, LAS float* sil, int tid) {
    for (int i = tid; i < 5 * DM; i += NWAVES * 64) { const int r = i / DM, k = i - r * DM; const float v = (r < 4) ? ap->in[I_C][r * DM + k] : ap->in[I_CCTX][k]; sil[i] = siluf_(v); }
}
__device__ __forceinline__ void ada_item(CArgsP ap, unsigned char* ws, const LAS float* sil, int l, int kc, int ng, int lane) {
    const int nq = ng * 64 + lane;
    const float* wp = ap->in[I_ADAW] + ((size_t)l * DM + kc * 128) * 6144 + nq * 4;
    f32x4 a0 = {0, 0, 0, 0}, a1 = a0, a2 = a0, a3 = a0, a4 = a0;
#pragma unroll 8
    for (int k = 0; k < 128; ++k) { const f32x4 w = *(const f32x4*)(wp + (size_t)k * 6144); const int kk = kc * 128 + k;
        a0 += w * sil[kk]; a1 += w * sil[DM + kk]; a2 += w * sil[2 * DM + kk]; a3 += w * sil[3 * DM + kk]; a4 += w * sil[4 * DM + kk]; }
    if (kc == 0) { const f32x4 bv = *(const f32x4*)(ap->in[I_ADAB] + l * 6144 + nq * 4); a0 += bv; a1 += bv; a2 += bv; a3 += bv; a4 += bv; }
    float* mp = (float*)(ws + WS_AGG) + ((size_t)(kc * 4 + l) * 5) * 6144 + nq * 4;
    *(f32x4*)(mp) = a0; *(f32x4*)(mp + 6144) = a1; *(f32x4*)(mp + 2 * 6144) = a2; *(f32x4*)(mp + 3 * 6144) = a3; *(f32x4*)(mp + 4 * 6144) = a4;
}
__device__ __forceinline__ void ada_layer(CArgsP ap, unsigned char* ws, const LAS float* sil, int l, int lane, int widx, int nw) {
    for (int it = widx; it < 384; it += nw) ada_item(ap, ws, sil, l, it / 24, it % 24, lane);
}
__device__ __forceinline__ void mods_reduce(CArgsP ap, unsigned char* ws, int l, int gt_, int NGT) {
    const float* part = (const float*)(ws + WS_AGG) + (size_t)l * 5 * 6144; float* mods = (float*)(ws + WS_MODS) + (size_t)l * 5 * 6144; float* GM = (float*)(ws + WS_GM) + (size_t)l * 5 * DM;
    for (int it = gt_; it < 5 * 6144 / 4; it += NGT) { f32x4 acc = {0.f, 0.f, 0.f, 0.f};
#pragma unroll
        for (int kc = 0; kc < 16; ++kc) acc += *(const f32x4*)(part + (size_t)kc * 4 * 5 * 6144 + (size_t)it * 4);
        *(f32x4*)(mods + (size_t)it * 4) = acc;
        const int r = (it * 4) / 6144, c = it * 4 - r * 6144;
        if (l >= 1 && c >= DM && c < 2 * DM) { const f32x4 g = *(const f32x4*)(ap->in[I_NORMG] + l * DM + (c - DM)); *(f32x4*)(GM + (size_t)r * DM + (c - DM)) = g * (acc + 1.0f); } }
}

__device__ __forceinline__ void fresh_ids(LAS unsigned char* ldsl, int& bx, int& wave, int& lane) {
    bx = __builtin_amdgcn_readfirstlane((int)((volatile LAS unsigned*)(ldsl + MISC_OFF))[12]); wave = __builtin_amdgcn_readfirstlane((int)((volatile LAS unsigned*)(ldsl + LDSCTL_OFF))[hw_slot()]); lane = lane_id_opaque();
    asm volatile("" : "+s"(bx), "+s"(wave), "+v"(lane));
}

enum { K_PRO, K_MODRED, K_PRE0, K_GEMM_BF16, K_GEMM_RES, K_GEMM_GATES, K_QKPOST, K_ATT_A, K_ATT_B, K_COMBINE, K_CONV, K_SCAN_AGG, K_SCAN_APPLY, K_FINAL };
template <int KIND, int layer, int PH, bool DUPRUN = false>
__device__ __forceinline__ void run_phase(char* ldsg, int wave_s) {
    LAS unsigned char* ldsl = (LAS unsigned char*)ldsg;
    CArgsP ap = (CArgsP)__builtin_amdgcn_kernarg_segment_ptr();
    asm volatile("" : "+s"(ap));
    int G = pg8::GRID, bx = __builtin_amdgcn_readfirstlane((int)((volatile LAS unsigned*)(ldsl + MISC_OFF))[12]), wave = wave_s;
    asm volatile("" : "+s"(G)); asm volatile("" : "+s"(bx)); asm volatile("" : "+s"(wave));
    int tid = wave * 64 + lane_id_opaque();
    asm volatile("" : "+v"(tid));
    const int lane = tid & 63;
    const int vcu = (G % 8 == 0) ? (bx % 8) * (G / 8) + bx / 8 : bx;
    const int gw = vcu * NWAVES + wave, NGW = G * NWAVES;
    const int gt_ = vcu * NWAVES * 64 + tid, NGT = G * NWAVES * 64;
    unsigned char* ws = ap->ws;
    float* mods = (float*)(ws + WS_MODS);
    float* tabc = (float*)(ws + WS_TAB); float* tabs = tabc + 96 * 32; float* c8t = (float*)(ws + WS_TAB + 65536);
    bf16_t* WA_IN = (bf16_t*)(ws + WS_WA_IN); bf16_t* WA_OUT = (bf16_t*)(ws + WS_WA_OUT); bf16_t* WB_IN = (bf16_t*)(ws + WS_WB_IN); bf16_t* WB_OUT = (bf16_t*)(ws + WS_WB_OUT);
    bf16_t* WR_IN = (bf16_t*)(ws + WS_WR_IN); bf16_t* WR_OUT = (bf16_t*)(ws + WS_WR_OUT); bf16_t* WG = (bf16_t*)(ws + WS_WG);
    float* X = (float*)(ws + WS_X); bf16_t* H = (bf16_t*)(ws + WS_H); bf16_t* Y = (bf16_t*)(ws + WS_Y); bf16_t* U = (bf16_t*)(ws + WS_U); bf16_t* OD = (bf16_t*)(ws + WS_OD);
    unsigned* SAB = (unsigned*)(ws + WS_SA); float* AGG = (float*)(ws + WS_AGG);
    bf16_t* UP = (bf16_t*)(ws + WS_UP); float* GM = (float*)(ws + WS_GM); float* SHW = (float*)(ws + WS_SHW); float* SSQ = (float*)(ws + WS_SSQ);
    (void)GM; (void)SHW; (void)SSQ; (void)mods; (void)tabc; (void)tabs; (void)c8t; (void)WA_IN; (void)WA_OUT; (void)WB_IN; (void)WB_OUT; (void)WR_IN; (void)WR_OUT; (void)WG; (void)X; (void)H; (void)Y; (void)U; (void)OD; (void)SAB; (void)AGG; (void)UP;
    (void)gw; (void)NGW; (void)gt_; (void)NGT; (void)lane; (void)ldsl;

    if constexpr (KIND == K_PRO) {
        {
            LAS float* sil = (LAS float*)ldsl;
            LAS int* ctr = (LAS int*)(ldsl + 40960 + NWAVES * 9216);
            if (tid == 0) *ctr = 0;
            ada_fill_sil(ap, sil, tid); __syncthreads();
            if (wave < 3) { const int it = bx + 256 * wave; ada_item(ap, ws, sil, it / 384, (it % 384) / 24, it % 24, lane); }
            LAS bf16_t* scr = (LAS bf16_t*)(ldsl + 40960 + wave * 9216);
            constexpr int I_AIN = (DM / 64) * (A_IN / 64), I_SQ = (DM / 64) * (DM / 64), I_BIN = (DM / 64) * (B_IN / 64);
            constexpr int NITEMS = I_AIN + I_SQ + I_BIN;
            static_assert(NITEMS % pg8::GRID == 0, "item list per workgroup");
            for (;;) {
                int k = 0; if (lane == 0) k = __hip_atomic_fetch_add(ctr, 1, __ATOMIC_RELAXED, __HIP_MEMORY_SCOPE_WORKGROUP);
                k = __builtin_amdgcn_readfirstlane(k); if (k >= NITEMS / pg8::GRID) break;
                int r = vcu + pg8::GRID * k;
                if (r < I_AIN) { p0_transpose_item(ap->in[I_AWIN], DM, A_IN, WA_IN, scr, r, lane, 2560); continue; } r -= I_AIN;
                if (r < I_SQ) { p0_transpose_item(ap->in[I_AWOUT], DM, DM, WA_OUT, scr, r, lane, 0); continue; } r -= I_SQ;
                p0_transpose_item(ap->in[I_BWIN], DM, B_IN, WB_IN, scr, r, lane, 4096);
            }
        }
        for (int it = gt_; it < 96 * 32; it += NGT) { const int pos = it >> 5, j = it & 31; const float freq = powf(10000.0f, -(float)j / 32.0f); const float p = (float)(pos < 32 ? pos : pos - 32);
            float s, c; sincos_d(p * freq, s, c); tabc[it] = c; tabs[it] = s; }
        for (int it = gt_; it < 2 * DM; it += NGT) { const float lam = ap->in[I_RLAM][it]; const float z = -lam; const float sp = fmaxf(z, 0.f) + log1pf(__expf(-fabsf(z))); c8t[it] = 8.0f * sp; }
    }
    else if constexpr (KIND == K_MODRED) {
        mods_reduce(ap, ws, 0, gt_, NGT); mods_reduce(ap, ws, 1, gt_, NGT);
    }
    else if constexpr (KIND == K_PRE0) {
        { const float* gsrc = ap->in[I_NORMG];
          for (int row = gw; row < MROWS; row += NGW) {
            const int b = row / TT, t = row - b * TT; const float* mrow = mods + (size_t)(t < CTXL ? 4 : b) * 6144;
            const float* xsrc = (t < CTXL) ? ap->in[I_CTX] + (size_t)(b * CTXL + t) * DM : ap->in[I_X] + (size_t)(b * SEQ + t - CTXL) * DM;
            const f32x4* xr = (const f32x4*)xsrc + lane; f32x4 v[8]; float s = 0.f;
#pragma unroll
            for (int j = 0; j < 8; ++j) { v[j] = xr[64 * j]; s += (v[j].x * v[j].x + v[j].y * v[j].y) + (v[j].z * v[j].z + v[j].w * v[j].w); }
            s = wave_sum(s);
            if (lane < 32) SSQ[(size_t)row * 32 + lane] = (lane == 0) ? s : 0.f;
            u32x2* o8 = (u32x2*)(H + (size_t)row * DM) + lane;
#pragma unroll
            for (int j = 0; j < 8; ++j) { const int c = 4 * lane + 256 * j; const f32x4 g = *(const f32x4*)(gsrc + c), sc = *(const f32x4*)(mrow + DM + c);
                const f32x4 y = v[j] * g * (sc + 1.0f); u32x2 w; w.x = pk2(y.x, y.y); w.y = pk2(y.z, y.w); o8[64 * j] = w; }
          } }
        for (int l = 0; l < 2; ++l) {
            LAS float* shl = (LAS float*)ldsl;
            __syncthreads();
            for (int i = tid; i < 5 * DM; i += NWAVES * 64) { const int r = i >> 11, k = i & (DM - 1); shl[i] = mods[(size_t)(l * 5 + r) * 6144 + k]; }
            __syncthreads();
            const bf16_t* Wt = (l == 0) ? WA_IN : (l == 3) ? WA_IN + (size_t)A_IN * DM : (l == 1) ? WB_IN : WR_IN; const int N = (l == 1) ? B_IN : (l == 2) ? R_IN : A_IN;
            for (int n = gw; n < N; n += NGW) { float a0 = 0.f, a1 = 0.f, a2 = 0.f, a3 = 0.f, a4 = 0.f;
#pragma unroll
                for (int j = 0; j < 4; ++j) { const int k0 = j * 512 + lane * 8; const u32x4 w = *(const u32x4*)(Wt + (size_t)n * DM + k0);
                    const float wf[8] = {bflo(w.x), bfhi(w.x), bflo(w.y), bfhi(w.y), bflo(w.z), bfhi(w.z), bflo(w.w), bfhi(w.w)};
#pragma unroll
                    for (int e = 0; e < 8; ++e) { a0 += wf[e] * shl[k0 + e]; a1 += wf[e] * shl[DM + k0 + e]; a2 += wf[e] * shl[2 * DM + k0 + e]; a3 += wf[e] * shl[3 * DM + k0 + e]; a4 += wf[e] * shl[4 * DM + k0 + e]; } }
                a0 = wave_sum(a0); a1 = wave_sum(a1); a2 = wave_sum(a2); a3 = wave_sum(a3); a4 = wave_sum(a4);
                if (lane == 0) { float* o = SHW + (size_t)l * 5 * 8192 + n; o[0] = a0; o[8192] = a1; o[2 * 8192] = a2; o[3 * 8192] = a3; o[4 * 8192] = a4; } }
        }
    }
    else if constexpr (KIND == K_GEMM_BF16) {
        constexpr size_t OB = (layer == 0) ? WS_WA_IN : (layer == 3) ? WS_WA_IN + (size_t)A_IN * DM * 2 : (layer == 1) ? WS_WB_IN : WS_WR_IN;
        constexpr int N = (layer == 1) ? B_IN : (layer == 2) ? R_IN : A_IN;
        pg8::EpiBf16<layer, N> E{ws, ap};
        if constexpr (layer == 0) {
            typedef pg8::Sched<MROWS / 256, N / 256, DM / 64, 0, 0, TAIL_SPLIT> SchedT; SchedT S; S.init(bx, vcu);
            pg8::gemm_phase<pg8::EpiBf16<layer, N>, SchedT, DM / 64, PH, WS_H, OB>(ldsl, tid, S, E);
            if constexpr (!DUPRUN && SchedT::F == 1 && SchedT::T > 0) { int bx, wave, lane; fresh_ids(ldsl, bx, wave, lane); const int tid = wave * 64 + lane; if (bx >= SchedT::T) {
                CArgsP ap2 = (CArgsP)__builtin_amdgcn_kernarg_segment_ptr(); asm volatile("" : "+s"(ap2)); const CArgsP ap = ap2; unsigned char* const ws = ap2->ws;
                const int widx = (bx - SchedT::T) * NWAVES + wave, nw = (pg8::GRID - SchedT::T) * NWAVES;
                LAS float* sil = (LAS float*)ldsl; ada_fill_sil(ap, sil, tid); __syncthreads(); ada_layer(ap, ws, sil, 2, lane, widx, nw); ada_layer(ap, ws, sil, 3, lane, widx, nw); } }
        } else {
            constexpr int CLO = (layer == 3) ? 8 : 0, CHI = (layer == 3) ? 12 : N / 256;
            typedef pg8::SchedM<N / 256, DM / 64, CLO, CHI> SchedT; SchedT S; S.init(bx, vcu);
            constexpr size_t OB0 = (layer == 1) ? WS_WA_OUT : (layer == 2) ? WS_WB_OUT : WS_WR_OUT;
            pg8::EpiResid<layer - 1, false> E0{ws, ap};
            pg8::gemm_phase<pg8::EpiBf16<layer, N>, SchedT, DM / 64, PH, WS_H, OB, pg8::EpiResid<layer - 1, false>, WS_Y, OB0>(ldsl, tid, S, E, E0);
            if constexpr (!DUPRUN && SchedT::T > 0) { int bx, wave, lane; fresh_ids(ldsl, bx, wave, lane); const int tid = wave * 64 + lane; (void)tid; if (bx < SchedT::SH || bx >= SchedT::SH + SchedT::T) {
                CArgsP ap2 = (CArgsP)__builtin_amdgcn_kernarg_segment_ptr(); asm volatile("" : "+s"(ap2)); const CArgsP ap = ap2; unsigned char* const ws = ap2->ws;
                const int widx = ((bx < SchedT::SH) ? bx : bx - SchedT::T) * NWAVES + wave, nw = (pg8::GRID - SchedT::T) * NWAVES;
                if constexpr (layer == 1) { conv_job(ap->in[I_BWOUT], DM, (bf16_t*)(ws + WS_WB_OUT), 0, 0, ws, ldsl, wave, lane, widx, nw); conv_job(ap->in[I_RWIN], R_IN, (bf16_t*)(ws + WS_WR_IN), 0, 2, ws, ldsl, wave, lane, widx, nw); }
                if constexpr (layer == 2) { conv_job(ap->in[I_RWOUT], DM, (bf16_t*)(ws + WS_WR_OUT), 0, 0, ws, ldsl, wave, lane, widx, nw); conv_job(ap->in[I_AWIN] + (size_t)DM * A_IN, A_IN, (bf16_t*)(ws + WS_WA_IN) + (size_t)A_IN * DM, 2560, 3, ws, ldsl, wave, lane, widx, nw);
                    conv_job(ap->in[I_AWOUT] + (size_t)DM * DM, DM, (bf16_t*)(ws + WS_WA_OUT) + (size_t)DM * DM, 0, 0, ws, ldsl, wave, lane, widx, nw);
                    LAS bf16_t* scr = (LAS bf16_t*)(ldsl + wave * 16384);
                    for (int it = widx; it < 32 * 16; it += nw) { const int mtx = it >> 4, sub = it & 15; const int gate = mtx >> 4, dir = (mtx >> 3) & 1, nblk = mtx & 7;
                        p0_transpose_item((gate ? ap->in[I_RWX] : ap->in[I_RWA]) + (size_t)(dir * 8 + nblk) * 65536, 256, 256, (bf16_t*)(ws + WS_WG), scr, sub, lane, -(mtx + 1)); } } } }
        }
    }
    else if constexpr (KIND == K_GEMM_RES) {
        constexpr size_t OB = (layer == 0) ? WS_WA_OUT : (layer == 3) ? WS_WA_OUT + (size_t)DM * DM * 2 : (layer == 1) ? WS_WB_OUT : WS_WR_OUT;
        if constexpr ((layer == 1 || layer == 2) && !DUPRUN) {
            constexpr int LN = layer + 1, NN_ = (LN == 2) ? R_IN : A_IN;
            const float* pp = (const float*)(ws + WS_SHWP) + (size_t)(LN - 1) * 32 * 5 * 8192; float* dst = SHW + (size_t)LN * 5 * 8192;
            for (int i = gt_; i < 5 * NN_; i += NGT) { const int r = i / NN_, n = i - r * NN_; float pv[32];
#pragma unroll
                for (int kb = 0; kb < 32; ++kb) pv[kb] = pp[(size_t)kb * 5 * 8192 + (size_t)r * 8192 + n];
                float sv = 0.f;
#pragma unroll
                for (int kb = 0; kb < 32; ++kb) sv += pv[kb];
                dst[(size_t)r * 8192 + n] = sv; }
        }
        if constexpr (layer == 1 && !DUPRUN) {
            float s1 = ap->in[I_BLAM][lane] * ap->in[I_BLAM][128 + lane] + ap->in[I_BLAM][64 + lane] * ap->in[I_BLAM][192 + lane];
            float s2 = ap->in[I_BLAM][256 + lane] * ap->in[I_BLAM][384 + lane] + ap->in[I_BLAM][320 + lane] * ap->in[I_BLAM][448 + lane];
            s1 = wave_sum(s1); s2 = wave_sum(s2);
            const float lam = expf(s1) - expf(s2) + LAM_INIT1;
            const int hsel = lane >> 5, j = lane & 31;
            for (int it = gw; it < NB * CTXL * 4; it += NGW) { const int cr = it >> 2, row = (cr >> 8) * TT + (cr & 255), h = (it & 3) * 2 + hsel;
                const u32x4 r0 = *(const u32x4*)(OD + (size_t)row * 4096 + h * 256 + j * 8), r1 = *(const u32x4*)(OD + (size_t)row * 4096 + (8 + h) * 256 + j * 8), zr = *(const u32x4*)(U + (size_t)row * B_IN + 6144 + h * 256 + j * 8);
                float o[8] = {bflo(r0.x) - lam * bflo(r1.x), bfhi(r0.x) - lam * bfhi(r1.x), bflo(r0.y) - lam * bflo(r1.y), bfhi(r0.y) - lam * bfhi(r1.y),
                              bflo(r0.z) - lam * bflo(r1.z), bfhi(r0.z) - lam * bfhi(r1.z), bflo(r0.w) - lam * bflo(r1.w), bfhi(r0.w) - lam * bfhi(r1.w)};
                const float z[8] = {bflo(zr.x), bfhi(zr.x), bflo(zr.y), bfhi(zr.y), bflo(zr.z), bfhi(zr.z), bflo(zr.w), bfhi(zr.w)};
                float ss = 0.f;
#pragma unroll
                for (int k = 0; k < 8; ++k) ss += o[k] * o[k];
                ss += shx<1>(ss); ss += shx<2>(ss); ss += shx<4>(ss); ss += shx<8>(ss); ss += shx<16>(ss);
                const float rstd = frsq(ss * (1.0f / 256.0f) + EPS); const float* sg = ap->in[I_BSUBG] + j * 8;
#pragma unroll
                for (int k = 0; k < 8; ++k) o[k] = (o[k] * rstd * sg[k]) * (1.0f - LAM_INIT1) * siluf_(z[k]);
                u32x4 w; w.x = pk2(o[0], o[1]); w.y = pk2(o[2], o[3]); w.z = pk2(o[4], o[5]); w.w = pk2(o[6], o[7]);
                *(u32x4*)(Y + (size_t)row * DM + h * 256 + j * 8) = w; }
        }
        typedef pg8::Sched<32, DM / 256, DM / 64, 1, 0, TAIL_SPLIT> SchedT; SchedT S; S.init(bx, vcu);
        pg8::EpiResid<layer, DUPRUN> E{ws, ap};
        pg8::gemm_phase<pg8::EpiResid<layer, DUPRUN>, SchedT, DM / 64, PH, WS_Y, OB>(ldsl, tid, S, E);
    }
    else if constexpr (KIND == K_GEMM_GATES) {
        typedef pg8::Sched<MROWS / 256, 32, 4, 0, 1, false> SchedT; SchedT S; S.init(bx, vcu);
        pg8::EpiGates E{ws, ap};
        pg8::gemm_phase<pg8::EpiGates, SchedT, 4, PH, WS_UP, WS_WG>(ldsl, tid, S, E);
    }
    else if constexpr (KIND == K_ATT_A) {
        if constexpr (layer == 0 && !DUPRUN) { mods_reduce(ap, ws, 2, gt_, NGT); mods_reduce(ap, ws, 3, gt_, NGT); }
        const int nlat = 512, ntot = (layer == 0) ? 576 : 512;
        for (int u = vcu; u < ntot; u += G) {
            int b, h, qrow, seq;
            if (u < nlat) { const int qb = u & 7, hh = (u >> 3) & 15; b = u >> 7; h = hh; qrow = b * TT + CTXL + qb * 256; seq = TT; }
            else { const int v = u - nlat; b = v >> 4; h = v & 15; qrow = b * TT; seq = CTXL; }
            const int g4 = h >> 2;
            const bf16_t* Qb = U + (size_t)qrow * A_IN + h * 128;
            const bf16_t* Kh = U + (size_t)(b * TT) * A_IN + 2048 + g4 * 128;
            const bf16_t* Vh = U + (size_t)(b * TT) * A_IN + 2560 + g4 * 128;
            const bf16_t* Zb = U + (size_t)qrow * A_IN + 3072 + h * 128;
            att::attn_unit_dma<A_IN, DM, true>(Qb, Kh, Vh, Y + (size_t)qrow * DM + h * 128, Zb, seq, ldsg, tid);
        }
    }
    else if constexpr (KIND == K_ATT_B) {
        float s1 = ap->in[I_BLAM][lane] * ap->in[I_BLAM][128 + lane] + ap->in[I_BLAM][64 + lane] * ap->in[I_BLAM][192 + lane];
        float s2 = ap->in[I_BLAM][256 + lane] * ap->in[I_BLAM][384 + lane] + ap->in[I_BLAM][320 + lane] * ap->in[I_BLAM][448 + lane];
        s1 = wave_sum(s1); s2 = wave_sum(s2);
        const float lam = expf(s1) - expf(s2) + LAM_INIT1;
        for (int u = vcu; u < 640; u += G) {
            if (u < 512) { const int qb = u & 15, h = (u >> 4) & 7, b = u >> 7; att::attn_unit_pair<B_IN, 4096>(ws, ap, lam, b * TT + CTXL + qb * 128, b, h, TT, ldsg, tid); }
            else { const int v = u - 512; const int m = v & 1, qh = (v >> 1) & 1, h = (v >> 2) & 7, b = v >> 5; att::attn_unit_pair_one<B_IN, 4096>(ws, ap, b * TT + qh * 128, b, h, m, CTXL, ldsg, tid); }
        }
    }
    else if constexpr (KIND == K_COMBINE) {
        float s1 = ap->in[I_BLAM][lane] * ap->in[I_BLAM][128 + lane] + ap->in[I_BLAM][64 + lane] * ap->in[I_BLAM][192 + lane];
        float s2 = ap->in[I_BLAM][256 + lane] * ap->in[I_BLAM][384 + lane] + ap->in[I_BLAM][320 + lane] * ap->in[I_BLAM][448 + lane];
        s1 = wave_sum(s1); s2 = wave_sum(s2);
        const float lam = expf(s1) - expf(s2) + LAM_INIT1;
        const int hsel = lane >> 5, j = lane & 31;
        for (int it0 = gw; it0 < MROWS * 4; it0 += 2 * NGW) {
            u32x4 r0v[2], r1v[2], zrv[2]; bool ok[2];
#pragma unroll
            for (int q = 0; q < 2; ++q) { const int it = it0 + q * NGW; ok[q] = it < MROWS * 4; const int itc = ok[q] ? it : 0; const int row = itc >> 2, h = (itc & 3) * 2 + hsel;
                r0v[q] = *(const u32x4*)(OD + (size_t)row * 4096 + h * 256 + j * 8); r1v[q] = *(const u32x4*)(OD + (size_t)row * 4096 + (8 + h) * 256 + j * 8); zrv[q] = *(const u32x4*)(U + (size_t)row * B_IN + 6144 + h * 256 + j * 8); }
#pragma unroll
            for (int q = 0; q < 2; ++q) if (ok[q]) { const int it = it0 + q * NGW; const int row = it >> 2, h = (it & 3) * 2 + hsel; const u32x4 r0 = r0v[q], r1 = r1v[q], zr = zrv[q];
                float o[8] = {bflo(r0.x) - lam * bflo(r1.x), bfhi(r0.x) - lam * bfhi(r1.x), bflo(r0.y) - lam * bflo(r1.y), bfhi(r0.y) - lam * bfhi(r1.y),
                              bflo(r0.z) - lam * bflo(r1.z), bfhi(r0.z) - lam * bfhi(r1.z), bflo(r0.w) - lam * bflo(r1.w), bfhi(r0.w) - lam * bfhi(r1.w)};
                const float z[8] = {bflo(zr.x), bfhi(zr.x), bflo(zr.y), bfhi(zr.y), bflo(zr.z), bfhi(zr.z), bflo(zr.w), bfhi(zr.w)};
                float ss = 0.f;
#pragma unroll
                for (int k = 0; k < 8; ++k) ss += o[k] * o[k];
                ss += shx<1>(ss); ss += shx<2>(ss); ss += shx<4>(ss); ss += shx<8>(ss); ss += shx<16>(ss);
                const float rstd = frsq(ss * (1.0f / 256.0f) + EPS); const float* sg = ap->in[I_BSUBG] + j * 8;
#pragma unroll
                for (int k = 0; k < 8; ++k) o[k] = (o[k] * rstd * sg[k]) * (1.0f - LAM_INIT1) * siluf_(z[k]);
                u32x4 w; w.x = pk2(o[0], o[1]); w.y = pk2(o[2], o[3]); w.z = pk2(o[4], o[5]); w.w = pk2(o[6], o[7]);
                *(u32x4*)(Y + (size_t)row * DM + h * 256 + j * 8) = w; }
        }
    }
    else if constexpr (KIND == K_CONV) {
        const int c8 = (gt_ & 255) * 8;
        f32x4 wv[4][2], bv[2];
#pragma unroll
        for (int jj = 0; jj < 4; ++jj) { wv[jj][0] = *(const f32x4*)(ap->in[I_RCONVW] + jj * DM + c8); wv[jj][1] = *(const f32x4*)(ap->in[I_RCONVW] + jj * DM + c8 + 4); }
        bv[0] = *(const f32x4*)(ap->in[I_RCONVB] + c8); bv[1] = *(const f32x4*)(ap->in[I_RCONVB] + c8 + 4);
        for (int it = gt_; it < (MROWS / 4) * 256; it += NGT) {
            const int row0 = (it >> 8) * 4; const int b = row0 / TT, t0 = row0 - b * TT; const int lo = (t0 < CTXL) ? 0 : CTXL, hi_ = (t0 < CTXL) ? CTXL : TT;
            u32x4 rv[7];
#pragma unroll
            for (int q = 0; q < 7; ++q) { const int ts = t0 + q - 2; rv[q] = (ts >= lo && ts < hi_) ? *(const u32x4*)(U + (size_t)(b * TT + ts) * R_IN + c8) : (u32x4){0u, 0u, 0u, 0u}; }
#pragma unroll
            for (int r = 0; r < 4; ++r) { f32x4 a0 = bv[0], a1 = bv[1];
#pragma unroll
                for (int jj = 0; jj < 4; ++jj) { const u32x4 x = rv[r + jj]; a0 += (f32x4){bflo(x.x), bfhi(x.x), bflo(x.y), bfhi(x.y)} * wv[jj][0]; a1 += (f32x4){bflo(x.z), bfhi(x.z), bflo(x.w), bfhi(x.w)} * wv[jj][1]; }
                u32x4 o; o.x = pk2(a0.x, a0.y); o.y = pk2(a0.z, a0.w); o.z = pk2(a1.x, a1.y); o.w = pk2(a1.z, a1.w);
                *(u32x4*)(UP + (size_t)(row0 + r) * DM + c8) = o; }
        }
    }
    else if constexpr (KIND == K_SCAN_AGG) {
        const float* __restrict__ AGA = (const float*)(ws + WS_AG16); const float* __restrict__ AGB = AGA + (size_t)576 * 2 * DM; float* __restrict__ CAR = (float*)(ws + WS_CARRY);
        if (wave == 0 && vcu < 256) { const int b = vcu >> 6, dir = (vcu >> 5) & 1, ch = (vcu & 31) * 64 + lane; float h = 0.f;
            for (int k = 0; k < 9; ++k) {
                float av[16], bv[16]; unsigned off[16];
#pragma unroll
                for (int j = 0; j < 16; ++j) { const int q = 16 * k + j; const int c = dir ? (q < 16 ? 15 - q : 159 - q) : q; off[j] = (unsigned)(((b * 144 + c) * 2 + dir) * DM + ch); av[j] = AGA[off[j]]; bv[j] = AGB[off[j]]; }
#pragma unroll
                for (int j = 0; j < 16; ++j) { CAR[off[j]] = h; h = fmaf(av[j], h, bv[j]); }
            } }
    }
    else if constexpr (KIND == K_SCAN_APPLY) {
        const float* __restrict__ CAR = (const float*)(ws + WS_CARRY); const unsigned* __restrict__ SABr = SAB; const bf16_t* __restrict__ Ur = U; bf16_t* __restrict__ Yr = Y;
        for (int it = gt_; it < 576 * 512; it += NGT) {
            const int c4 = it & 511, g = it >> 9; const unsigned r0 = (unsigned)g * 16u;
            f32x4 hf = *(const f32x4*)(CAR + ((size_t)g * 2) * DM + c4 * 4), hr = *(const f32x4*)(CAR + ((size_t)g * 2 + 1) * DM + c4 * 4);
            u32x4 wf[16], wrv[16]; u32x2 zr[16];
#pragma unroll
            for (int s = 0; s < 16; ++s) { wf[s] = *(const u32x4*)(SABr + ((size_t)(r0 + s) * 2) * DM + c4 * 4); wrv[s] = *(const u32x4*)(SABr + ((size_t)(r0 + s) * 2 + 1) * DM + c4 * 4); zr[s] = *(const u32x2*)(Ur + (size_t)(r0 + s) * R_IN + DM + c4 * 4); }
            f32x4 hfv[16];
#pragma unroll
            for (int s = 0; s < 16; ++s) { const u32x4 w = wf[s];
                const f32x4 a = {__expf(bflo(w.x)), __expf(bflo(w.y)), __expf(bflo(w.z)), __expf(bflo(w.w))}, bb = {bfhi(w.x), bfhi(w.y), bfhi(w.z), bfhi(w.w)}; hf = a * hf + bb; hfv[s] = hf; }
#pragma unroll
            for (int s = 15; s >= 0; --s) { const u32x4 w = wrv[s];
                const f32x4 a = {__expf(bflo(w.x)), __expf(bflo(w.y)), __expf(bflo(w.z)), __expf(bflo(w.w))}, bb = {bfhi(w.x), bfhi(w.y), bfhi(w.z), bfhi(w.w)}; hr = a * hr + bb;
                const f32x4 y = hfv[s] + hr;
                u32x2 o; o.x = pk2(y.x * siluf_(bflo(zr[s].x)), y.y * siluf_(bfhi(zr[s].x))); o.y = pk2(y.z * siluf_(bflo(zr[s].y)), y.w * siluf_(bfhi(zr[s].y)));
                *(u32x2*)(Yr + (size_t)(r0 + s) * DM + c4 * 4) = o; }
        }
    }
    else {
        const float* gsrc = ap->in[I_NORMF];
        for (int r = gw; r < NB * SEQ; r += NGW) {
            const int b = r >> 11, t = r & (SEQ - 1); const size_t row = (size_t)b * TT + CTXL + t;
            const f32x4* xr = (const f32x4*)(X + row * DM) + lane; f32x4 v[8]; float s = 0.f;
#pragma unroll
            for (int j = 0; j < 8; ++j) { v[j] = xr[64 * j]; s += (v[j].x * v[j].x + v[j].y * v[j].y) + (v[j].z * v[j].z + v[j].w * v[j].w); }
            const float rstd = 1.0f / sqrtf(wave_sum(s) * (1.0f / DM) + EPS);
            f32x4* o = (f32x4*)(ap->out + (size_t)r * DM) + lane;
#pragma unroll
            for (int j = 0; j < 8; ++j) { const f32x4 g = *(const f32x4*)(gsrc + 4 * lane + 256 * j); o[64 * j] = (v[j] * rstd) * g; }
        }
    }
}

constexpr int N_PHASES_C = 19;
__global__ void __launch_bounds__(NWAVES * 64, 2) fwd_mega(Args args) {
    extern __shared__ __attribute__((aligned(16))) unsigned char lds[];
    LAS unsigned char* ldsl0 = (LAS unsigned char*)lds;
    for (int u = threadIdx.x; u < (LDS_BYTES - LDSCTL_OFF) / 4; u += NWAVES * 64) ((LAS unsigned*)(ldsl0 + LDSCTL_OFF))[u] = 0u;
    __syncthreads();
    { const int wv = __builtin_amdgcn_readfirstlane((int)threadIdx.x >> 6); if ((threadIdx.x & 63) == 0) ((volatile LAS unsigned*)(ldsl0 + LDSCTL_OFF))[hw_slot()] = (unsigned)wv;
      if (threadIdx.x == 0) ((volatile LAS unsigned*)(ldsl0 + MISC_OFF))[12] = blockIdx.x;
      if (!MK_PER_PHASE) (void)xcd_barrier_post((unsigned*)((gu32*)(args.ws + WS_CTL) + CW_BAR), (volatile LAS unsigned*)(ldsl0 + MISC_OFF) + 8, threadIdx.x == 0); }
    __syncthreads();
#define WAVE_IDX() ((int)__builtin_amdgcn_readfirstlane((int)((volatile LAS unsigned*)((LAS unsigned char*)lds + LDSCTL_OFF))[hw_slot()]))
#define KARG() ({ CArgsP ap_ = (CArgsP)__builtin_amdgcn_kernarg_segment_ptr(); asm volatile("" : "+s"(ap_)); ap_; })
#define GRID_BAR() do { CArgsP ap_ = KARG(); XcdBarrier b_; b_.bar = (unsigned*)((gu32*)(ap_->ws + WS_CTL) + CW_BAR); b_.x = xb_xcc_id(); b_.st = (volatile LAS unsigned*)((LAS unsigned char*)lds + MISC_OFF) + 8; xcd_barrier(b_, WAVE_IDX()); } while (0)
#if MK_PER_PHASE
#define PHASE(k, KIND, LAYER) if constexpr ((PH_MASK >> (k)) & 1) { CArgsP apq_ = KARG(); const int lo = apq_->ph_lo, hi = apq_->ph_hi; if (lo <= (k) && (k) < hi) { run_phase<KIND, LAYER, (k)>((char*)lds, WAVE_IDX()); } }
#else
#define PHASE(k, KIND, LAYER) if constexpr ((PH_MASK >> (k)) & 1) { run_phase<KIND, LAYER, (k)>((char*)lds, WAVE_IDX()); \
        if constexpr ((DUP_MASK >> (k)) & 1) { GRID_BAR(); run_phase<KIND, LAYER, 24 + ((k) & 7), true>((char*)lds, WAVE_IDX()); } \
        if constexpr ((k) + 1 < N_PHASES_C) { GRID_BAR(); if (DUP_BAR) GRID_BAR(); } }
#endif
    PHASE(0, K_PRO, 0) PHASE(1, K_MODRED, 0) PHASE(2, K_PRE0, 0)
    PHASE(3, K_GEMM_BF16, 0) PHASE(4, K_ATT_A, 0) PHASE(5, K_GEMM_RES, 0)
    PHASE(6, K_GEMM_BF16, 1) PHASE(7, K_ATT_B, 1) PHASE(9, K_GEMM_RES, 1)
    PHASE(10, K_GEMM_BF16, 2) PHASE(11, K_CONV, 2) PHASE(12, K_GEMM_GATES, 2) PHASE(13, K_SCAN_AGG, 2) PHASE(14, K_SCAN_APPLY, 2) PHASE(15, K_GEMM_RES, 2)
    PHASE(16, K_GEMM_BF16, 3) PHASE(17, K_ATT_A, 3) PHASE(18, K_GEMM_RES, 3)
#undef PHASE
#undef GRID_BAR
#undef KARG
#undef WAVE_IDX
}

constexpr int N_PHASES = N_PHASES_C;
extern "C" void kernel_launch(void* const* d_in, const int* in_sizes, int n_in, void* d_out, int out_size, void* d_ws, size_t ws_size, hipStream_t stream) {
    static int grid = 0;
    if (grid == 0) {
        if (n_in != 25 || in_sizes[0] != NB * SEQ * DM || out_size != NB * SEQ * DM || ws_size < WS_END) {
            fprintf(stderr, "kernel_launch: unexpected shapes: n_in %d in0 %d out %d ws %zu (need %zu)\n", n_in, n_in > 0 ? in_sizes[0] : -1, out_size, ws_size, (size_t)WS_END); grid = -1; return; }
        int dev = 0, cus = 0, per_cu = 0;
        if (hipGetDevice(&dev) != hipSuccess || hipDeviceGetAttribute(&cus, hipDeviceAttributeMultiprocessorCount, dev) != hipSuccess) { fprintf(stderr, "kernel_launch: device query failed\n"); grid = -1; return; }
        if (hipFuncSetAttribute((const void*)fwd_mega, hipFuncAttributeMaxDynamicSharedMemorySize, LDS_BYTES) != hipSuccess) { fprintf(stderr, "kernel_launch: hipFuncSetAttribute failed\n"); grid = -1; return; }
        if (hipOccupancyMaxActiveBlocksPerMultiprocessor(&per_cu, (const void*)fwd_mega, NWAVES * 64, LDS_BYTES) != hipSuccess || per_cu < 1) { fprintf(stderr, "kernel_launch: occupancy query says %d blocks/CU\n", per_cu); grid = -1; (void)hipGetLastError(); return; }
        if (cus != 256) { fprintf(stderr, "kernel_launch: built for a 256-CU device (MI355X), found %d CUs; nothing launched\n", cus); grid = -1; return; }
        grid = cus;
    }
    if (grid < 0) return;
    (void)hipMemsetAsync((char*)d_ws + WS_CTL, 0, CTL_ZERO_BYTES, stream);
    Args a{};
    for (int i = 0; i < 25; ++i) a.in[i] = (const float*)d_in[i];
    a.out = (float*)d_out; a.ws = (unsigned char*)d_ws;
#if MK_PER_PHASE
    for (int p = 0; p < N_PHASES; ++p) { a.ph_lo = p; a.ph_hi = p + 1; hipLaunchKernelGGL(fwd_mega, dim3(grid), dim3(NWAVES * 64), LDS_BYTES, stream, a); }
#else
    a.ph_lo = 0; a.ph_hi = N_PHASES;
    void* kargs[] = {&a};
    hipError_t e = hipLaunchCooperativeKernel((const void*)fwd_mega, dim3(grid), dim3(NWAVES * 64), kargs, LDS_BYTES, stream);
    if (e != hipSuccess) fprintf(stderr, "kernel_launch: cooperative launch failed: %s (grid %d)\n", hipGetErrorString(e), grid);
#endif
}
```

```cpp
#include <hip/hip_runtime.h>
#include <cstdio>
#include <cstdint>
#include <cmath>

#ifndef PH_MASK
#define PH_MASK 0x7ffff
#endif
#ifndef DUP_MASK
#define DUP_MASK 0
#endif
#ifndef DUP_SUB
#define DUP_SUB 0
#endif
#ifndef DUP_BAR
#define DUP_BAR 0
#endif
#ifndef TAIL_SPLIT
#define TAIL_SPLIT false
#endif
#ifndef MK_PER_PHASE
#define MK_PER_PHASE 0
#endif

constexpr int NB = 4, SEQ = 2048, CTXL = 256, DM = 2048, TT = SEQ + CTXL  , MROWS = NB * TT  ;
constexpr int A_IN = 5120, B_IN = 8192, R_IN = 4096;
constexpr float EPS = 1e-6f;
constexpr int CH = 32, NCH = TT / CH  , NCC = CTXL / CH  ;
constexpr float LAM_INIT1 = 0.35550906759096927f;

typedef unsigned short bf16_t;
typedef short bf16x8 __attribute__((ext_vector_type(8)));
typedef short s16x4 __attribute__((ext_vector_type(4)));
typedef float f32x4 __attribute__((ext_vector_type(4)));
typedef float f32x8 __attribute__((ext_vector_type(8)));
typedef float f32x16 __attribute__((ext_vector_type(16)));
typedef unsigned u32x4 __attribute__((ext_vector_type(4)));
typedef unsigned u32x2 __attribute__((ext_vector_type(2)));
#define LAS __attribute__((address_space(3)))
#define GAS __attribute__((address_space(1)))

__device__ __forceinline__ unsigned pk2(float lo, float hi) { unsigned r; asm("v_cvt_pk_bf16_f32 %0, %1, %2" : "=v"(r) : "v"(lo), "v"(hi)); return r; }
__device__ __forceinline__ unsigned f2bf(float f) { return pk2(f, 0.f) & 0xffffu; }
__device__ __forceinline__ float bflo(unsigned w) { return __uint_as_float(w << 16); }
__device__ __forceinline__ float bfhi(unsigned w) { return __uint_as_float(w & 0xffff0000u); }
__device__ __forceinline__ float bf1(bf16_t v) { return __uint_as_float((unsigned)v << 16); }
__device__ __forceinline__ unsigned cvt_pk_bf16(float lo, float hi) { unsigned r; asm volatile("v_cvt_pk_bf16_f32 %0, %1, %2" : "=v"(r) : "v"(lo), "v"(hi)); return r; }
__device__ __forceinline__ float frcp(float x) { return __builtin_amdgcn_rcpf(x); }
__device__ __forceinline__ float frsq(float x) { return __builtin_amdgcn_rsqf(x); }
__device__ __forceinline__ float fsqrt_(float x) { return __builtin_amdgcn_sqrtf(x); }
__device__ __forceinline__ float sigmoidf_(float x) { return frcp(1.0f + __expf(-x)); }
__device__ __forceinline__ float siluf_(float x) { return x * frcp(1.0f + __expf(-x)); }
template <int M> __device__ __forceinline__ float shx(float v) { return __int_as_float(__builtin_amdgcn_ds_swizzle(__float_as_int(v), (M << 10) | 0x1f)); }
__device__ __forceinline__ float wave_sum(float v) {
    v += shx<1>(v); v += shx<2>(v); v += shx<4>(v); v += shx<8>(v); v += shx<16>(v);
    auto rr = __builtin_amdgcn_permlane32_swap(__float_as_uint(v), __float_as_uint(v), false, false);
    return __uint_as_float(rr[0]) + __uint_as_float(rr[1]);
}

constexpr size_t MiB = 1u << 20;
constexpr size_t WS_CTL = 0, WS_MODS = 1 * MiB, CTL_ZERO_BYTES = 2 * MiB;
constexpr size_t WS_GM = 2 * MiB + 128 * 1024;
constexpr size_t WS_SHW = 2 * MiB + 512 * 1024;
constexpr size_t WS_SSQ = 282 * MiB;
constexpr size_t WS_FSQ = 281 * MiB;
constexpr size_t WS_SHWP = 568 * MiB;
constexpr size_t WS_TAB = 2 * MiB;
constexpr size_t WS_WA_IN = 4 * MiB, WS_WA_OUT = 44 * MiB, WS_WB_IN = 60 * MiB, WS_WB_OUT = 92 * MiB, WS_WR_IN = 100 * MiB, WS_WR_OUT = 116 * MiB, WS_WG = 124 * MiB;
constexpr size_t WS_X = 128 * MiB;
constexpr size_t WS_H = 200 * MiB;
constexpr size_t WS_Y = 236 * MiB;
constexpr size_t WS_AGG = 272 * MiB;
constexpr size_t WS_U = 284 * MiB;
constexpr size_t WS_OD = 428 * MiB;
constexpr size_t WS_UP = 356 * MiB;
constexpr size_t WS_SA = 392 * MiB;
constexpr size_t WS_AG16 = 536 * MiB;
constexpr size_t WS_CARRY = 556 * MiB;
constexpr size_t WS_SLAB = 568 * MiB;
constexpr size_t WS_DUMMY = 632 * MiB;
constexpr size_t WS_END = 584 * MiB;
constexpr int CW_BAR = 4096, CW_SEAM = 16384;

struct Args { const float* in[25]; float* out; unsigned char* ws; int ph_lo, ph_hi; };
typedef const __attribute__((address_space(4))) Args* CArgsP;
enum { I_X = 0, I_C, I_CTX, I_CCTX, I_ADAW, I_ADAB, I_NORMG, I_NORMF, I_AWIN, I_AQG, I_AKG, I_AWOUT, I_BWIN, I_BLAM, I_BSUBG, I_BWOUT,
       I_RWIN, I_RCONVW, I_RCONVB, I_RWA, I_RBA, I_RWX, I_RBX, I_RLAM, I_RWOUT };


__host__ __device__ __forceinline__ int qk_pi(int c) { return (c & 64) | (((c >> 2) & 1) << 5) | (((c >> 3) & 7) << 2) | (c & 3); }
__host__ __device__ __forceinline__ int qk_pi_inv(int e) { return (e & 64) | (((e >> 2) & 7) << 3) | (((e >> 5) & 1) << 2) | (e & 3); }

namespace pg8 {
constexpr int BM = 256, BK = 64, HALF = 128, HTB = HALF * BK * 2, STAGE_BYTES = 8 * HTB, NXCD = 8, WGM = 8;
__host__ __device__ __forceinline__ int lds_byte(int r, int c) { const int st = (r >> 4) * 2 + (c >> 5), rr = r & 15, cc = c & 31, ob = rr * 64 + cc * 2; return st * 1024 + (ob ^ (((ob >> 9) & 1) << 5)); }
__host__ __device__ __forceinline__ void stage_rc(int b, int& R, int& C) { const int st = b / 1024, sb = b % 1024, swz = sb ^ (((sb >> 9) & 1) << 5); R = (st >> 1) * 16 + swz / 64; C = (st & 1) * 32 + (swz % 64) / 2; }
__host__ __device__ __forceinline__ int perm32(int rho) { const int n = rho >> 4, i = rho & 15; return 8 * (i >> 2) + 4 * n + (i & 3); }

struct Unit { int pm, pn, acol, kofs, nt, kind; };

constexpr int GRID = 256;
template <int NM, int NN, int KT, int ROWMODE, int GATES, bool SPLIT> struct Sched {
    static constexpr int nM = NM, nN = NN, nwg = NM * NN, G = GRID, R = nwg / G, T = nwg - R * G;
    static constexpr int F0 = (!SPLIT || T == 0 || R == 0) ? 1 : (G / T >= 8 ? 8 : G / T >= 4 ? 4 : G / T >= 2 ? 2 : 1);
    static constexpr int F = (KT / F0 >= 4) ? F0 : (KT / (F0 / 2 > 0 ? F0 / 2 : 1) >= 4 ? (F0 / 2 > 0 ? F0 / 2 : 1) : 1);
    int c, v;
    __device__ void init(int c_, int v_) { c = c_; v = v_; }
    __device__ bool is_slice(int i) const { return F > 1 && i == R; }
    __device__ bool next(int i, Unit& u) const {
        long L; u.kofs = 0; u.nt = KT; u.kind = 0;
        if (GATES && T > 0 && 2 * T <= G && i == R) { if (c >= 2 * T) return false; L = (long)R * G + (c >> 1); u.kind = 1 + (c & 1); }
        else
        if (i < R) L = (long)i * G + c;
        else if (i == R && T > 0) { if (F == 1) { L = (long)R * G + c; if (L >= nwg) return false; } else { if (v >= T * F) return false; const int tt = v / F, sj = v - tt * F; u.nt = KT / F; u.kofs = sj * u.nt * BK; L = (long)R * G + tt; } }
        else return false;
        int wgid = (int)L; { const int q = nwg / NXCD, r = nwg % NXCD, xcd = wgid % NXCD, off = wgid / NXCD; wgid = (xcd < r ? xcd * (q + 1) : r * (q + 1) + (xcd - r) * q) + off; }
        const int nig = WGM * nN, gid = wgid / nig, fm = gid * WGM, gsz = (nM - fm) < WGM ? (nM - fm) : WGM;
        int pm = fm + ((wgid % nig) % gsz); u.pn = (wgid % nig) / gsz;
        if (ROWMODE == 1) pm = 9 * (pm >> 3) + 1 + (pm & 7);
        u.pm = pm; u.acol = GATES ? 256 * (u.pn >> 2) : 0; return true;
    }
};

template <int NN, int KT, int CLO, int CHI> struct SchedM {
    static constexpr int G = GRID, NLAT = 32 * NN, NCX = 4 * (CHI - CLO), TOT = 32 + NLAT + NCX, R = TOT / G, T = TOT - R * G, F = 1;
    static constexpr int SH = (T > 0 && T + 32 <= G) ? 32 : 0;
    int c;
    __device__ void init(int c_, int) { c = c_; }
    __device__ bool is_slice(int) const { return false; }
    __device__ bool next(int i, Unit& u) const {
        int L = i * G + c; if (i == R && T > 0) { const int cc = c - SH; if (cc < 0 || cc >= T) return false; L = R * G + cc; }
        if (L >= TOT) return false; u.kofs = 0; u.nt = KT; u.acol = 0;
        if (L < 32) { u.kind = 0; u.pm = 9 * (L >> 3); u.pn = L & 7; return true; }
        if (L < 32 + NLAT) { u.kind = 1; constexpr int nwg = NLAT; int wgid = L - 32; { constexpr int q = nwg / NXCD; const int xcd = wgid % NXCD, off = wgid / NXCD; wgid = xcd * q + off; }
            constexpr int nig = WGM * NN; const int gid = wgid / nig, fm = gid * WGM; const int pmi = fm + ((wgid % nig) % WGM); u.pn = (wgid % nig) / WGM; u.pm = 9 * (pmi >> 3) + 1 + (pmi & 7); return true; }
        const int r = L - 32 - NLAT; u.kind = 2; u.pm = 9 * (r / (CHI - CLO)); u.pn = CLO + r % (CHI - CLO); return true;
    }
};

__device__ __forceinline__ int opq(int x) { asm volatile("" : "+s"(x)); return x; }
constexpr int RSTD_OFF = 131072;
constexpr int SHWT_OFF = 147456;
constexpr int HSQ_OFF = 139264;
template <int LAYER, int N> struct EpiBf16 {
    unsigned char* ws; CArgsP ap;
    static constexpr int QKT = (LAYER == 1) ? 16 : (LAYER == 2) ? 0 : 10; static constexpr bool RMS = (LAYER != 1);
    template <class SchedT> __device__ __forceinline__ void prep(LAS unsigned char* lds, const SchedT& S, int tid) const {
        const float* ssq = (const float*)(ws + WS_SSQ); Unit u;
        for (int i = 0; i < 8 && S.next(i, u); ++i) if (tid < 256) { const f32x4* p4 = (const f32x4*)(ssq + (size_t)(u.pm * BM + tid) * 32); float s = 0.f;
#pragma unroll
            for (int j = 0; j < 8; ++j) { const f32x4 v = p4[j]; s += (v.x + v.y) + (v.z + v.w); }
            ((LAS float*)(lds + opq(RSTD_OFF)))[i * 256 + tid] = frsq(s * (1.0f / DM) + EPS); }
        else { const int t2 = tid - 256; const int bq = u.pm / 9, mr = (u.pm - 9 * bq) == 0 ? 4 : bq; float sv;
            sv = ((const float*)(ws + WS_SHW))[(size_t)(LAYER * 5 + mr) * 8192 + u.pn * BM + t2];
            ((LAS float*)(lds + opq(SHWT_OFF)))[i * 256 + t2] = sv; }
    }
    __device__ __forceinline__ void operator()(f32x4 (&acc)[2][2][4][2], const Unit& u, int ui, LAS unsigned char* lds, int wr, int wc, int tl_, unsigned gmask) const {
        unsigned char* w_ = ws; asm volatile("" : "+v"(tl_), "+s"(w_)); const int lane = tl_ & 63, fr = lane & 15, fq = lane >> 4;
        const int bq = u.pm / 9, pr_ = u.pm - 9 * bq, isctx = pr_ == 0;
        bf16_t* O = (bf16_t*)(w_ + WS_U);
        const int rl0 = wr * 64 + fr, row0 = u.pm * BM + rl0, col0 = u.pn * BM + wc * 32 + 8 * fq;
        const LAS float* rt = (const LAS float*)(lds + opq(RSTD_OFF)) + ui * 256 + rl0;
        f32x4 sv[2][2];
#pragma unroll
        for (int bj = 0; bj < 2; ++bj)
#pragma unroll
            for (int n = 0; n < 2; ++n) sv[bj][n] = *(const LAS f32x4*)((const LAS float*)(lds + opq(SHWT_OFF)) + ui * 256 + wc * 32 + 8 * fq + bj * HALF + 4 * n);
        if (QKT == 0 || u.pn >= QKT) {
#pragma unroll
            for (int ai = 0; ai < 2; ++ai)
#pragma unroll
                for (int m = 0; m < 4; ++m) { if (!((gmask >> (ai * 4 + m)) & 1u)) continue; bf16_t* rowp = O + (size_t)(row0 + ai * HALF + m * 16) * N + col0; const float rs = rt[ai * HALF + m * 16];
#pragma unroll
                    for (int bj = 0; bj < 2; ++bj) { const f32x4 v0 = acc[ai][bj][m][0] * rs + sv[bj][0], v1 = acc[ai][bj][m][1] * rs + sv[bj][1];
                        u32x4 w; w.x = cvt_pk_bf16(v0[0], v0[1]); w.y = cvt_pk_bf16(v0[2], v0[3]); w.z = cvt_pk_bf16(v1[0], v1[1]); w.w = cvt_pk_bf16(v1[2], v1[3]);
                        *(u32x4*)(rowp + bj * HALF) = w; } }
            return;
        }
        LAS float* hs = (LAS float*)(lds + opq(HSQ_OFF));
        if constexpr (RMS) {
#pragma unroll
            for (int ai = 0; ai < 2; ++ai)
#pragma unroll
                for (int m = 0; m < 4; ++m) { const int rl = rl0 + ai * HALF + m * 16; const float rs = rt[ai * HALF + m * 16];
#pragma unroll
                    for (int bj = 0; bj < 2; ++bj) { const f32x4 v0 = acc[ai][bj][m][0] * rs + sv[bj][0], v1 = acc[ai][bj][m][1] * rs + sv[bj][1];
                        float q = ((v0[0] * v0[0] + v0[1] * v0[1]) + (v0[2] * v0[2] + v0[3] * v0[3])) + ((v1[0] * v1[0] + v1[1] * v1[1]) + (v1[2] * v1[2] + v1[3] * v1[3]));
                        q += shx<16>(q); { auto rr = __builtin_amdgcn_permlane32_swap(__float_as_uint(q), __float_as_uint(q), false, false); q = __uint_as_float(rr[0]) + __uint_as_float(rr[1]); }
                        if (fq == 0) hs[rl * 8 + bj * 4 + wc] = q; } }
            asm volatile("s_waitcnt lgkmcnt(0)" ::: "memory"); __builtin_amdgcn_s_barrier(); asm volatile("" ::: "memory");
        }
        const int i16 = 4 * (wc & 1) + fq, hf = wc >> 1;
        f32x4 g0 = {1.f, 1.f, 1.f, 1.f}, g1 = g0;
        if constexpr (RMS) { const float* gg = ((u.pn < 8) ? ap->in[I_AQG] : ap->in[I_AKG]) + (LAYER == 3 ? 128 : 0) + 64 * hf + 4 * i16; g0 = *(const f32x4*)gg; g1 = *(const f32x4*)(gg + 32); }
        const float* tc = (const float*)(w_ + WS_TAB) + 4 * i16; const float* ts = tc + 96 * 32;
#pragma unroll
        for (int ai = 0; ai < 2; ++ai)
#pragma unroll
            for (int m = 0; m < 4; ++m) { if (!((gmask >> (ai * 4 + m)) & 1u)) continue; const int rl = rl0 + ai * HALF + m * 16; const float rs = rt[ai * HALF + m * 16];
                bf16_t* rowp = O + (size_t)(u.pm * BM + rl) * N + col0;
                f32x4 cs = {1.f, 1.f, 1.f, 1.f}, sn = {0.f, 0.f, 0.f, 0.f};
                if (!isctx) { const int tl = (pr_ - 1) * 256 + rl; const int pos = hf ? 32 + (tl & 63) : (tl >> 6); cs = *(const f32x4*)(tc + pos * 32); sn = *(const f32x4*)(ts + pos * 32); }
#pragma unroll
                for (int bj = 0; bj < 2; ++bj) { f32x4 x1 = acc[ai][bj][m][0] * rs + sv[bj][0], x2 = acc[ai][bj][m][1] * rs + sv[bj][1];
                    if constexpr (RMS) { const f32x4 pq = *(const LAS f32x4*)(hs + rl * 8 + bj * 4); const float rh = frsq(((pq[0] + pq[1]) + (pq[2] + pq[3])) * (1.0f / 128.0f) + EPS); x1 = x1 * rh * g0; x2 = x2 * rh * g1; }
                    const f32x4 y1 = x1 * cs - x2 * sn, y2 = x1 * sn + x2 * cs;
                    u32x4 w; w.x = cvt_pk_bf16(y1[0], y1[1]); w.y = cvt_pk_bf16(y1[2], y1[3]); w.z = cvt_pk_bf16(y2[0], y2[1]); w.w = cvt_pk_bf16(y2[2], y2[3]);
                    *(u32x4*)(rowp + bj * HALF) = w; } }
    }
};
template <int LAYER, bool DUP> struct EpiResid {
    unsigned char* ws; CArgsP ap;
    static constexpr bool NEXT = LAYER < 3;
    template <class SchedT> __device__ __forceinline__ void prep(LAS unsigned char*, const SchedT&, int) const {}
    __device__ __forceinline__ void operator()(f32x4 (&acc)[2][2][4][2], const Unit& u, int, LAS unsigned char* lds, int wr, int wc, int tl_, unsigned gmask) const {
        unsigned char* w_ = ws; asm volatile("" : "+v"(tl_), "+s"(w_)); const int lane = tl_ & 63, fr = lane & 15, fq = lane >> 4;
        const int bq = u.pm / 9, pr_ = u.pm - 9 * bq, isctx = pr_ == 0, mr = isctx ? 4 : bq;
        if constexpr (LAYER == 3 && !DUP) {
            const float* gt = (const float*)(w_ + WS_MODS) + (size_t)(LAYER * 5 + mr) * 6144 + 4096;
            const bf16_t* xbin = (const bf16_t*)(w_ + WS_X) + (size_t)u.pm * BM * DM;
            const int rl0 = wr * 64 + fr, col0 = u.pn * BM + wc * 32 + 8 * fq, lrow0 = bq * SEQ + (pr_ - 1) * 256;
            float* fsq = (float*)(w_ + WS_FSQ);
            f32x4 gv[2][2];
#pragma unroll
            for (int bj = 0; bj < 2; ++bj)
#pragma unroll
                for (int n = 0; n < 2; ++n) gv[bj][n] = *(const f32x4*)(gt + col0 + bj * HALF + 4 * n);
#pragma unroll
            for (int ai = 0; ai < 2; ++ai)
#pragma unroll
                for (int m = 0; m < 4; ++m) { const int rl = rl0 + ai * HALF + m * 16; const unsigned ro = (unsigned)(rl * DM + col0) * 4u; float sq = 0.f;
#pragma unroll
                    for (int bj = 0; bj < 2; ++bj) { const u32x4 bw = *(const u32x4*)((const char*)xbin + (ro >> 1) + bj * HALF * 2);
                        const f32x4 bs[2] = {(f32x4){bflo(bw.x), bfhi(bw.x), bflo(bw.y), bfhi(bw.y)}, (f32x4){bflo(bw.z), bfhi(bw.z), bflo(bw.w), bfhi(bw.w)}};
#pragma unroll
                        for (int n = 0; n < 2; ++n) { const f32x4 xn = bs[n] + gv[bj][n] * acc[ai][bj][m][n]; acc[ai][bj][m][n] = xn;
                            sq += (xn[0] * xn[0] + xn[1] * xn[1]) + (xn[2] * xn[2] + xn[3] * xn[3]); } }
                    sq += shx<16>(sq); { auto rr = __builtin_amdgcn_permlane32_swap(__float_as_uint(sq), __float_as_uint(sq), false, false); sq = __uint_as_float(rr[0]) + __uint_as_float(rr[1]); }
                    if (fq == 0) __hip_atomic_store(fsq + (size_t)(lrow0 + rl) * 32 + u.pn * 4 + wc, sq, __ATOMIC_RELAXED, __HIP_MEMORY_SCOPE_AGENT);
                    if (m & 1) asm volatile("" ::: "memory"); }
            asm volatile("s_waitcnt vmcnt(0)" ::: "memory"); __builtin_amdgcn_s_barrier(); asm volatile("" ::: "memory");
            const int tid = (wr * 4 + wc) * 64 + lane; const int panel = bq * 8 + pr_ - 1;
            if (tid == 0) { unsigned* cw = (unsigned*)(w_ + WS_CTL) + CW_SEAM + panel * 16;
                __hip_atomic_fetch_add(cw, 1u, __ATOMIC_RELAXED, __HIP_MEMORY_SCOPE_AGENT);
                unsigned sp = 0; while (__hip_atomic_load(cw, __ATOMIC_RELAXED, __HIP_MEMORY_SCOPE_AGENT) < 8u) { __builtin_amdgcn_s_sleep(1); if (++sp > (1u << 22)) break; }
                __builtin_amdgcn_fence(__ATOMIC_ACQUIRE, "agent"); asm volatile("s_waitcnt vmcnt(0)" ::: "memory"); }
            asm volatile("" ::: "memory"); __builtin_amdgcn_s_barrier(); asm volatile("" ::: "memory");
            LAS float* rt = (LAS float*)(lds + opq(HSQ_OFF));
            if (tid < 256) { const f32x4* p4 = (const f32x4*)(fsq + (size_t)(lrow0 + tid) * 32); float sa = 0.f;
#pragma unroll
                for (int j = 0; j < 8; ++j) { const f32x4 v = p4[j]; sa += (v.x + v.y) + (v.z + v.w); }
                rt[tid] = frsq(sa * (1.0f / DM) + EPS); }
            asm volatile("s_waitcnt lgkmcnt(0)" ::: "memory"); __builtin_amdgcn_s_barrier(); asm volatile("" ::: "memory");
            const float* nf = ap->in[I_NORMF] + col0; float* outp = ap->out + (size_t)lrow0 * DM;
#pragma unroll
            for (int bj = 0; bj < 2; ++bj)
#pragma unroll
                for (int n = 0; n < 2; ++n) gv[bj][n] = *(const f32x4*)(nf + bj * HALF + 4 * n);
#pragma unroll
            for (int ai = 0; ai < 2; ++ai)
#pragma unroll
                for (int m = 0; m < 4; ++m) { const int rl = rl0 + ai * HALF + m * 16; const float rs = rt[rl]; const unsigned ro = (unsigned)(rl * DM + col0) * 4u;
#pragma unroll
                    for (int bj = 0; bj < 2; ++bj)
#pragma unroll
                        for (int n = 0; n < 2; ++n) *(f32x4*)((char*)outp + ro + (bj * HALF + 4 * n) * 4) = acc[ai][bj][m][n] * rs * gv[bj][n]; }
            return;
        }
        const float* gt = (const float*)(w_ + WS_MODS) + (size_t)(LAYER * 5 + mr) * 6144 + 4096;
        const float* gmN = (const float*)(w_ + WS_GM) + (size_t)((LAYER + 1) * 5 + mr) * DM;
        const float* basep = (LAYER == 0) ? (isctx ? ap->in[I_CTX] + (size_t)(bq * CTXL) * DM : ap->in[I_X] + (size_t)(bq * SEQ + (pr_ - 1) * 256) * DM) : nullptr;
        const bf16_t* xbin = (const bf16_t*)(w_ + WS_X) + (size_t)u.pm * BM * DM;
        bf16_t* outp = (bf16_t*)(w_ + (DUP ? WS_DUMMY : WS_X)) + (size_t)u.pm * BM * DM; bf16_t* hp = (bf16_t*)(w_ + (DUP ? WS_DUMMY + 72 * MiB : WS_H)) + (size_t)u.pm * BM * DM;
        float* ssq = (float*)(w_ + (DUP ? WS_DUMMY + 108 * MiB : WS_SSQ));
        const int rl0 = wr * 64 + fr, col0 = u.pn * BM + wc * 32 + 8 * fq;
        f32x4 gv[2][2], mv[2][2];
#pragma unroll
        for (int bj = 0; bj < 2; ++bj)
#pragma unroll
            for (int n = 0; n < 2; ++n) { gv[bj][n] = *(const f32x4*)(gt + col0 + bj * HALF + 4 * n); if (NEXT) mv[bj][n] = *(const f32x4*)(gmN + col0 + bj * HALF + 4 * n); }
#pragma unroll
        for (int ai = 0; ai < 2; ++ai)
#pragma unroll
            for (int m = 0; m < 4; ++m) { if (!((gmask >> (ai * 4 + m)) & 1u)) continue; const int rl = rl0 + ai * HALF + m * 16; const unsigned ro = (unsigned)(rl * DM + col0) * 4u; float sq = 0.f;
#pragma unroll
                for (int bj = 0; bj < 2; ++bj) { f32x4 xn[2], bs[2];
                    if constexpr (LAYER == 0) { bs[0] = *(const f32x4*)((const char*)basep + ro + bj * HALF * 4); bs[1] = *(const f32x4*)((const char*)basep + ro + bj * HALF * 4 + 16); }
                    else { const u32x4 bw = *(const u32x4*)((const char*)xbin + (ro >> 1) + bj * HALF * 2); bs[0] = (f32x4){bflo(bw.x), bfhi(bw.x), bflo(bw.y), bfhi(bw.y)}; bs[1] = (f32x4){bflo(bw.z), bfhi(bw.z), bflo(bw.w), bfhi(bw.w)}; }
#pragma unroll
                    for (int n = 0; n < 2; ++n) { xn[n] = bs[n] + gv[bj][n] * acc[ai][bj][m][n];
                        if (NEXT) sq += (xn[n][0] * xn[n][0] + xn[n][1] * xn[n][1]) + (xn[n][2] * xn[n][2] + xn[n][3] * xn[n][3]); }
                    { u32x4 xw; xw.x = cvt_pk_bf16(xn[0][0], xn[0][1]); xw.y = cvt_pk_bf16(xn[0][2], xn[0][3]); xw.z = cvt_pk_bf16(xn[1][0], xn[1][1]); xw.w = cvt_pk_bf16(xn[1][2], xn[1][3]);
                        *(u32x4*)((char*)outp + (ro >> 1) + bj * HALF * 2) = xw; }
                    if (NEXT) { const f32x4 h0 = xn[0] * mv[bj][0], h1 = xn[1] * mv[bj][1]; u32x4 w; w.x = cvt_pk_bf16(h0[0], h0[1]); w.y = cvt_pk_bf16(h0[2], h0[3]); w.z = cvt_pk_bf16(h1[0], h1[1]); w.w = cvt_pk_bf16(h1[2], h1[3]);
                        *(u32x4*)((char*)hp + (ro >> 1) + bj * HALF * 2) = w; } }
                if (NEXT) { sq += shx<16>(sq); { auto rr = __builtin_amdgcn_permlane32_swap(__float_as_uint(sq), __float_as_uint(sq), false, false); sq = __uint_as_float(rr[0]) + __uint_as_float(rr[1]); }
                    if (fq == 0) ssq[(size_t)(u.pm * BM + rl) * 32 + u.pn * 4 + wc] = sq; }
                if (m & 1) asm volatile("" ::: "memory"); }
    }
};
template <int CTRL> __device__ __forceinline__ float dpp_f(float oldv, float src) { return __int_as_float(__builtin_amdgcn_update_dpp(__float_as_int(oldv), __float_as_int(src), CTRL, 0xf, 0xf, false)); }
struct EpiGates {
    unsigned char* ws; CArgsP ap;
    template <class SchedT> __device__ __forceinline__ void prep(LAS unsigned char*, const SchedT&, int) const {}
    __device__ __forceinline__ void operator()(f32x4 (&acc)[2][2][4][2], const Unit& u, int, LAS unsigned char*, int wr, int wc, int tl_, unsigned gmask) const {
        unsigned char* w_ = ws; asm volatile("" : "+v"(tl_), "+s"(w_)); const int lane = tl_ & 63, fr = lane & 15, fq = lane >> 4;
        const bf16_t* UP = (const bf16_t*)(w_ + WS_UP); const float* ba = ap->in[I_RBA]; const float* bx = ap->in[I_RBX]; const float* c8 = (const float*)(w_ + WS_TAB + 65536);
        unsigned* AB = (unsigned*)(w_ + WS_SA); float* AGA = (float*)(w_ + WS_AG16); float* AGB = AGA + (size_t)576 * 2 * DM;
        const int nblk = u.pn >> 2, dir = (u.pn >> 1) & 1, jt = u.pn & 1;
        const int row0 = u.pm * BM + wr * 64 + fr, chb = nblk * 256 + jt * 128 + 16 * wc + 4 * fq;
#pragma unroll
        for (int bj = 0; bj < 2; ++bj) { if (u.kind != 0 && u.kind - 1 != bj) continue; const int ch = chb + 64 * bj;
            const f32x4 bav = *(const f32x4*)(ba + dir * DM + ch), bxv = *(const f32x4*)(bx + dir * DM + ch), cv = *(const f32x4*)(c8 + dir * DM + ch);
#pragma unroll
            for (int ai = 0; ai < 2; ++ai)
#pragma unroll
                for (int m = 0; m < 4; ++m) { if (!((gmask >> (ai * 4 + m)) & 1u)) continue; const int row = row0 + ai * HALF + m * 16;
                    const u32x2 upw = *(const u32x2*)((const char*)UP + (unsigned)(row * DM + ch) * 2u);
                    const float up[4] = {bflo(upw.x), bfhi(upw.x), bflo(upw.y), bfhi(upw.y)};
                    const f32x4 pr = acc[ai][bj][m][0] + bav, pi = acc[ai][bj][m][1] + bxv; u32x4 w; f32x4 A, Bv;
#pragma unroll
                    for (int j = 0; j < 4; ++j) { const float r = sigmoidf_(pr[j]), ig = sigmoidf_(pi[j]); const float la = -r * cv[j]; const float a = __expf(la);
                        const float om = fmaf(-a, a, 1.0f);
                        w[j] = cvt_pk_bf16(la, fsqrt_(om) * (ig * up[j]));
                        A[j] = __expf(bflo(w[j])); Bv[j] = bfhi(w[j]); }
                    *(u32x4*)((char*)AB + (unsigned)((row * 2 + dir) * DM + ch) * 4u) = w;
#define GSTEP(CT) asm volatile("s_nop 1\n\tv_fmac_f32_dpp %0, %0, %4 " CT " row_mask:0xf bank_mask:0xf\n\tv_fmac_f32_dpp %1, %1, %5 " CT " row_mask:0xf bank_mask:0xf\n\tv_fmac_f32_dpp %2, %2, %6 " CT " row_mask:0xf bank_mask:0xf\n\tv_fmac_f32_dpp %3, %3, %7 " CT " row_mask:0xf bank_mask:0xf\n\t" \
                                   "v_mul_f32_dpp %4, %4, %4 " CT " row_mask:0xf bank_mask:0xf\n\tv_mul_f32_dpp %5, %5, %5 " CT " row_mask:0xf bank_mask:0xf\n\tv_mul_f32_dpp %6, %6, %6 " CT " row_mask:0xf bank_mask:0xf\n\tv_mul_f32_dpp %7, %7, %7 " CT " row_mask:0xf bank_mask:0xf" \
                                   : "+v"(Bv[0]), "+v"(Bv[1]), "+v"(Bv[2]), "+v"(Bv[3]), "+v"(A[0]), "+v"(A[1]), "+v"(A[2]), "+v"(A[3]));
                    if (dir == 0) { GSTEP("row_shr:1") GSTEP("row_shr:2") GSTEP("row_shr:4") GSTEP("row_shr:8") } else { GSTEP("row_shl:1") GSTEP("row_shl:2") GSTEP("row_shl:4") GSTEP("row_shl:8") }
#undef GSTEP
                    if (fr == (dir ? 0 : 15)) { const unsigned ao = (unsigned)((((u.pm * 16 + ai * 8 + wr * 4 + m) * 2 + dir) * DM + ch) * 4u); *(f32x4*)((char*)AGA + ao) = A; *(f32x4*)((char*)AGB + ao) = Bv; }
                    asm volatile("" ::: "memory"); __builtin_amdgcn_sched_barrier(0); } }
    }
};

struct NoEpi { unsigned char* ws; template <class SchedT> __device__ __forceinline__ void prep(LAS unsigned char*, const SchedT&, int) const {}
    __device__ __forceinline__ void operator()(f32x4 (&)[2][2][4][2], const Unit&, int, LAS unsigned char*, int, int, int, unsigned) const {} };
template <class Epi, class SchedT, int KT, int BANK, size_t OA, size_t OB, class Epi0 = NoEpi, size_t OA0 = 0, size_t OB0 = 0>
__device__ __forceinline__ void gemm_phase(LAS unsigned char* lds, const int tid, const SchedT& S, const Epi& E, const Epi0& E0 = Epi0{}) {
    constexpr bool MERGED = !__is_same(Epi0, NoEpi);
    constexpr bool SP2 = true, ALIGN_EPI = true;
    const int wid = __builtin_amdgcn_readfirstlane(tid >> 6), lane = tid & 63, wr = wid >> 2, wc = wid & 3, fr = lane & 15, fq = lane >> 4;
    constexpr int K = KT * BK, lda = DM;
    unsigned voffA[2], voffB[2];
#pragma unroll
    for (int i = 0; i < 2; ++i) { int R, C; stage_rc(tid * 16 + i * 8192, R, C); const int Rb = (R & ~31) + perm32(R & 31);
        voffA[i] = (unsigned)(R * lda + C) * 2u; voffB[i] = (unsigned)(Rb * K + C) * 2u; }
    constexpr unsigned kstep = (unsigned)(BK * 2);
    constexpr unsigned hstepA = (unsigned)HALF * lda * 2, hstepB = (unsigned)HALF * K * 2;
    constexpr unsigned tstepA = 2 * hstepA, tstepB = 2 * hstepB;
    const unsigned ldsw = (unsigned)wid * 1024u;
    const int aoff = lds_byte(wr * 64 + fr, fq * 8), boff = lds_byte(wc * 32 + fr, fq * 8);
#define PG8_SA(b, h) (((b) * 2 + (h)) * HTB)
#define PG8_SB(b, h) ((4 + (b) * 2 + (h)) * HTB)
#define PG8_STAGE(bufoff, goff, voff) do { _Pragma("unroll") for (int _i = 0; _i < 2; ++_i) \
        __builtin_amdgcn_global_load_lds((const unsigned*)((const char*)E.ws + (unsigned)((goff) + (voff)[_i])), (LAS unsigned*)(lds + (bufoff) + ldsw + _i * 8192), 16, 0, 0); } while (0)
#define PG8_LDA(dst, b, h) do { _Pragma("unroll") for (int m = 0; m < 4; ++m) _Pragma("unroll") for (int k = 0; k < 2; ++k) dst[m][k] = *(const LAS bf16x8*)(lds + PG8_SA(b, h) + aoff + m * 2048 + k * 1024); } while (0)
#define PG8_LDB(dst, b, h) do { _Pragma("unroll") for (int n = 0; n < 2; ++n) _Pragma("unroll") for (int k = 0; k < 2; ++k) dst[n][k] = *(const LAS bf16x8*)(lds + PG8_SB(b, h) + boff + n * 2048 + k * 1024); } while (0)
#define PG8_MMA(ai, bj, At, Bt) do { __builtin_amdgcn_s_setprio(1); _Pragma("unroll") for (int m = 0; m < 4; ++m) _Pragma("unroll") for (int n = 0; n < 2; ++n) _Pragma("unroll") for (int k = 0; k < 2; ++k) \
        acc[ai][bj][m][n] = __builtin_amdgcn_mfma_f32_16x16x32_bf16(Bt[n][k], At[m][k], acc[ai][bj][m][n], 0, 0, 0); __builtin_amdgcn_s_setprio(0); } while (0)
#define PG8_WAIT_V(n) asm volatile("s_waitcnt vmcnt(" #n ")" ::: "memory")
#define PG8_WAIT_L(n) asm volatile("s_waitcnt lgkmcnt(" #n ")" ::: "memory")
#define PG8_BAR __builtin_amdgcn_s_barrier()
#define PG8_SCHED __builtin_amdgcn_sched_barrier(0)
    Unit cur, nxt; int ui = 0;
    if (!S.next(0, cur)) return;
    E.prep(lds, S, tid); __syncthreads();
    f32x4 acc[2][2][4][2];
#pragma unroll
    for (int a = 0; a < 2; ++a)
#pragma unroll
        for (int b = 0; b < 2; ++b)
#pragma unroll
            for (int m = 0; m < 4; ++m)
#pragma unroll
                for (int n = 0; n < 2; ++n) acc[a][b][m][n] = (f32x4){0.f, 0.f, 0.f, 0.f};
    bf16x8 At[4][2], B0[2][2], B1[2][2];
#define PG8_UA(u) ((unsigned)((MERGED && (u).kind == 0) ? OA0 : OA) + (unsigned)(u).pm * tstepA + (unsigned)((u).acol + (u).kofs) * 2u)
#define PG8_UB(u) ((unsigned)((MERGED && (u).kind == 0) ? OB0 : OB) + (unsigned)(u).pn * tstepB + (unsigned)(u).kofs * 2u)
    unsigned cA = PG8_UA(cur), cB = PG8_UB(cur);
    {
        PG8_STAGE(PG8_SB(0, 0), cB, voffB); PG8_STAGE(PG8_SB(0, 1), cB + hstepB, voffB); PG8_STAGE(PG8_SA(0, 0), cA, voffA); PG8_STAGE(PG8_SA(0, 1), cA + hstepA, voffA);
        if (wr == 1) PG8_BAR;
        PG8_WAIT_V(2); PG8_BAR;
        PG8_STAGE(PG8_SB(1, 0), cB + kstep, voffB); PG8_STAGE(PG8_SA(1, 0), cA + kstep, voffA); PG8_STAGE(PG8_SB(1, 1), cB + hstepB + kstep, voffB);
        PG8_WAIT_V(6); PG8_BAR;
    }
    for (;;) {
        const bool has_next = S.next(ui + 1, nxt);
        const unsigned nA = has_next ? PG8_UA(nxt) : cA, nB = has_next ? PG8_UB(nxt) : cB;
        const int nt = cur.nt;
        for (int t = 0; t < nt; t += 2) {
            const bool last = (t == nt - 2);
            if constexpr (MERGED) if (last && has_next && nxt.kind == 2) {
                unsigned char* w0_ = E.ws; asm volatile("" : "+s"(w0_));
                if (wid == 0) { unsigned* cw = (unsigned*)(w0_ + WS_CTL) + CW_SEAM + 1024 + BANK * 64 + (nxt.pm / 9) * 16; unsigned sp_ = 0;
                    while ((unsigned)__builtin_amdgcn_readfirstlane((int)__hip_atomic_load(cw, __ATOMIC_RELAXED, __HIP_MEMORY_SCOPE_AGENT)) < 8u) { __builtin_amdgcn_s_sleep(2); if (++sp_ > (1u << 22)) break; }
                    __builtin_amdgcn_fence(__ATOMIC_ACQUIRE, "agent"); asm volatile("s_waitcnt vmcnt(0)" ::: "memory"); }
                asm volatile("" ::: "memory"); PG8_BAR; asm volatile("" ::: "memory");
                if (tid < 256) { const f32x4* p4 = (const f32x4*)((const float*)(w0_ + WS_SSQ) + (size_t)(nxt.pm * BM + tid) * 32); float s_ = 0.f;
#pragma unroll
                    for (int j = 0; j < 8; ++j) { const f32x4 v_ = p4[j]; s_ += (v_.x + v_.y) + (v_.z + v_.w); }
                    ((LAS float*)(lds + opq(RSTD_OFF)))[(ui + 1) * 256 + tid] = frsq(s_ * (1.0f / DM) + EPS); }
            }
            const unsigned a1 = cA + (unsigned)(t + 1) * kstep;
            const unsigned a2 = last ? nA : cA + (unsigned)(t + 2) * kstep, b2 = last ? nB : cB + (unsigned)(t + 2) * kstep;
            const unsigned a3 = a2 + kstep, b3 = b2 + kstep;
            PG8_LDB(B0, 0, 0); PG8_LDB(B1, 0, 1); PG8_SCHED; PG8_LDA(At, 0, 0); PG8_STAGE(PG8_SA(1, 1), a1 + hstepA, voffA);
            PG8_WAIT_V(8); PG8_WAIT_L(0); PG8_BAR; PG8_MMA(0, 0, At, B0); PG8_MMA(0, 1, At, B1); PG8_BAR; PG8_SCHED;
            PG8_LDA(At, 0, 1); PG8_STAGE(PG8_SB(0, 0), b2, voffB); PG8_STAGE(PG8_SB(0, 1), b2 + hstepB, voffB); PG8_STAGE(PG8_SA(0, 0), a2, voffA);
            PG8_WAIT_V(8); PG8_WAIT_L(0); PG8_BAR; PG8_MMA(1, 0, At, B0); PG8_MMA(1, 1, At, B1); PG8_BAR; PG8_SCHED;
            PG8_LDB(B0, 1, 0); PG8_LDB(B1, 1, 1); PG8_SCHED; PG8_LDA(At, 1, 0); PG8_STAGE(PG8_SA(0, 1), a2 + hstepA, voffA);
            PG8_WAIT_V(8); PG8_WAIT_L(0); PG8_BAR; PG8_MMA(0, 0, At, B0); PG8_MMA(0, 1, At, B1); PG8_BAR; PG8_SCHED;
            PG8_LDA(At, 1, 1); PG8_STAGE(PG8_SB(1, 0), b3, voffB); PG8_STAGE(PG8_SB(1, 1), b3 + hstepB, voffB); PG8_STAGE(PG8_SA(1, 0), a3, voffA);
            PG8_WAIT_V(8); PG8_WAIT_L(0); PG8_BAR; PG8_MMA(1, 0, At, B0); PG8_MMA(1, 1, At, B1); PG8_BAR; PG8_SCHED;
        }
        if constexpr (ALIGN_EPI) { if (wr == 0) PG8_BAR; }
        if (MERGED && cur.kind == 0) {
            E0(acc, cur, ui, lds, wr, wc, tid, 0xffu);
            asm volatile("s_waitcnt vmcnt(0)" ::: "memory"); PG8_BAR; asm volatile("" ::: "memory");
            if (tid == 0) { unsigned char* w0_ = E.ws; asm volatile("" : "+s"(w0_)); unsigned* cw = (unsigned*)(w0_ + WS_CTL) + CW_SEAM + 1024 + BANK * 64 + (cur.pm / 9) * 16;
                __builtin_amdgcn_fence(__ATOMIC_RELEASE, "agent"); asm volatile("s_waitcnt vmcnt(0)" ::: "memory");
                __hip_atomic_fetch_add(cw, 1u, __ATOMIC_RELAXED, __HIP_MEMORY_SCOPE_AGENT); }
        } else
        if (!S.is_slice(ui)) E(acc, cur, ui, lds, wr, wc, tid, 0xffu);
        if (!has_next) break;
#pragma unroll
        for (int a = 0; a < 2; ++a)
#pragma unroll
            for (int b = 0; b < 2; ++b)
#pragma unroll
                for (int m = 0; m < 4; ++m)
#pragma unroll
                    for (int n = 0; n < 2; ++n) acc[a][b][m][n] = (f32x4){0.f, 0.f, 0.f, 0.f};
        cur = nxt; cA = nA; cB = nB; ++ui;
        if constexpr (ALIGN_EPI) { if (wr == 1) PG8_BAR; }
    }
    PG8_WAIT_V(0);
    if constexpr (!ALIGN_EPI) { if (wr == 0) PG8_BAR; }
    PG8_BAR;
    if constexpr (SchedT::F > 1) if (S.is_slice(ui)) {
        unsigned char* w_ = E.ws; asm volatile("" : "+s"(w_)); float* slab = (float*)(w_ + WS_SLAB); unsigned* cnt = (unsigned*)(w_ + WS_CTL) + CW_SEAM + BANK * 4096;
        constexpr int F = SchedT::F; const int tt = S.v / F, sj = S.v - tt * F; float* my = slab + ((size_t)(tt * F + sj) * 32) * 2048;
#pragma unroll
        for (int a = 0; a < 2; ++a)
#pragma unroll
            for (int b = 0; b < 2; ++b)
#pragma unroll
                for (int m = 0; m < 4; ++m)
#pragma unroll
                    for (int n = 0; n < 2; ++n) { float* sp_ = my + (size_t)((((a * 2 + b) * 4 + m) * 2 + n) * 512 + tid) * 4;
                        asm volatile("global_store_dwordx4 %0, %1, off sc1\n\ts_nop 1" :: "v"(sp_), "v"(acc[a][b][m][n]) : "memory"); }
        asm volatile("s_waitcnt vmcnt(0)" ::: "memory"); __syncthreads();
        if (tid == 0) { unsigned* cw = cnt + tt * 16;
            __hip_atomic_fetch_add(cw, 1u, __ATOMIC_RELAXED, __HIP_MEMORY_SCOPE_AGENT);
            unsigned sp = 0; while (__hip_atomic_load(cw, __ATOMIC_RELAXED, __HIP_MEMORY_SCOPE_AGENT) < (unsigned)F) { __builtin_amdgcn_s_sleep(1); if (++sp > (1u << 22)) break; }
            __builtin_amdgcn_fence(__ATOMIC_ACQUIRE, "agent"); asm volatile("s_waitcnt vmcnt(0)" ::: "memory"); }
        __syncthreads();
        constexpr int per = 8 / F; const unsigned gmask = ((1u << per) - 1u) << (sj * per);
        const float* t0 = slab + ((size_t)(tt * F) * 32) * 2048;
#pragma unroll
        for (int a = 0; a < 2; ++a)
#pragma unroll
            for (int m = 0; m < 4; ++m) if ((gmask >> (a * 4 + m)) & 1u) {
#pragma unroll
                for (int b = 0; b < 2; ++b)
#pragma unroll
                    for (int n = 0; n < 2; ++n) { const float* fp = t0 + (size_t)((((a * 2 + b) * 4 + m) * 2 + n) * 512 + tid) * 4; f32x4 sm = *(const f32x4*)fp;
#pragma unroll
                        for (int sl = 1; sl < F; ++sl) sm += *(const f32x4*)(fp + (size_t)sl * 32 * 2048);
                        acc[a][b][m][n] = sm; } }
        E(acc, cur, ui, lds, wr, wc, tid, gmask);
        asm volatile("s_waitcnt vmcnt(0)" ::: "memory"); __syncthreads();
    }
#undef PG8_UA
#undef PG8_UB
#undef PG8_SA
#undef PG8_SB
#undef PG8_STAGE
#undef PG8_LDA
#undef PG8_LDB
#undef PG8_MMA
#undef PG8_WAIT_V
#undef PG8_WAIT_L
#undef PG8_BAR
#undef PG8_SCHED
}
}

namespace att {
constexpr int D = 128, NW = 8, QBLK = 32, KVBLK = 64;
constexpr float SCALE = 0.088388347648318440f;
constexpr float THR = 8.f;
constexpr int SHM_V = KVBLK * D * 2, SHM_K = KVBLK * D * 2, SHM_ATTN = 3 * SHM_V + 3 * SHM_K + NW * 64 * 4;
#define KSWZ(row, colB) ((row) * 256 + ((colB) ^ (((row) & 7) << 4)))
#define SBAR() __builtin_amdgcn_sched_barrier(0)
__device__ __forceinline__ int crow(int r, int hi) { return (r & 3) + 8 * (r >> 2) + 4 * hi; }
__device__ __forceinline__ unsigned cvtpk(float lo, float hi) { unsigned r; asm volatile("v_cvt_pk_bf16_f32 %0, %1, %2" : "=v"(r) : "v"(lo), "v"(hi)); return r; }
__device__ __forceinline__ bf16x8 ld8(const bf16_t* p) { return *reinterpret_cast<const bf16x8*>(p); }

__device__ __forceinline__ void partialSM(f32x16& p0, f32x16& p1, float& m_reg, float& mn, float& alpha) {
  constexpr float C = SCALE * 1.4426950408889634f;
  float pmax = p0[0]; for (int r = 1; r < 16; ++r) pmax = fmaxf(pmax, p0[r]); for (int r = 0; r < 16; ++r) pmax = fmaxf(pmax, p1[r]);
  { auto rr = __builtin_amdgcn_permlane32_swap(__float_as_uint(pmax), __float_as_uint(pmax), false, false);
    pmax = fmaxf(__uint_as_float(rr[0]), __uint_as_float(rr[1])); }
  if (__builtin_expect(__all(pmax - m_reg <= THR / SCALE), 1)) { mn = m_reg; alpha = 1.f; }
  else { mn = fmaxf(m_reg, pmax); alpha = __builtin_amdgcn_exp2f((m_reg - mn) * C); m_reg = mn; }
  float mnC = -mn * C;
  for (int r = 0; r < 16; ++r) p0[r] = fmaf(p0[r], C, mnC); for (int r = 0; r < 16; ++r) p1[r] = fmaf(p1[r], C, mnC);
  for (int r = 0; r < 16; ++r) p0[r] = __builtin_amdgcn_exp2f(p0[r]);
}
__device__ __forceinline__ void finishSM(f32x16& p0, f32x16& p1, float alpha, float& l_reg, bf16x8& pa0, bf16x8& pa1, bf16x8& pa2, bf16x8& pa3) {
  for (int r = 0; r < 16; ++r) p1[r] = __builtin_amdgcn_exp2f(p1[r]);
  float ps = 0; for (int r = 0; r < 16; ++r) ps += p0[r]; for (int r = 0; r < 16; ++r) ps += p1[r];
  { auto rr = __builtin_amdgcn_permlane32_swap(__float_as_uint(ps), __float_as_uint(ps), false, false);
    ps = __uint_as_float(rr[0]) + __uint_as_float(rr[1]); }
  l_reg = l_reg * alpha + ps;
#define PK4(P, BASE, OUT) do { unsigned a0 = cvtpk(P[BASE + 0], P[BASE + 1]), a1 = cvtpk(P[BASE + 2], P[BASE + 3]);   \
    unsigned b0 = cvtpk(P[BASE + 4], P[BASE + 5]), b1 = cvtpk(P[BASE + 6], P[BASE + 7]);                              \
    auto r0 = __builtin_amdgcn_permlane32_swap(a0, b0, false, false); auto r1 = __builtin_amdgcn_permlane32_swap(a1, b1, false, false); \
    u32x4 w = {r0[0], r1[0], r0[1], r1[1]}; OUT = *reinterpret_cast<bf16x8*>(&w); } while (0)
  PK4(p0, 0, pa0); PK4(p0, 8, pa1); PK4(p1, 0, pa2); PK4(p1, 8, pa3);
#undef PK4
}
__device__ __forceinline__ void qkt(f32x16& p0, f32x16& p1, const bf16_t* Ks, const bf16x8* qr, int r32, int hi) {
  p0 = f32x16{}; p1 = f32x16{};
  for (int d0 = 0; d0 < 8; ++d0) { int cb = (d0 * 16 + hi * 8) * 2;
    bf16x8 b0 = *reinterpret_cast<const bf16x8*>((const char*)Ks + KSWZ(r32, cb));
    bf16x8 b1 = *reinterpret_cast<const bf16x8*>((const char*)Ks + KSWZ(32 + r32, cb));
    p0 = __builtin_amdgcn_mfma_f32_32x32x16_bf16(b0, qr[d0], p0, 0, 0, 0);
    p1 = __builtin_amdgcn_mfma_f32_32x32x16_bf16(b1, qr[d0], p1, 0, 0, 0); }
}
__device__ __forceinline__ int v_st(int k, int c) { const int kk = (k & ~0xC) | ((k & 4) << 1) | ((k & 8) >> 1); return ((kk >> 3) * 4 + (c >> 5)) * 512 + ((kk & 7) * 32 + (c & 31)) * 2; }
__device__ __forceinline__ int v_rd_base(int lane) { return ((lane & 3) << 3) | (((lane >> 2) & 3) << 6) | (((lane >> 4) & 1) << 5) | (((lane >> 5) & 1) << 8); }
constexpr int v_rd_off(int d0, int ks, int half) { return d0 * 512 + ks * 4096 + half * 2048; }
template <int OFF> __device__ __forceinline__ s16x4 tr_read(int vb) {
  s16x4 r; asm volatile("ds_read_b64_tr_b16 %0, %1 offset:%2" : "=&v"(r) : "v"(vb), "i"(OFF) : "memory"); return r;
}
template <int D0> __device__ __forceinline__ void pv_one(f32x16& od, int vb, bf16x8 pa0, bf16x8 pa1, bf16x8 pa2, bf16x8 pa3) {
  const s16x4 l0 = tr_read<v_rd_off(D0, 0, 0)>(vb), h0 = tr_read<v_rd_off(D0, 0, 1)>(vb), l1 = tr_read<v_rd_off(D0, 1, 0)>(vb), h1 = tr_read<v_rd_off(D0, 1, 1)>(vb);
  const s16x4 l2 = tr_read<v_rd_off(D0, 2, 0)>(vb), h2 = tr_read<v_rd_off(D0, 2, 1)>(vb), l3 = tr_read<v_rd_off(D0, 3, 0)>(vb), h3 = tr_read<v_rd_off(D0, 3, 1)>(vb);
  asm volatile("s_waitcnt lgkmcnt(0)" ::: "memory"); SBAR();
#define PK(L, H) (bf16x8){L[0], L[1], L[2], L[3], H[0], H[1], H[2], H[3]}
  od = __builtin_amdgcn_mfma_f32_32x32x16_bf16(pa0, PK(l0, h0), od, 0, 0, 0);
  od = __builtin_amdgcn_mfma_f32_32x32x16_bf16(pa1, PK(l1, h1), od, 0, 0, 0);
  od = __builtin_amdgcn_mfma_f32_32x32x16_bf16(pa2, PK(l2, h2), od, 0, 0, 0);
  od = __builtin_amdgcn_mfma_f32_32x32x16_bf16(pa3, PK(l3, h3), od, 0, 0, 0);
#undef PK
}
__device__ __forceinline__ void pv_d0(f32x16* o, int vb, bf16x8 pa0, bf16x8 pa1, bf16x8 pa2, bf16x8 pa3) {
  pv_one<0>(o[0], vb, pa0, pa1, pa2, pa3); pv_one<1>(o[1], vb, pa0, pa1, pa2, pa3); pv_one<2>(o[2], vb, pa0, pa1, pa2, pa3); pv_one<3>(o[3], vb, pa0, pa1, pa2, pa3);
}
template <int LD, int ldo, bool GATED>
__device__ __forceinline__ void attn_unit(const bf16_t* __restrict__ Qb, const bf16_t* __restrict__ Kh, const bf16_t* __restrict__ Vh,
                                          bf16_t* __restrict__ Ob, const bf16_t* __restrict__ Zb, int seq, char* lds, const int tid) {
  constexpr int SDEPTH = 2;
  const int wid = tid >> 6, lane = tid & 63, r32 = lane & 31, hi = lane >> 5;
  char* V_lds = lds; char* K_lds = lds + 3 * SHM_V;
  float* ws = (float*)(lds + 3 * SHM_V + 3 * SHM_K) + wid * 64; float* li_l = ws; float* al_l = ws + 32;
  float m_reg = -1e30f, l_reg = 0; f32x16 o[4] = {}; bf16x8 qr[8];
  { const unsigned qoff = (unsigned)((wid * QBLK + r32) * LD + hi * 8) * 2u;
#pragma unroll
    for (int d0 = 0; d0 < 8; ++d0) qr[d0] = *(const bf16x8*)((const char*)Qb + qoff + d0 * 32); }
  const int sr = tid >> 4, sc = (tid & 15) * 8, vst0 = v_st(sr, sc), vst1 = v_st(32 + sr, sc);
  const int vb0 = (int)(uintptr_t)V_lds + v_rd_base(lane);
  struct { bf16x8 vs0, vs1, ks0, ks1; } sr_[SDEPTH];
  const unsigned soff0 = (unsigned)(sr * LD + sc) * 2u, soff1 = (unsigned)((32 + sr) * LD + sc) * 2u;
#define SLOAD(i, k0) do { const char* vt_ = (const char*)Vh + (size_t)(k0) * (LD * 2); const char* kt_ = (const char*)Kh + (size_t)(k0) * (LD * 2); \
    sr_[i].vs0 = *(const bf16x8*)(vt_ + soff0); sr_[i].vs1 = *(const bf16x8*)(vt_ + soff1); sr_[i].ks0 = *(const bf16x8*)(kt_ + soff0); sr_[i].ks1 = *(const bf16x8*)(kt_ + soff1); } while (0)
#define SWRITE(so, i) do { *(bf16x8*)(V_lds + (so) + vst0) = sr_[i].vs0;          \
    *(bf16x8*)(V_lds + (so) + vst1) = sr_[i].vs1; int kc = sc * 2;               \
    *(bf16x8*)(K_lds + (so) + KSWZ(sr, kc)) = sr_[i].ks0;                       \
    *(bf16x8*)(K_lds + (so) + KSWZ(32 + sr, kc)) = sr_[i].ks1; } while (0)
#define SWAIT() do { asm volatile("s_waitcnt vmcnt(4)" ::: "memory"); } while (0)
#define RESC(a) do { if (__any((a) < 1.f)) { if (hi == 0) al_l[r32] = (a); asm volatile("s_waitcnt lgkmcnt(0)" ::: "memory"); \
    for (int d = 0; d < 4; ++d) for (int r = 0; r < 16; ++r) o[d][r] *= al_l[crow(r, hi)]; } } while (0)
#define ROT() do { const int t_ = sp; sp = sc_; sc_ = sn; sn = t_; } while (0)
  f32x16 pA0, pA1, pB0, pB1; float mnA, mnB, alA, alB; bf16x8 pa0, pa1, pa2, pa3; const int NT = seq / KVBLK;
  constexpr int SE = 0, SO = SDEPTH - 1;
  int sp = 0, sc_ = SHM_V, sn = 2 * SHM_V;
  SLOAD(SE, 0); asm volatile("s_waitcnt vmcnt(0)" ::: "memory"); SWRITE(0, SE); __syncthreads();
  qkt(pA0, pA1, (const bf16_t*)K_lds, qr, r32, hi); partialSM(pA0, pA1, m_reg, mnA, alA);
  SLOAD(SO, KVBLK); if (2 < NT) SLOAD(SE, 2 * KVBLK);
  SWAIT(); SWRITE(SHM_V, SO);
  for (int j = 1; j + 1 < NT; j += 2) {
    __syncthreads();
    SBAR(); qkt(pB0, pB1, (const bf16_t*)(K_lds + sc_), qr, r32, hi);
    finishSM(pA0, pA1, alA, l_reg, pa0, pa1, pa2, pa3); SBAR();
    SLOAD(SO, (j + SDEPTH) * KVBLK); SBAR();
    pv_d0(o, vb0 + sp, pa0, pa1, pa2, pa3); partialSM(pB0, pB1, m_reg, mnB, alB);
    SWAIT(); SWRITE(sn, SE);
    RESC(alB); ROT();
    __syncthreads();
    SBAR(); qkt(pA0, pA1, (const bf16_t*)(K_lds + sc_), qr, r32, hi);
    finishSM(pB0, pB1, alB, l_reg, pa0, pa1, pa2, pa3); SBAR();
    if (j + 3 < NT) SLOAD(SE, (j + 1 + SDEPTH) * KVBLK); SBAR();
    pv_d0(o, vb0 + sp, pa0, pa1, pa2, pa3); partialSM(pA0, pA1, m_reg, mnA, alA);
    SWAIT(); SWRITE(sn, SO);
    RESC(alA); ROT();
  }
  __syncthreads();
  SBAR(); qkt(pB0, pB1, (const bf16_t*)(K_lds + sc_), qr, r32, hi);
  finishSM(pA0, pA1, alA, l_reg, pa0, pa1, pa2, pa3); SBAR();
  pv_d0(o, vb0 + sp, pa0, pa1, pa2, pa3); partialSM(pB0, pB1, m_reg, mnB, alB);
  RESC(alB);
  finishSM(pB0, pB1, alB, l_reg, pa0, pa1, pa2, pa3); SBAR();
  pv_d0(o, vb0 + sc_, pa0, pa1, pa2, pa3); SBAR();
#define ZLD(i) (*(const u32x4*)((const char*)Zb + (unsigned)((wid * QBLK + (i) * 4 + (lane >> 4)) * LD + (lane & 15) * 8) * 2u))
  u32x4 za, zb; if constexpr (GATED) { za = ZLD(0); zb = ZLD(1); }
  if (hi == 0) li_l[r32] = l_reg; asm volatile("s_waitcnt lgkmcnt(0)" ::: "memory");
  float rli[16];
#pragma unroll
  for (int r = 0; r < 16; ++r) rli[r] = __builtin_amdgcn_rcpf(li_l[crow(r, hi)]);
  __syncthreads();
  { bf16_t* stg = (bf16_t*)lds + wid * 4096;
#pragma unroll
    for (int r = 0; r < 16; ++r) { const int orow = crow(r, hi);
#pragma unroll
      for (int d0 = 0; d0 < 4; ++d0) stg[orow * 128 + d0 * 32 + r32] = (bf16_t)f2bf(o[d0][r] * rli[r]); }
    asm volatile("s_waitcnt lgkmcnt(0)" ::: "memory");
#pragma unroll 1
    for (int i = 0; i < 8; i += 2) { u32x4 na, nb; if constexpr (GATED) { const int i2 = (i + 2) & 7; na = ZLD(i2); nb = ZLD(i2 + 1); }
#pragma unroll
      for (int q = 0; q < 2; ++q) { const int row = (i + q) * 4 + (lane >> 4), ch = lane & 15; u32x4 v = *(const u32x4*)(stg + row * 128 + ch * 8);
        if constexpr (GATED) { const u32x4 z = q ? zb : za;
          v.x = pk2(bflo(v.x) * siluf_(bflo(z.x)), bfhi(v.x) * siluf_(bfhi(z.x))); v.y = pk2(bflo(v.y) * siluf_(bflo(z.y)), bfhi(v.y) * siluf_(bfhi(z.y)));
          v.z = pk2(bflo(v.z) * siluf_(bflo(z.z)), bfhi(v.z) * siluf_(bfhi(z.z))); v.w = pk2(bflo(v.w) * siluf_(bflo(z.w)), bfhi(v.w) * siluf_(bfhi(z.w))); }
        *(u32x4*)((char*)Ob + (unsigned)((wid * QBLK + row) * ldo + ch * 8) * 2u) = v; }
      if constexpr (GATED) { za = na; zb = nb; } }
#undef ZLD
    asm volatile("s_waitcnt lgkmcnt(0)" ::: "memory"); }
  __syncthreads();
#undef SLOAD
#undef SWRITE
#undef SWAIT
#undef RESC
#undef ROT
}

template <int LD, int ldo, bool GATED>
__device__ __forceinline__ void attn_unit_dma(const bf16_t* __restrict__ Qb, const bf16_t* __restrict__ Kh, const bf16_t* __restrict__ Vh,
                                              bf16_t* __restrict__ Ob, const bf16_t* __restrict__ Zb, int seq, char* lds, const int tid) {
  const int wid = tid >> 6, lane = tid & 63, r32 = lane & 31, hi = lane >> 5;
  char* V_lds = lds; char* K_lds = lds + 65536;
  float* ws = (float*)(lds + 131072) + wid * 64; float* li_l = ws; float* al_l = ws + 32;
  float m_reg = -1e30f, l_reg = 0; f32x16 o[4] = {}; bf16x8 qr[8];
  { const unsigned qoff = (unsigned)((wid * QBLK + r32) * LD + hi * 8) * 2u;
#pragma unroll
    for (int d0 = 0; d0 < 8; ++d0) qr[d0] = *(const bf16x8*)((const char*)Qb + qoff + d0 * 32); }
  const int vb0 = (int)(uintptr_t)V_lds + v_rd_base(lane);
  unsigned kof[2], vof[2];
#pragma unroll
  for (int i = 0; i < 2; ++i) { const int ob = ((i * 8 + wid) * 64 + lane) * 16, row = ob >> 8, cb = (ob & 255) ^ ((row & 7) << 4); kof[i] = (unsigned)(row * LD * 2 + cb);
    const int st = ob >> 9, e = (ob & 511) >> 1, kk = (st >> 2) * 8 + (e >> 5), c = (st & 3) * 32 + (e & 31), k = (kk & ~0xC) | ((kk & 4) << 1) | ((kk & 8) >> 1); vof[i] = (unsigned)(k * LD * 2 + c * 2); }
#define ADMA(t) do { const size_t to_ = (size_t)((t) * KVBLK) * (LD * 2); const int so_ = ((t) & 3) * SHM_V; _Pragma("unroll") for (int i_ = 0; i_ < 2; ++i_) { \
    __builtin_amdgcn_global_load_lds((const unsigned*)((const char*)Kh + to_ + kof[i_]), (LAS unsigned*)(LAS char*)(K_lds + so_ + (i_ * 8 + wid) * 1024), 16, 0, 0); \
    __builtin_amdgcn_global_load_lds((const unsigned*)((const char*)Vh + to_ + vof[i_]), (LAS unsigned*)(LAS char*)(V_lds + so_ + (i_ * 8 + wid) * 1024), 16, 0, 0); } } while (0)
#define AWAIT(more) do { if (more) asm volatile("s_waitcnt vmcnt(4)" ::: "memory"); else asm volatile("s_waitcnt vmcnt(0)" ::: "memory"); } while (0)
#define RESC(a) do { if (__any((a) < 1.f)) { if (hi == 0) al_l[r32] = (a); asm volatile("s_waitcnt lgkmcnt(0)" ::: "memory"); \
    for (int d = 0; d < 4; ++d) for (int r = 0; r < 16; ++r) o[d][r] *= al_l[crow(r, hi)]; } } while (0)
  f32x16 pA0, pA1, pB0, pB1; float mnA, mnB, alA, alB; bf16x8 pa0, pa1, pa2, pa3; const int NT = seq / KVBLK;
  const int hf = wid >> 2;
#define AMID(more) do { if (more) asm volatile("s_waitcnt vmcnt(4)" ::: "memory"); else asm volatile("s_waitcnt vmcnt(0)" ::: "memory"); __syncthreads(); } while (0)
  ADMA(0); ADMA(1); asm volatile("s_waitcnt vmcnt(0)" ::: "memory"); __syncthreads();
  if (2 < NT) ADMA(2);
  qkt(pA0, pA1, (const bf16_t*)K_lds, qr, r32, hi); SBAR(); partialSM(pA0, pA1, m_reg, mnA, alA); SBAR();
  if (hf == 0) {
    for (int j = 1; j + 1 < NT; j += 2) {
      asm volatile("s_waitcnt vmcnt(0)" ::: "memory"); __syncthreads();
      if (j + 2 < NT) ADMA(j + 2);
      SBAR(); qkt(pB0, pB1, (const bf16_t*)(K_lds + (j & 3) * SHM_K), qr, r32, hi); SBAR(); finishSM(pA0, pA1, alA, l_reg, pa0, pa1, pa2, pa3);
      SBAR();
      pv_d0(o, vb0 + ((j - 1) & 3) * SHM_V, pa0, pa1, pa2, pa3); SBAR(); partialSM(pB0, pB1, m_reg, mnB, alB); RESC(alB);
      asm volatile("s_waitcnt vmcnt(0)" ::: "memory"); __syncthreads();
      if (j + 3 < NT) ADMA(j + 3);
      SBAR(); qkt(pA0, pA1, (const bf16_t*)(K_lds + ((j + 1) & 3) * SHM_K), qr, r32, hi); SBAR(); finishSM(pB0, pB1, alB, l_reg, pa0, pa1, pa2, pa3);
      SBAR();
      pv_d0(o, vb0 + (j & 3) * SHM_V, pa0, pa1, pa2, pa3); SBAR(); partialSM(pA0, pA1, m_reg, mnA, alA); RESC(alA);
    }
    asm volatile("s_waitcnt vmcnt(0)" ::: "memory"); __syncthreads();
    SBAR(); qkt(pB0, pB1, (const bf16_t*)(K_lds + ((NT - 1) & 3) * SHM_K), qr, r32, hi); SBAR(); finishSM(pA0, pA1, alA, l_reg, pa0, pa1, pa2, pa3);
    SBAR();
    pv_d0(o, vb0 + ((NT - 2) & 3) * SHM_V, pa0, pa1, pa2, pa3); SBAR(); partialSM(pB0, pB1, m_reg, mnB, alB); RESC(alB);
  } else {
    qkt(pB0, pB1, (const bf16_t*)(K_lds + SHM_K), qr, r32, hi);
    for (int j = 1; j + 1 < NT; j += 2) {
      asm volatile("s_waitcnt vmcnt(0)" ::: "memory"); __syncthreads();
      if (j + 2 < NT) ADMA(j + 2);
      SBAR(); finishSM(pA0, pA1, alA, l_reg, pa0, pa1, pa2, pa3); SBAR(); pv_d0(o, vb0 + ((j - 1) & 3) * SHM_V, pa0, pa1, pa2, pa3);
      SBAR();
      partialSM(pB0, pB1, m_reg, mnB, alB); RESC(alB); SBAR(); qkt(pA0, pA1, (const bf16_t*)(K_lds + ((j + 1) & 3) * SHM_K), qr, r32, hi);
      asm volatile("s_waitcnt vmcnt(0)" ::: "memory"); __syncthreads();
      if (j + 3 < NT) ADMA(j + 3);
      SBAR(); finishSM(pB0, pB1, alB, l_reg, pa0, pa1, pa2, pa3); SBAR(); pv_d0(o, vb0 + (j & 3) * SHM_V, pa0, pa1, pa2, pa3);
      SBAR();
      partialSM(pA0, pA1, m_reg, mnA, alA); RESC(alA); SBAR(); qkt(pB0, pB1, (const bf16_t*)(K_lds + ((j + 2) & 3) * SHM_K), qr, r32, hi);
    }
    asm volatile("s_waitcnt vmcnt(0)" ::: "memory"); __syncthreads();
    SBAR(); finishSM(pA0, pA1, alA, l_reg, pa0, pa1, pa2, pa3); SBAR(); pv_d0(o, vb0 + ((NT - 2) & 3) * SHM_V, pa0, pa1, pa2, pa3);
    SBAR();
    partialSM(pB0, pB1, m_reg, mnB, alB); RESC(alB);
  }
  SBAR();
  finishSM(pB0, pB1, alB, l_reg, pa0, pa1, pa2, pa3); SBAR();
  pv_d0(o, vb0 + ((NT - 1) & 3) * SHM_V, pa0, pa1, pa2, pa3); SBAR();
#undef AMID
#define ZLD(i) (*(const u32x4*)((const char*)Zb + (unsigned)((wid * QBLK + (i) * 4 + (lane >> 4)) * LD + (lane & 15) * 8) * 2u))
  u32x4 za, zb; if constexpr (GATED) { za = ZLD(0); zb = ZLD(1); }
  if (hi == 0) li_l[r32] = l_reg; asm volatile("s_waitcnt lgkmcnt(0)" ::: "memory");
  float rli[16];
#pragma unroll
  for (int r = 0; r < 16; ++r) rli[r] = __builtin_amdgcn_rcpf(li_l[crow(r, hi)]);
  __syncthreads();
  { bf16_t* stg = (bf16_t*)lds + wid * 4096;
#pragma unroll
    for (int r = 0; r < 16; ++r) { const int orow = crow(r, hi);
#pragma unroll
      for (int d0 = 0; d0 < 4; ++d0) stg[orow * 128 + d0 * 32 + r32] = (bf16_t)f2bf(o[d0][r] * rli[r]); }
    asm volatile("s_waitcnt lgkmcnt(0)" ::: "memory");
#pragma unroll 1
    for (int i = 0; i < 8; i += 2) { u32x4 na, nb; if constexpr (GATED) { const int i2 = (i + 2) & 7; na = ZLD(i2); nb = ZLD(i2 + 1); }
#pragma unroll
      for (int q = 0; q < 2; ++q) { const int row = (i + q) * 4 + (lane >> 4), ch = lane & 15; u32x4 v = *(const u32x4*)(stg + row * 128 + ch * 8);
        if constexpr (GATED) { const u32x4 z = q ? zb : za;
          v.x = pk2(bflo(v.x) * siluf_(bflo(z.x)), bfhi(v.x) * siluf_(bfhi(z.x))); v.y = pk2(bflo(v.y) * siluf_(bflo(z.y)), bfhi(v.y) * siluf_(bfhi(z.y)));
          v.z = pk2(bflo(v.z) * siluf_(bflo(z.z)), bfhi(v.z) * siluf_(bfhi(z.z))); v.w = pk2(bflo(v.w) * siluf_(bflo(z.w)), bfhi(v.w) * siluf_(bfhi(z.w))); }
        *(u32x4*)((char*)Ob + (unsigned)((wid * QBLK + row) * ldo + ch * 8) * 2u) = v; }
      if constexpr (GATED) { za = na; zb = nb; } }
#undef ZLD
    asm volatile("s_waitcnt lgkmcnt(0)" ::: "memory"); }
  __syncthreads();
#undef ADMA
#undef AWAIT
#undef RESC
}
#define PVH_PK(L, H) (bf16x8){L[0], L[1], L[2], L[3], H[0], H[1], H[2], H[3]}
template <int D0> __device__ __forceinline__ void pvh_step(f32x16* o, int vb, bf16x8 pa0, bf16x8 pa1, bf16x8 pa2, bf16x8 pa3, s16x4& l0, s16x4& h0, s16x4& l1, s16x4& h1, s16x4& l2, s16x4& h2, s16x4& l3, s16x4& h3) {
  asm volatile("s_waitcnt lgkmcnt(4)" ::: "memory"); SBAR();
  o[D0] = __builtin_amdgcn_mfma_f32_32x32x16_bf16(pa0, PVH_PK(l0, h0), o[D0], 0, 0, 0); o[D0] = __builtin_amdgcn_mfma_f32_32x32x16_bf16(pa1, PVH_PK(l1, h1), o[D0], 0, 0, 0); SBAR();
  if constexpr (D0 < 3) { l0 = tr_read<v_rd_off(D0 + 1, 0, 0)>(vb); h0 = tr_read<v_rd_off(D0 + 1, 0, 1)>(vb); l1 = tr_read<v_rd_off(D0 + 1, 1, 0)>(vb); h1 = tr_read<v_rd_off(D0 + 1, 1, 1)>(vb);
    asm volatile("s_waitcnt lgkmcnt(4)" ::: "memory"); } else asm volatile("s_waitcnt lgkmcnt(0)" ::: "memory");
  SBAR();
  o[D0] = __builtin_amdgcn_mfma_f32_32x32x16_bf16(pa2, PVH_PK(l2, h2), o[D0], 0, 0, 0); o[D0] = __builtin_amdgcn_mfma_f32_32x32x16_bf16(pa3, PVH_PK(l3, h3), o[D0], 0, 0, 0); SBAR();
  if constexpr (D0 < 3) { l2 = tr_read<v_rd_off(D0 + 1, 2, 0)>(vb); h2 = tr_read<v_rd_off(D0 + 1, 2, 1)>(vb); l3 = tr_read<v_rd_off(D0 + 1, 3, 0)>(vb); h3 = tr_read<v_rd_off(D0 + 1, 3, 1)>(vb); }
}
__device__ __forceinline__ void pv_d0p(f32x16* o, int vb, bf16x8 pa0, bf16x8 pa1, bf16x8 pa2, bf16x8 pa3) {
  s16x4 l0 = tr_read<v_rd_off(0, 0, 0)>(vb), h0 = tr_read<v_rd_off(0, 0, 1)>(vb), l1 = tr_read<v_rd_off(0, 1, 0)>(vb), h1 = tr_read<v_rd_off(0, 1, 1)>(vb);
  s16x4 l2 = tr_read<v_rd_off(0, 2, 0)>(vb), h2 = tr_read<v_rd_off(0, 2, 1)>(vb), l3 = tr_read<v_rd_off(0, 3, 0)>(vb), h3 = tr_read<v_rd_off(0, 3, 1)>(vb);
  pvh_step<0>(o, vb, pa0, pa1, pa2, pa3, l0, h0, l1, h1, l2, h2, l3, h3); pvh_step<1>(o, vb, pa0, pa1, pa2, pa3, l0, h0, l1, h1, l2, h2, l3, h3);
  pvh_step<2>(o, vb, pa0, pa1, pa2, pa3, l0, h0, l1, h1, l2, h2, l3, h3); pvh_step<3>(o, vb, pa0, pa1, pa2, pa3, l0, h0, l1, h1, l2, h2, l3, h3);
}
#undef PVH_PK
constexpr int P2_K = 65536, P2_MB = 98304, P2_SCR = 139264, P2_HSX = P2_SCR + NW * 64 * 4, SHM_PAIR = P2_HSX + 1024;
template <int LD, int ldo, int M, bool COMB>
__device__ __forceinline__ void attn_pair_map(unsigned char* const wsb, CArgsP ap, const float lam, const int qrow, const int bq, const int h, int seq, char* lds, int tid) {
  asm volatile("" : "+v"(tid));
  constexpr int m = M;
  const int wid = tid >> 6, lane = tid & 63, r32 = lane & 31, hi = lane >> 5, pr = wid & 3, g = wid >> 2;
  const bf16_t* __restrict__ Vh; const bf16_t* __restrict__ K0; const bf16_t* __restrict__ Q0;
  { unsigned char* w_ = wsb; asm volatile("" : "+s"(w_)); const bf16_t* U_ = (const bf16_t*)(w_ + WS_U);
    Q0 = U_ + (size_t)qrow * LD + h * 128; K0 = U_ + (size_t)(bq * TT) * LD + 2048 + h * 128; Vh = U_ + (size_t)(bq * TT) * LD + 4096 + h * 256; }
  char* V_lds = lds; char* K_lds = lds + P2_K; char* MB = lds + P2_MB + pr * 10240;
  float* ws = (float*)(lds + P2_SCR) + wid * 64; float* li_l = ws; float* al_l = ws + 32;
  const int vb0 = (int)(uintptr_t)V_lds + v_rd_base(lane) + g * SHM_V;
  unsigned kof[2], vof[4];
#pragma unroll
  for (int i = 0; i < 2; ++i) { const int ob = ((i * 8 + wid) * 64 + lane) * 16, row = ob >> 8, cb = (ob & 255) ^ ((row & 7) << 4); kof[i] = (unsigned)(row * LD * 2 + cb); }
#pragma unroll
  for (int i = 0; i < 4; ++i) { const int ob = ((i * 8 + wid) * 64 + lane) * 16, vh = ob >> 14, oi = ob & 16383, st = oi >> 9, e = (oi & 511) >> 1, kk = (st >> 2) * 8 + (e >> 5), c = (st & 3) * 32 + (e & 31);
    const int k = (kk & ~0xC) | ((kk & 4) << 1) | ((kk & 8) >> 1); vof[i] = (unsigned)(k * LD * 2 + (vh * 128 + c) * 2); }
#define P2_DMAK(t, slot) do { const char* kt_ = (const char*)Kh + (size_t)((t) * KVBLK) * (LD * 2); _Pragma("unroll") for (int i_ = 0; i_ < 2; ++i_) \
    __builtin_amdgcn_global_load_lds((const unsigned*)(kt_ + kof[i_]), (LAS unsigned*)(LAS char*)(K_lds + (slot) * SHM_K + (i_ * 8 + wid) * 1024), 16, 0, 0); } while (0)
#define P2_DMAV(t, slot) do { const char* vt_ = (const char*)Vh + (size_t)((t) * KVBLK) * (LD * 2); _Pragma("unroll") for (int i_ = 0; i_ < 4; ++i_) \
    __builtin_amdgcn_global_load_lds((const unsigned*)(vt_ + vof[i_]), (LAS unsigned*)(LAS char*)(V_lds + (slot) * (2 * SHM_V) + (i_ * 8 + wid) * 1024), 16, 0, 0); } while (0)
#define P2_RESC(a) do { if (__any((a) < 1.f)) { if (hi == 0) al_l[r32] = (a); asm volatile("s_waitcnt lgkmcnt(0)" ::: "memory"); \
    for (int d = 0; d < 4; ++d) for (int r = 0; r < 16; ++r) o[d][r] *= al_l[crow(r, hi)]; } } while (0)
  const int NT = seq / KVBLK;
  {
  const bf16_t* Qb = Q0 + m * 1024; const bf16_t* Kh = K0 + m * 1024;
  float m_reg = -1e30f, l_reg = 0; f32x16 o[4] = {}; bf16x8 qr[8];
  { const unsigned qoff = (unsigned)((pr * QBLK + r32) * LD + hi * 8) * 2u;
#pragma unroll
    for (int d0 = 0; d0 < 8; ++d0) qr[d0] = *(const bf16x8*)((const char*)Qb + qoff + d0 * 32); }
  f32x16 S0, S1; bf16x8 pa0, pa1, pa2, pa3;
  P2_DMAK(0, 0); P2_DMAK(1, 1); asm volatile("s_waitcnt vmcnt(0)" ::: "memory");
  __syncthreads();
  if (g == 0) qkt(S0, S1, (const bf16_t*)K_lds, qr, r32, hi);
  for (int j = 0; j <= NT; ++j) {
    const bool own = ((j & 1) == g);
    asm volatile("s_waitcnt vmcnt(0)" ::: "memory");
    __syncthreads();
    if (j + 2 < NT) P2_DMAK(j + 2, j & 1);
    if (j < NT) P2_DMAV(j, j & 1);
    SBAR();
    if (own) __builtin_amdgcn_s_setprio(2); else __builtin_amdgcn_s_setprio(0);
    if (own) {
      float alp = 1.f;
      if (j >= 1) { const char* mb = MB + ((j - 1) & 1) * 5120; alp = *(const float*)(mb + 4096 + lane * 4); m_reg = *(const float*)(mb + 4352 + lane * 4); l_reg = *(const float*)(mb + 4608 + lane * 4);
        asm volatile("s_waitcnt lgkmcnt(0)" ::: "memory"); }
      bf16x8 pn0, pn1, pn2, pn3; float al = 1.f;
      if (j < NT) { float mn; partialSM(S0, S1, m_reg, mn, al); finishSM(S0, S1, al, l_reg, pn0, pn1, pn2, pn3);
        char* mb = MB + (j & 1) * 5120;
        *(bf16x8*)(mb + lane * 16) = pn0; *(bf16x8*)(mb + 1024 + lane * 16) = pn1; *(bf16x8*)(mb + 2048 + lane * 16) = pn2; *(bf16x8*)(mb + 3072 + lane * 16) = pn3;
        *(float*)(mb + 4096 + lane * 4) = al; *(float*)(mb + 4352 + lane * 4) = m_reg; *(float*)(mb + 4608 + lane * 4) = l_reg; }
      SBAR();
      if (j >= 1) { const char* mb = MB + ((j - 1) & 1) * 5120;
        pa0 = *(const bf16x8*)(mb + lane * 16); pa1 = *(const bf16x8*)(mb + 1024 + lane * 16); pa2 = *(const bf16x8*)(mb + 2048 + lane * 16); pa3 = *(const bf16x8*)(mb + 3072 + lane * 16);
        P2_RESC(alp);
        asm volatile("s_waitcnt lgkmcnt(0)" ::: "memory"); SBAR();
        pv_d0p(o, vb0 + ((j - 1) & 1) * (2 * SHM_V), pa0, pa1, pa2, pa3); SBAR(); }
      if (j < NT) P2_RESC(al);
    } else {
      if (j >= 1) { const char* mb = MB + ((j - 1) & 1) * 5120;
        pa0 = *(const bf16x8*)(mb + lane * 16); pa1 = *(const bf16x8*)(mb + 1024 + lane * 16); pa2 = *(const bf16x8*)(mb + 2048 + lane * 16); pa3 = *(const bf16x8*)(mb + 3072 + lane * 16);
        asm volatile("s_waitcnt lgkmcnt(0)" ::: "memory"); SBAR();
        pv_d0p(o, vb0 + ((j - 1) & 1) * (2 * SHM_V), pa0, pa1, pa2, pa3); SBAR(); }
      if (j + 1 < NT) qkt(S0, S1, (const bf16_t*)(K_lds + ((j + 1) & 1) * SHM_K), qr, r32, hi);
    }
  }
  __builtin_amdgcn_s_setprio(0);
  if (hi == 0) li_l[r32] = l_reg; asm volatile("s_waitcnt lgkmcnt(0)" ::: "memory");
  float rli[16];
#pragma unroll
  for (int r = 0; r < 16; ++r) rli[r] = __builtin_amdgcn_rcpf(li_l[crow(r, hi)]);
  __syncthreads();
  { bf16_t* stg = (bf16_t*)lds + wid * 4096;
    unsigned char* w2_ = wsb; int lane_e = lane, pr_e = pr, g_e = g; asm volatile("" : "+s"(w2_), "+v"(lane_e), "+v"(pr_e), "+v"(g_e));
    bf16_t* Ob = (bf16_t*)(w2_ + WS_OD) + (size_t)qrow * ldo + h * 256; bf16_t* ObS = Ob + M * 8 * 256;
    const bf16_t* Zb = (const bf16_t*)(w2_ + WS_U) + (size_t)qrow * LD + 6144 + h * 256; bf16_t* Yb = (bf16_t*)(w2_ + WS_Y) + (size_t)qrow * DM + h * 256;
    const float* subg = ap->in[I_BSUBG];
#pragma unroll
    for (int r = 0; r < 16; ++r) { const int orow = crow(r, hi);
#pragma unroll
      for (int d0 = 0; d0 < 4; ++d0) stg[orow * 128 + d0 * 32 + r32] = (bf16_t)f2bf(o[d0][r] * rli[r]); }
    asm volatile("s_waitcnt lgkmcnt(0)" ::: "memory");
    if (!COMB) {
#pragma unroll 2
      for (int i = 0; i < 8; ++i) { const int row = i * 4 + (lane_e >> 4), ch = lane_e & 15; const u32x4 v = *(const u32x4*)(stg + row * 128 + ch * 8);
        *(u32x4*)((char*)ObS + (unsigned)((pr_e * QBLK + row) * ldo + g_e * 128 + ch * 8) * 2u) = v; }
      asm volatile("s_waitcnt lgkmcnt(0)" ::: "memory");
    } else {
      float* hsx = (float*)(lds + P2_HSX); const int ch = lane_e & 15;
#define P2_DIFF(v0, v1, od) do { od[0] = bflo(v0.x) - lam * bflo(v1.x); od[1] = bfhi(v0.x) - lam * bfhi(v1.x); od[2] = bflo(v0.y) - lam * bflo(v1.y); od[3] = bfhi(v0.y) - lam * bfhi(v1.y); \
        od[4] = bflo(v0.z) - lam * bflo(v1.z); od[5] = bfhi(v0.z) - lam * bfhi(v1.z); od[6] = bflo(v0.w) - lam * bflo(v1.w); od[7] = bfhi(v0.w) - lam * bfhi(v1.w); } while (0)
#pragma unroll 2
      for (int i = 0; i < 8; ++i) { const int row = i * 4 + (lane_e >> 4); const u32x4 v1 = *(const u32x4*)(stg + row * 128 + ch * 8);
        const u32x4 v0 = *(const u32x4*)((const char*)Ob + (unsigned)((pr_e * QBLK + row) * ldo + g_e * 128 + ch * 8) * 2u);
        float od[8]; P2_DIFF(v0, v1, od); float ss = 0.f;
#pragma unroll
        for (int k = 0; k < 8; ++k) ss += od[k] * od[k];
        ss += shx<1>(ss); ss += shx<2>(ss); ss += shx<4>(ss); ss += shx<8>(ss);
        if (ch == 0) hsx[(pr_e * QBLK + row) * 2 + g_e] = ss; }
      asm volatile("s_waitcnt lgkmcnt(0)" ::: "memory"); __syncthreads();
      const f32x4 sg0 = *(const f32x4*)(subg + g_e * 128 + ch * 8), sg1 = *(const f32x4*)(subg + g_e * 128 + ch * 8 + 4);
#pragma unroll 2
      for (int i = 0; i < 8; ++i) { const int row = i * 4 + (lane_e >> 4); const u32x4 v1 = *(const u32x4*)(stg + row * 128 + ch * 8);
        const u32x4 v0 = *(const u32x4*)((const char*)Ob + (unsigned)((pr_e * QBLK + row) * ldo + g_e * 128 + ch * 8) * 2u);
        const u32x4 zr = *(const u32x4*)((const char*)Zb + (unsigned)((pr_e * QBLK + row) * LD + g_e * 128 + ch * 8) * 2u);
        float od[8]; P2_DIFF(v0, v1, od);
        const float rstd = frsq((hsx[(pr_e * QBLK + row) * 2] + hsx[(pr_e * QBLK + row) * 2 + 1]) * (1.0f / 256.0f) + EPS);
        const float z[8] = {bflo(zr.x), bfhi(zr.x), bflo(zr.y), bfhi(zr.y), bflo(zr.z), bfhi(zr.z), bflo(zr.w), bfhi(zr.w)};
        const float sg[8] = {sg0[0], sg0[1], sg0[2], sg0[3], sg1[0], sg1[1], sg1[2], sg1[3]};
#pragma unroll
        for (int k = 0; k < 8; ++k) od[k] = (od[k] * rstd * sg[k]) * (1.0f - LAM_INIT1) * siluf_(z[k]);
        u32x4 w; w.x = pk2(od[0], od[1]); w.y = pk2(od[2], od[3]); w.z = pk2(od[4], od[5]); w.w = pk2(od[6], od[7]);
        *(u32x4*)((char*)Yb + (unsigned)((pr_e * QBLK + row) * DM + g_e * 128 + ch * 8) * 2u) = w; }
#undef P2_DIFF
      asm volatile("s_waitcnt lgkmcnt(0)" ::: "memory");
    } }
  __syncthreads();
  }
#undef P2_DMAK
#undef P2_DMAV
#undef P2_RESC
}
template <int LD, int ldo>
__device__ __forceinline__ void attn_unit_pair(unsigned char* const wsb, CArgsP ap, const float lam, const int qrow, const int bq, const int h, int seq, char* lds, const int tid) {
  attn_pair_map<LD, ldo, 0, false>(wsb, ap, lam, qrow, bq, h, seq, lds, tid);
  attn_pair_map<LD, ldo, 1, true>(wsb, ap, lam, qrow, bq, h, seq, lds, tid);
}
template <int LD, int ldo>
__device__ __forceinline__ void attn_unit_pair_one(unsigned char* const wsb, CArgsP ap, const int qrow, const int bq, const int h, const int m, int seq, char* lds, const int tid) {
  if (m == 0) attn_pair_map<LD, ldo, 0, false>(wsb, ap, 0.f, qrow, bq, h, seq, lds, tid);
  else        attn_pair_map<LD, ldo, 1, false>(wsb, ap, 0.f, qrow, bq, h, seq, lds, tid);
}
#undef KSWZ
#undef SBAR
}

constexpr int RING_BYTES = 131072, ATT_OST_OFF = 69632  , LDSCTL_OFF = 155648, MISC_OFF = LDSCTL_OFF + 320, LDS_BYTES = 163840;
static_assert(att::SHM_ATTN <= RING_BYTES && att::SHM_PAIR <= LDSCTL_OFF && MISC_OFF + 128 <= LDS_BYTES, "LDS map");
constexpr int NWAVES = 8;

typedef GAS unsigned gu32;
#define RLX_AGENT __ATOMIC_RELAXED, __HIP_MEMORY_SCOPE_AGENT
#define LDS_WAIT() asm volatile("s_waitcnt lgkmcnt(0)" ::: "memory")
#define VM_WAIT() asm volatile("s_waitcnt vmcnt(0)" ::: "memory")

#define XB_TMO      128
#define XB_XCNT(j)  (256  + 64 * (j))
#define XB_XSUB(j)  (1280 + 64 * (j))
#define XB_XGEN(j)  (2304 + 64 * (j))
#define XB_TOP      3328
#define XB_TOPGEN   3392
#define XCD_BAR_WORDS 3456
#define XB_SPIN_CAP (1u << 18)
__device__ __forceinline__ unsigned xb_ld(unsigned* p)              { return __hip_atomic_load(p, __ATOMIC_RELAXED, __HIP_MEMORY_SCOPE_AGENT); }
__device__ __forceinline__ unsigned xb_add(unsigned* p, unsigned v) { return __hip_atomic_fetch_add(p, v, __ATOMIC_RELAXED, __HIP_MEMORY_SCOPE_AGENT); }
__device__ __forceinline__ int lane_id_opaque() { int lo_, r_; asm volatile("v_mbcnt_lo_u32_b32 %0, -1, 0" : "=v"(lo_)); asm volatile("v_mbcnt_hi_u32_b32 %0, -1, %1" : "=v"(r_) : "v"(lo_)); return r_; }
__device__ __forceinline__ unsigned hw_slot() { return (unsigned)__builtin_amdgcn_s_getreg((5 << 11) | 4) & 63u; }
__device__ __forceinline__ unsigned xb_xcc_id() { return (unsigned)__builtin_amdgcn_s_getreg((3 << 11) | 20) & 0xFu; }
#define XB_SPIN(cond, bar) do { unsigned _sp = 0; while (cond) { __builtin_amdgcn_s_sleep(1); \
    if ((++_sp & 255u) == 0u) { if (xb_ld(&(bar)[XB_TMO])) break; if (_sp > XB_SPIN_CAP) { atomicAdd(&(bar)[XB_TMO], 1u); break; } } } } while (0)
struct XcdBarrier { unsigned* bar; unsigned x; volatile LAS unsigned* st; };
__device__ __forceinline__ XcdBarrier xcd_barrier_post(unsigned* bar, volatile LAS unsigned* st, bool is_t0) {
    XcdBarrier b; b.bar = bar; b.x = xb_xcc_id(); b.st = st;
    if (is_t0) (void)xb_add(&bar[XB_XCNT(b.x)], 1u);
    return b;
}
__device__ __forceinline__ void xcd_barrier_complete(unsigned* bar, unsigned x, unsigned& nloc, unsigned& nx) {
    const unsigned G = 256u;
    unsigned sum, cnt, mine, sp = 0u;
    for (;;) {
        sum = 0u; cnt = 0u; mine = 0u;
#pragma unroll
        for (unsigned j = 0; j < 16; ++j) { const unsigned c = xb_ld(&bar[XB_XCNT(j)]); sum += c; cnt += (c > 0u) ? 1u : 0u; mine = (j == x) ? c : mine; }
        if (sum == G) break;
        __builtin_amdgcn_s_sleep(1);
        if ((++sp & 255u) == 0u) { if (xb_ld(&bar[XB_TMO])) break; if (sp > XB_SPIN_CAP) { atomicAdd(&bar[XB_TMO], 1u); break; } }
    }
    nloc = mine > 0u ? mine : 1u; nx = cnt > 0u ? cnt : 1u;
}
__device__ __forceinline__ void xcd_barrier(const XcdBarrier& b, int wave_s) {
    asm volatile("s_waitcnt vmcnt(0)" ::: "memory");
    __syncthreads();
    if (wave_s == 0 && lane_id_opaque() == 0) {
        unsigned* bar = b.bar;
        __builtin_amdgcn_s_waitcnt(0);
        unsigned nloc = b.st[0], nx = b.st[1];
        if (nloc == 0u) { xcd_barrier_complete(bar, b.x, nloc, nx); b.st[0] = nloc; b.st[1] = nx; }
        const unsigned old = xb_add(&bar[XB_XSUB(b.x)], 1u);
        const unsigned gen = old / nloc;
        if (old + 1u == (gen + 1u) * nloc) {
            __builtin_amdgcn_fence(__ATOMIC_RELEASE, "agent");
            asm volatile("s_waitcnt vmcnt(0)" ::: "memory");
            const unsigned og = xb_add(&bar[XB_TOP], 1u);
            const unsigned tg = og / nx;
            if (og + 1u == (tg + 1u) * nx) xb_add(&bar[XB_TOPGEN], 1u);
            else XB_SPIN(xb_ld(&bar[XB_TOPGEN]) == tg, bar);
            __builtin_amdgcn_fence(__ATOMIC_ACQUIRE, "agent");
            xb_add(&bar[XB_XGEN(b.x)], 1u);
            asm volatile("s_waitcnt vmcnt(0)" ::: "memory");
        } else {
            XB_SPIN(xb_ld(&bar[XB_XGEN(b.x)]) == gen, bar);
            __builtin_amdgcn_fence(__ATOMIC_ACQUIRE, "agent");
            asm volatile("s_waitcnt vmcnt(0)" ::: "memory");
        }
    }
    __syncthreads();
}

__device__ __forceinline__ int p0_dst_row(int ns, int qkcols) {
    if (qkcols > 0) return (ns < qkcols) ? ((ns & ~127) | qk_pi_inv(ns & 127)) : ns;
    if (qkcols < 0) { const int code = -qkcols - 1, gate = code >> 4, dir = (code >> 3) & 1, nblk = code & 7, e = ns & 127;
        const int c = (((e >> 6) & 1) << 7) | (((e >> 4) & 3) << 5) | (((e >> 2) & 3) << 3) | (gate << 2) | (e & 3); return (nblk * 4 + dir * 2 + (ns >> 7)) * 256 + c; }
    return ns;
}
__device__ __forceinline__ void p0_transpose_item(const float* __restrict__ W, int K, int N, bf16_t* __restrict__ WT, LAS bf16_t* scr, int item, int lane, int qkcols, const float* shl = nullptr, float* shwp = nullptr) {
    const int nblk = N / 64, kb = item / nblk, nb = item % nblk, k0 = 64 * kb, n0 = 64 * nb;
    const int n4 = (lane & 15) * 4, kr = lane >> 4;
    f32x4 v[16];
#pragma unroll
    for (int i = 0; i < 16; ++i) v[i] = *(const f32x4*)(W + (size_t)(k0 + 4 * i + kr) * N + n0 + n4);
    float shv[5];
    if (shl) {
#pragma unroll
        for (int r = 0; r < 5; ++r) shv[r] = shl[(size_t)r * 6144 + k0 + lane]; }
#pragma unroll
    for (int i = 0; i < 16; ++i) { const int k = 4 * i + kr;
        scr[(n4 + 0) * 72 + k] = (bf16_t)f2bf(v[i].x); scr[(n4 + 1) * 72 + k] = (bf16_t)f2bf(v[i].y); scr[(n4 + 2) * 72 + k] = (bf16_t)f2bf(v[i].z); scr[(n4 + 3) * 72 + k] = (bf16_t)f2bf(v[i].w); }
    LAS float* shs = (LAS float*)(scr + 64 * 72);
    if (shl) {
#pragma unroll
        for (int r = 0; r < 5; ++r) shs[r * 64 + lane] = shv[r]; }
    LDS_WAIT(); asm volatile("" ::: "memory");
#pragma unroll
    for (int i = 0; i < 8; ++i) { const int n = 8 * i + (lane >> 3), kc = (lane & 7) * 8;
        const u32x4 o = *(const LAS u32x4*)(scr + n * 72 + kc);
        const int ns = n0 + n, nd = p0_dst_row(ns, qkcols);
        *(u32x4*)(WT + (size_t)nd * K + k0 + kc) = o; }
    if (shl) { float a0 = 0.f, a1 = 0.f, a2 = 0.f, a3 = 0.f, a4 = 0.f;
#pragma unroll 1
        for (int c = 0; c < 8; ++c) { const u32x4 w = *(const LAS u32x4*)(scr + lane * 72 + c * 8);
            const float wf[8] = {bflo(w.x), bfhi(w.x), bflo(w.y), bfhi(w.y), bflo(w.z), bfhi(w.z), bflo(w.w), bfhi(w.w)};
#pragma unroll
            for (int h = 0; h < 2; ++h) { const f32x4 s0 = *(const LAS f32x4*)(shs + c * 8 + h * 4), s1 = *(const LAS f32x4*)(shs + 64 + c * 8 + h * 4), s2 = *(const LAS f32x4*)(shs + 128 + c * 8 + h * 4),
                                 s3 = *(const LAS f32x4*)(shs + 192 + c * 8 + h * 4), s4 = *(const LAS f32x4*)(shs + 256 + c * 8 + h * 4);
#pragma unroll
                for (int e = 0; e < 4; ++e) { const float x = wf[h * 4 + e]; a0 += x * s0[e]; a1 += x * s1[e]; a2 += x * s2[e]; a3 += x * s3[e]; a4 += x * s4[e]; } } }
        const int nd = p0_dst_row(n0 + lane, qkcols); float* o = shwp + (size_t)kb * 5 * 8192 + nd;
        o[0] = a0; o[8192] = a1; o[2 * 8192] = a2; o[3 * 8192] = a3; o[4 * 8192] = a4; }
    LDS_WAIT(); asm volatile("" ::: "memory");
}
__device__ __forceinline__ void conv_job(const float* W, int N, bf16_t* WT, int qkcols, int shw_layer, unsigned char* ws, LAS unsigned char* ldsl, int wave, int lane, int widx, int nw) {
    LAS bf16_t* scr = (LAS bf16_t*)(ldsl + wave * 16384);
    const float* shl = shw_layer > 0 ? (const float*)(ws + WS_MODS) + (size_t)shw_layer * 5 * 6144 : nullptr;
    float* shwp = shw_layer > 0 ? (float*)(ws + WS_SHWP) + (size_t)(shw_layer - 1) * 32 * 5 * 8192 : nullptr;
    const int items = (DM / 64) * (N / 64);
    for (int it = widx; it < items; it += nw) { int l2 = lane; asm volatile("" : "+v"(l2));
        p0_transpose_item(W, DM, N, WT, scr, it, l2, qkcols, shl, shwp); }
}
__device__ __forceinline__ void sincos_d(float angf, float& s, float& c) {
    const double a = (double)angf; const double kq = rint(a * 0.63661977236758134308); const double r = a - kq * 1.57079632679489661923; const double r2 = r * r;
    const double sp = r * (1.0 + r2 * (-1.0 / 6 + r2 * (1.0 / 120 + r2 * (-1.0 / 5040 + r2 * (1.0 / 362880 + r2 * (-1.0 / 39916800 + r2 * (1.0 / 6227020800.0)))))));
    const double cp = 1.0 + r2 * (-0.5 + r2 * (1.0 / 24 + r2 * (-1.0 / 720 + r2 * (1.0 / 40320 + r2 * (-1.0 / 3628800 + r2 * (1.0 / 479001600.0))))));
    const int q = ((int)kq) & 3;
    const double ss = (q == 0) ? sp : (q == 1) ? cp : (q == 2) ? -sp : -cp;
    const double cc = (q == 0) ? cp : (q == 1) ? -sp : (q == 2) ? -cp : sp;
    s = (float)ss; c = (float)cc;
}

__device__ __forceinline__ void ada_fill_sil(CArgsP ap, LAS float* sil, int tid) {
    for (int i = tid; i < 5 * DM; i += NWAVES * 64) { const int r = i / DM, k = i - r * DM; const float v = (r < 4) ? ap->in[I_C][r * DM + k] : ap->in[I_CCTX][k]; sil[i] = siluf_(v); }
}
__device__ __forceinline__ void ada_item(CArgsP ap, unsigned char* ws, const LAS float* sil, int l, int kc, int ng, int lane) {
    const int nq = ng * 64 + lane;
    const float* wp = ap->in[I_ADAW] + ((size_t)l * DM + kc * 128) * 6144 + nq * 4;
    f32x4 a0 = {0, 0, 0, 0}, a1 = a0, a2 = a0, a3 = a0, a4 = a0;
#pragma unroll 8
    for (int k = 0; k < 128; ++k) { const f32x4 w = *(const f32x4*)(wp + (size_t)k * 6144); const int kk = kc * 128 + k;
        a0 += w * sil[kk]; a1 += w * sil[DM + kk]; a2 += w * sil[2 * DM + kk]; a3 += w * sil[3 * DM + kk]; a4 += w * sil[4 * DM + kk]; }
    if (kc == 0) { const f32x4 bv = *(const f32x4*)(ap->in[I_ADAB] + l * 6144 + nq * 4); a0 += bv; a1 += bv; a2 += bv; a3 += bv; a4 += bv; }
    float* mp = (float*)(ws + WS_AGG) + ((size_t)(kc * 4 + l) * 5) * 6144 + nq * 4;
    *(f32x4*)(mp) = a0; *(f32x4*)(mp + 6144) = a1; *(f32x4*)(mp + 2 * 6144) = a2; *(f32x4*)(mp + 3 * 6144) = a3; *(f32x4*)(mp + 4 * 6144) = a4;
}
__device__ __forceinline__ void ada_layer(CArgsP ap, unsigned char* ws, const LAS float* sil, int l, int lane, int widx, int nw) {
    for (int it = widx; it < 384; it += nw) ada_item(ap, ws, sil, l, it / 24, it % 24, lane);
}
__device__ __forceinline__ void mods_reduce(CArgsP ap, unsigned char* ws, int l, int gt_, int NGT) {
    const float* part = (const float*)(ws + WS_AGG) + (size_t)l * 5 * 6144; float* mods = (float*)(ws + WS_MODS) + (size_t)l * 5 * 6144; float* GM = (float*)(ws + WS_GM) + (size_t)l * 5 * DM;
    for (int it = gt_; it < 5 * 6144 / 4; it += NGT) { f32x4 acc = {0.f, 0.f, 0.f, 0.f};
#pragma unroll
        for (int kc = 0; kc < 16; ++kc) acc += *(const f32x4*)(part + (size_t)kc * 4 * 5 * 6144 + (size_t)it * 4);
        *(f32x4*)(mods + (size_t)it * 4) = acc;
        const int r = (it * 4) / 6144, c = it * 4 - r * 6144;
        if (l >= 1 && c >= DM && c < 2 * DM) { const f32x4 g = *(const f32x4*)(ap->in[I_NORMG] + l * DM + (c - DM)); *(f32x4*)(GM + (size_t)r * DM + (c - DM)) = g * (acc + 1.0f); } }
}

__device__ __forceinline__ void fresh_ids(LAS unsigned char* ldsl, int& bx, int& wave, int& lane) {
    bx = __builtin_amdgcn_readfirstlane((int)((volatile LAS unsigned*)(ldsl + MISC_OFF))[12]); wave = __builtin_amdgcn_readfirstlane((int)((volatile LAS unsigned*)(ldsl + LDSCTL_OFF))[hw_slot()]); lane = lane_id_opaque();
    asm volatile("" : "+s"(bx), "+s"(wave), "+v"(lane));
}

enum { K_PRO, K_MODRED, K_PRE0, K_GEMM_BF16, K_GEMM_RES, K_GEMM_GATES, K_QKPOST, K_ATT_A, K_ATT_B, K_COMBINE, K_CONV, K_SCAN_AGG, K_SCAN_APPLY, K_FINAL };
template <int KIND, int layer, int PH, bool DUPRUN = false>
__device__ __forceinline__ void run_phase(char* ldsg, int wave_s) {
    LAS unsigned char* ldsl = (LAS unsigned char*)ldsg;
    CArgsP ap = (CArgsP)__builtin_amdgcn_kernarg_segment_ptr();
    asm volatile("" : "+s"(ap));
    int G = pg8::GRID, bx = __builtin_amdgcn_readfirstlane((int)((volatile LAS unsigned*)(ldsl + MISC_OFF))[12]), wave = wave_s;
    asm volatile("" : "+s"(G)); asm volatile("" : "+s"(bx)); asm volatile("" : "+s"(wave));
    int tid = wave * 64 + lane_id_opaque();
    asm volatile("" : "+v"(tid));
    const int lane = tid & 63;
    const int vcu = (G % 8 == 0) ? (bx % 8) * (G / 8) + bx / 8 : bx;
    const int gw = vcu * NWAVES + wave, NGW = G * NWAVES;
    const int gt_ = vcu * NWAVES * 64 + tid, NGT = G * NWAVES * 64;
    unsigned char* ws = ap->ws;
    float* mods = (float*)(ws + WS_MODS);
    float* tabc = (float*)(ws + WS_TAB); float* tabs = tabc + 96 * 32; float* c8t = (float*)(ws + WS_TAB + 65536);
    bf16_t* WA_IN = (bf16_t*)(ws + WS_WA_IN); bf16_t* WA_OUT = (bf16_t*)(ws + WS_WA_OUT); bf16_t* WB_IN = (bf16_t*)(ws + WS_WB_IN); bf16_t* WB_OUT = (bf16_t*)(ws + WS_WB_OUT);
    bf16_t* WR_IN = (bf16_t*)(ws + WS_WR_IN); bf16_t* WR_OUT = (bf16_t*)(ws + WS_WR_OUT); bf16_t* WG = (bf16_t*)(ws + WS_WG);
    float* X = (float*)(ws + WS_X); bf16_t* H = (bf16_t*)(ws + WS_H); bf16_t* Y = (bf16_t*)(ws + WS_Y); bf16_t* U = (bf16_t*)(ws + WS_U); bf16_t* OD = (bf16_t*)(ws + WS_OD);
    unsigned* SAB = (unsigned*)(ws + WS_SA); float* AGG = (float*)(ws + WS_AGG);
    bf16_t* UP = (bf16_t*)(ws + WS_UP); float* GM = (float*)(ws + WS_GM); float* SHW = (float*)(ws + WS_SHW); float* SSQ = (float*)(ws + WS_SSQ);
    (void)GM; (void)SHW; (void)SSQ; (void)mods; (void)tabc; (void)tabs; (void)c8t; (void)WA_IN; (void)WA_OUT; (void)WB_IN; (void)WB_OUT; (void)WR_IN; (void)WR_OUT; (void)WG; (void)X; (void)H; (void)Y; (void)U; (void)OD; (void)SAB; (void)AGG; (void)UP;
    (void)gw; (void)NGW; (void)gt_; (void)NGT; (void)lane; (void)ldsl;

    if constexpr (KIND == K_PRO) {
        {
            LAS float* sil = (LAS float*)ldsl;
            LAS int* ctr = (LAS int*)(ldsl + 40960 + NWAVES * 9216);
            if (tid == 0) *ctr = 0;
            ada_fill_sil(ap, sil, tid); __syncthreads();
            if (wave < 3) { const int it = bx + 256 * wave; ada_item(ap, ws, sil, it / 384, (it % 384) / 24, it % 24, lane); }
            LAS bf16_t* scr = (LAS bf16_t*)(ldsl + 40960 + wave * 9216);
            constexpr int I_AIN = (DM / 64) * (A_IN / 64), I_SQ = (DM / 64) * (DM / 64), I_BIN = (DM / 64) * (B_IN / 64);
            constexpr int NITEMS = I_AIN + I_SQ + I_BIN;
            static_assert(NITEMS % pg8::GRID == 0, "item list per workgroup");
            for (;;) {
                int k = 0; if (lane == 0) k = __hip_atomic_fetch_add(ctr, 1, __ATOMIC_RELAXED, __HIP_MEMORY_SCOPE_WORKGROUP);
                k = __builtin_amdgcn_readfirstlane(k); if (k >= NITEMS / pg8::GRID) break;
                int r = vcu + pg8::GRID * k;
                if (r < I_AIN) { p0_transpose_item(ap->in[I_AWIN], DM, A_IN, WA_IN, scr, r, lane, 2560); continue; } r -= I_AIN;
                if (r < I_SQ) { p0_transpose_item(ap->in[I_AWOUT], DM, DM, WA_OUT, scr, r, lane, 0); continue; } r -= I_SQ;
                p0_transpose_item(ap->in[I_BWIN], DM, B_IN, WB_IN, scr, r, lane, 4096);
            }
        }
        for (int it = gt_; it < 96 * 32; it += NGT) { const int pos = it >> 5, j = it & 31; const float freq = powf(10000.0f, -(float)j / 32.0f); const float p = (float)(pos < 32 ? pos : pos - 32);
            float s, c; sincos_d(p * freq, s, c); tabc[it] = c; tabs[it] = s; }
        for (int it = gt_; it < 2 * DM; it += NGT) { const float lam = ap->in[I_RLAM][it]; const float z = -lam; const float sp = fmaxf(z, 0.f) + log1pf(__expf(-fabsf(z))); c8t[it] = 8.0f * sp; }
    }
    else if constexpr (KIND == K_MODRED) {
        mods_reduce(ap, ws, 0, gt_, NGT); mods_reduce(ap, ws, 1, gt_, NGT);
    }
    else if constexpr (KIND == K_PRE0) {
        { const float* gsrc = ap->in[I_NORMG];
          for (int row = gw; row < MROWS; row += NGW) {
            const int b = row / TT, t = row - b * TT; const float* mrow = mods + (size_t)(t < CTXL ? 4 : b) * 6144;
            const float* xsrc = (t < CTXL) ? ap->in[I_CTX] + (size_t)(b * CTXL + t) * DM : ap->in[I_X] + (size_t)(b * SEQ + t - CTXL) * DM;
            const f32x4* xr = (const f32x4*)xsrc + lane; f32x4 v[8]; float s = 0.f;
#pragma unroll
            for (int j = 0; j < 8; ++j) { v[j] = xr[64 * j]; s += (v[j].x * v[j].x + v[j].y * v[j].y) + (v[j].z * v[j].z + v[j].w * v[j].w); }
            s = wave_sum(s);
            if (lane < 32) SSQ[(size_t)row * 32 + lane] = (lane == 0) ? s : 0.f;
            u32x2* o8 = (u32x2*)(H + (size_t)row * DM) + lane;
#pragma unroll
            for (int j = 0; j < 8; ++j) { const int c = 4 * lane + 256 * j; const f32x4 g = *(const f32x4*)(gsrc + c), sc = *(const f32x4*)(mrow + DM + c);
                const f32x4 y = v[j] * g * (sc + 1.0f); u32x2 w; w.x = pk2(y.x, y.y); w.y = pk2(y.z, y.w); o8[64 * j] = w; }
          } }
        for (int l = 0; l < 2; ++l) {
            LAS float* shl = (LAS float*)ldsl;
            __syncthreads();
            for (int i = tid; i < 5 * DM; i += NWAVES * 64) { const int r = i >> 11, k = i & (DM - 1); shl[i] = mods[(size_t)(l * 5 + r) * 6144 + k]; }
            __syncthreads();
            const bf16_t* Wt = (l == 0) ? WA_IN : (l == 3) ? WA_IN + (size_t)A_IN * DM : (l == 1) ? WB_IN : WR_IN; const int N = (l == 1) ? B_IN : (l == 2) ? R_IN : A_IN;
            for (int n = gw; n < N; n += NGW) { float a0 = 0.f, a1 = 0.f, a2 = 0.f, a3 = 0.f, a4 = 0.f;
#pragma unroll
                for (int j = 0; j < 4; ++j) { const int k0 = j * 512 + lane * 8; const u32x4 w = *(const u32x4*)(Wt + (size_t)n * DM + k0);
                    const float wf[8] = {bflo(w.x), bfhi(w.x), bflo(w.y), bfhi(w.y), bflo(w.z), bfhi(w.z), bflo(w.w), bfhi(w.w)};
#pragma unroll
                    for (int e = 0; e < 8; ++e) { a0 += wf[e] * shl[k0 + e]; a1 += wf[e] * shl[DM + k0 + e]; a2 += wf[e] * shl[2 * DM + k0 + e]; a3 += wf[e] * shl[3 * DM + k0 + e]; a4 += wf[e] * shl[4 * DM + k0 + e]; } }
                a0 = wave_sum(a0); a1 = wave_sum(a1); a2 = wave_sum(a2); a3 = wave_sum(a3); a4 = wave_sum(a4);
                if (lane == 0) { float* o = SHW + (size_t)l * 5 * 8192 + n; o[0] = a0; o[8192] = a1; o[2 * 8192] = a2; o[3 * 8192] = a3; o[4 * 8192] = a4; } }
        }
    }
    else if constexpr (KIND == K_GEMM_BF16) {
        constexpr size_t OB = (layer == 0) ? WS_WA_IN : (layer == 3) ? WS_WA_IN + (size_t)A_IN * DM * 2 : (layer == 1) ? WS_WB_IN : WS_WR_IN;
        constexpr int N = (layer == 1) ? B_IN : (layer == 2) ? R_IN : A_IN;
        pg8::EpiBf16<layer, N> E{ws, ap};
        if constexpr (layer == 0) {
            typedef pg8::Sched<MROWS / 256, N / 256, DM / 64, 0, 0, TAIL_SPLIT> SchedT; SchedT S; S.init(bx, vcu);
            pg8::gemm_phase<pg8::EpiBf16<layer, N>, SchedT, DM / 64, PH, WS_H, OB>(ldsl, tid, S, E);
            if constexpr (!DUPRUN && SchedT::F == 1 && SchedT::T > 0) { int bx, wave, lane; fresh_ids(ldsl, bx, wave, lane); const int tid = wave * 64 + lane; if (bx >= SchedT::T) {
                CArgsP ap2 = (CArgsP)__builtin_amdgcn_kernarg_segment_ptr(); asm volatile("" : "+s"(ap2)); const CArgsP ap = ap2; unsigned char* const ws = ap2->ws;
                const int widx = (bx - SchedT::T) * NWAVES + wave, nw = (pg8::GRID - SchedT::T) * NWAVES;
                LAS float* sil = (LAS float*)ldsl; ada_fill_sil(ap, sil, tid); __syncthreads(); ada_layer(ap, ws, sil, 2, lane, widx, nw); ada_layer(ap, ws, sil, 3, lane, widx, nw); } }
        } else {
            constexpr int CLO = (layer == 3) ? 8 : 0, CHI = (layer == 3) ? 12 : N / 256;
            typedef pg8::SchedM<N / 256, DM / 64, CLO, CHI> SchedT; SchedT S; S.init(bx, vcu);
            constexpr size_t OB0 = (layer == 1) ? WS_WA_OUT : (layer == 2) ? WS_WB_OUT : WS_WR_OUT;
            pg8::EpiResid<layer - 1, false> E0{ws, ap};
            pg8::gemm_phase<pg8::EpiBf16<layer, N>, SchedT, DM / 64, PH, WS_H, OB, pg8::EpiResid<layer - 1, false>, WS_Y, OB0>(ldsl, tid, S, E, E0);
            if constexpr (!DUPRUN && SchedT::T > 0) { int bx, wave, lane; fresh_ids(ldsl, bx, wave, lane); const int tid = wave * 64 + lane; (void)tid; if (bx < SchedT::SH || bx >= SchedT::SH + SchedT::T) {
                CArgsP ap2 = (CArgsP)__builtin_amdgcn_kernarg_segment_ptr(); asm volatile("" : "+s"(ap2)); const CArgsP ap = ap2; unsigned char* const ws = ap2->ws;
                const int widx = ((bx < SchedT::SH) ? bx : bx - SchedT::T) * NWAVES + wave, nw = (pg8::GRID - SchedT::T) * NWAVES;
                if constexpr (layer == 1) { conv_job(ap->in[I_BWOUT], DM, (bf16_t*)(ws + WS_WB_OUT), 0, 0, ws, ldsl, wave, lane, widx, nw); conv_job(ap->in[I_RWIN], R_IN, (bf16_t*)(ws + WS_WR_IN), 0, 2, ws, ldsl, wave, lane, widx, nw); }
                if constexpr (layer == 2) { conv_job(ap->in[I_RWOUT], DM, (bf16_t*)(ws + WS_WR_OUT), 0, 0, ws, ldsl, wave, lane, widx, nw); conv_job(ap->in[I_AWIN] + (size_t)DM * A_IN, A_IN, (bf16_t*)(ws + WS_WA_IN) + (size_t)A_IN * DM, 2560, 3, ws, ldsl, wave, lane, widx, nw);
                    conv_job(ap->in[I_AWOUT] + (size_t)DM * DM, DM, (bf16_t*)(ws + WS_WA_OUT) + (size_t)DM * DM, 0, 0, ws, ldsl, wave, lane, widx, nw);
                    LAS bf16_t* scr = (LAS bf16_t*)(ldsl + wave * 16384);
                    for (int it = widx; it < 32 * 16; it += nw) { const int mtx = it >> 4, sub = it & 15; const int gate = mtx >> 4, dir = (mtx >> 3) & 1, nblk = mtx & 7;
                        p0_transpose_item((gate ? ap->in[I_RWX] : ap->in[I_RWA]) + (size_t)(dir * 8 + nblk) * 65536, 256, 256, (bf16_t*)(ws + WS_WG), scr, sub, lane, -(mtx + 1)); } } } }
        }
    }
    else if constexpr (KIND == K_GEMM_RES) {
        constexpr size_t OB = (layer == 0) ? WS_WA_OUT : (layer == 3) ? WS_WA_OUT + (size_t)DM * DM * 2 : (layer == 1) ? WS_WB_OUT : WS_WR_OUT;
        if constexpr ((layer == 1 || layer == 2) && !DUPRUN) {
            constexpr int LN = layer + 1, NN_ = (LN == 2) ? R_IN : A_IN;
            const float* pp = (const float*)(ws + WS_SHWP) + (size_t)(LN - 1) * 32 * 5 * 8192; float* dst = SHW + (size_t)LN * 5 * 8192;
            for (int i = gt_; i < 5 * NN_; i += NGT) { const int r = i / NN_, n = i - r * NN_; float pv[32];
#pragma unroll
                for (int kb = 0; kb < 32; ++kb) pv[kb] = pp[(size_t)kb * 5 * 8192 + (size_t)r * 8192 + n];
                float sv = 0.f;
#pragma unroll
                for (int kb = 0; kb < 32; ++kb) sv += pv[kb];
                dst[(size_t)r * 8192 + n] = sv; }
        }
        if constexpr (layer == 1 && !DUPRUN) {
            float s1 = ap->in[I_BLAM][lane] * ap->in[I_BLAM][128 + lane] + ap->in[I_BLAM][64 + lane] * ap->in[I_BLAM][192 + lane];
            float s2 = ap->in[I_BLAM][256 + lane] * ap->in[I_BLAM][384 + lane] + ap->in[I_BLAM][320 + lane] * ap->in[I_BLAM][448 + lane];
            s1 = wave_sum(s1); s2 = wave_sum(s2);
            const float lam = expf(s1) - expf(s2) + LAM_INIT1;
            const int hsel = lane >> 5, j = lane & 31;
            for (int it = gw; it < NB * CTXL * 4; it += NGW) { const int cr = it >> 2, row = (cr >> 8) * TT + (cr & 255), h = (it & 3) * 2 + hsel;
                const u32x4 r0 = *(const u32x4*)(OD + (size_t)row * 4096 + h * 256 + j * 8), r1 = *(const u32x4*)(OD + (size_t)row * 4096 + (8 + h) * 256 + j * 8), zr = *(const u32x4*)(U + (size_t)row * B_IN + 6144 + h * 256 + j * 8);
                float o[8] = {bflo(r0.x) - lam * bflo(r1.x), bfhi(r0.x) - lam * bfhi(r1.x), bflo(r0.y) - lam * bflo(r1.y), bfhi(r0.y) - lam * bfhi(r1.y),
                              bflo(r0.z) - lam * bflo(r1.z), bfhi(r0.z) - lam * bfhi(r1.z), bflo(r0.w) - lam * bflo(r1.w), bfhi(r0.w) - lam * bfhi(r1.w)};
                const float z[8] = {bflo(zr.x), bfhi(zr.x), bflo(zr.y), bfhi(zr.y), bflo(zr.z), bfhi(zr.z), bflo(zr.w), bfhi(zr.w)};
                float ss = 0.f;
#pragma unroll
                for (int k = 0; k < 8; ++k) ss += o[k] * o[k];
                ss += shx<1>(ss); ss += shx<2>(ss); ss += shx<4>(ss); ss += shx<8>(ss); ss += shx<16>(ss);
                const float rstd = frsq(ss * (1.0f / 256.0f) + EPS); const float* sg = ap->in[I_BSUBG] + j * 8;
#pragma unroll
                for (int k = 0; k < 8; ++k) o[k] = (o[k] * rstd * sg[k]) * (1.0f - LAM_INIT1) * siluf_(z[k]);
                u32x4 w; w.x = pk2(o[0], o[1]); w.y = pk2(o[2], o[3]); w.z = pk2(o[4], o[5]); w.w = pk2(o[6], o[7]);
                *(u32x4*)(Y + (size_t)row * DM + h * 256 + j * 8) = w; }
        }
        typedef pg8::Sched<32, DM / 256, DM / 64, 1, 0, TAIL_SPLIT> SchedT; SchedT S; S.init(bx, vcu);
        pg8::EpiResid<layer, DUPRUN> E{ws, ap};
        pg8::gemm_phase<pg8::EpiResid<layer, DUPRUN>, SchedT, DM / 64, PH, WS_Y, OB>(ldsl, tid, S, E);
    }
    else if constexpr (KIND == K_GEMM_GATES) {
        typedef pg8::Sched<MROWS / 256, 32, 4, 0, 1, false> SchedT; SchedT S; S.init(bx, vcu);
        pg8::EpiGates E{ws, ap};
        pg8::gemm_phase<pg8::EpiGates, SchedT, 4, PH, WS_UP, WS_WG>(ldsl, tid, S, E);
    }
    else if constexpr (KIND == K_ATT_A) {
        if constexpr (layer == 0 && !DUPRUN) { mods_reduce(ap, ws, 2, gt_, NGT); mods_reduce(ap, ws, 3, gt_, NGT); }
        const int nlat = 512, ntot = (layer == 0) ? 576 : 512;
        for (int u = vcu; u < ntot; u += G) {
            int b, h, qrow, seq;
            if (u < nlat) { const int qb = u & 7, hh = (u >> 3) & 15; b = u >> 7; h = hh; qrow = b * TT + CTXL + qb * 256; seq = TT; }
            else { const int v = u - nlat; b = v >> 4; h = v & 15; qrow = b * TT; seq = CTXL; }
            const int g4 = h >> 2;
            const bf16_t* Qb = U + (size_t)qrow * A_IN + h * 128;
            const bf16_t* Kh = U + (size_t)(b * TT) * A_IN + 2048 + g4 * 128;
            const bf16_t* Vh = U + (size_t)(b * TT) * A_IN + 2560 + g4 * 128;
            const bf16_t* Zb = U + (size_t)qrow * A_IN + 3072 + h * 128;
            att::attn_unit_dma<A_IN, DM, true>(Qb, Kh, Vh, Y + (size_t)qrow * DM + h * 128, Zb, seq, ldsg, tid);
        }
    }
    else if constexpr (KIND == K_ATT_B) {
        float s1 = ap->in[I_BLAM][lane] * ap->in[I_BLAM][128 + lane] + ap->in[I_BLAM][64 + lane] * ap->in[I_BLAM][192 + lane];
        float s2 = ap->in[I_BLAM][256 + lane] * ap->in[I_BLAM][384 + lane] + ap->in[I_BLAM][320 + lane] * ap->in[I_BLAM][448 + lane];
        s1 = wave_sum(s1); s2 = wave_sum(s2);
        const float lam = expf(s1) - expf(s2) + LAM_INIT1;
        for (int u = vcu; u < 640; u += G) {
            if (u < 512) { const int qb = u & 15, h = (u >> 4) & 7, b = u >> 7; att::attn_unit_pair<B_IN, 4096>(ws, ap, lam, b * TT + CTXL + qb * 128, b, h, TT, ldsg, tid); }
            else { const int v = u - 512; const int m = v & 1, qh = (v >> 1) & 1, h = (v >> 2) & 7, b = v >> 5; att::attn_unit_pair_one<B_IN, 4096>(ws, ap, b * TT + qh * 128, b, h, m, CTXL, ldsg, tid); }
        }
    }
    else if constexpr (KIND == K_COMBINE) {
        float s1 = ap->in[I_BLAM][lane] * ap->in[I_BLAM][128 + lane] + ap->in[I_BLAM][64 + lane] * ap->in[I_BLAM][192 + lane];
        float s2 = ap->in[I_BLAM][256 + lane] * ap->in[I_BLAM][384 + lane] + ap->in[I_BLAM][320 + lane] * ap->in[I_BLAM][448 + lane];
        s1 = wave_sum(s1); s2 = wave_sum(s2);
        const float lam = expf(s1) - expf(s2) + LAM_INIT1;
        const int hsel = lane >> 5, j = lane & 31;
        for (int it0 = gw; it0 < MROWS * 4; it0 += 2 * NGW) {
            u32x4 r0v[2], r1v[2], zrv[2]; bool ok[2];
#pragma unroll
            for (int q = 0; q < 2; ++q) { const int it = it0 + q * NGW; ok[q] = it < MROWS * 4; const int itc = ok[q] ? it : 0; const int row = itc >> 2, h = (itc & 3) * 2 + hsel;
                r0v[q] = *(const u32x4*)(OD + (size_t)row * 4096 + h * 256 + j * 8); r1v[q] = *(const u32x4*)(OD + (size_t)row * 4096 + (8 + h) * 256 + j * 8); zrv[q] = *(const u32x4*)(U + (size_t)row * B_IN + 6144 + h * 256 + j * 8); }
#pragma unroll
            for (int q = 0; q < 2; ++q) if (ok[q]) { const int it = it0 + q * NGW; const int row = it >> 2, h = (it & 3) * 2 + hsel; const u32x4 r0 = r0v[q], r1 = r1v[q], zr = zrv[q];
                float o[8] = {bflo(r0.x) - lam * bflo(r1.x), bfhi(r0.x) - lam * bfhi(r1.x), bflo(r0.y) - lam * bflo(r1.y), bfhi(r0.y) - lam * bfhi(r1.y),
                              bflo(r0.z) - lam * bflo(r1.z), bfhi(r0.z) - lam * bfhi(r1.z), bflo(r0.w) - lam * bflo(r1.w), bfhi(r0.w) - lam * bfhi(r1.w)};
                const float z[8] = {bflo(zr.x), bfhi(zr.x), bflo(zr.y), bfhi(zr.y), bflo(zr.z), bfhi(zr.z), bflo(zr.w), bfhi(zr.w)};
                float ss = 0.f;
#pragma unroll
                for (int k = 0; k < 8; ++k) ss += o[k] * o[k];
                ss += shx<1>(ss); ss += shx<2>(ss); ss += shx<4>(ss); ss += shx<8>(ss); ss += shx<16>(ss);
                const float rstd = frsq(ss * (1.0f / 256.0f) + EPS); const float* sg = ap->in[I_BSUBG] + j * 8;
#pragma unroll
                for (int k = 0; k < 8; ++k) o[k] = (o[k] * rstd * sg[k]) * (1.0f - LAM_INIT1) * siluf_(z[k]);
                u32x4 w; w.x = pk2(o[0], o[1]); w.y = pk2(o[2], o[3]); w.z = pk2(o[4], o[5]); w.w = pk2(o[6], o[7]);
                *(u32x4*)(Y + (size_t)row * DM + h * 256 + j * 8) = w; }
        }
    }
    else if constexpr (KIND == K_CONV) {
        const int c8 = (gt_ & 255) * 8;
        f32x4 wv[4][2], bv[2];
#pragma unroll
        for (int jj = 0; jj < 4; ++jj) { wv[jj][0] = *(const f32x4*)(ap->in[I_RCONVW] + jj * DM + c8); wv[jj][1] = *(const f32x4*)(ap->in[I_RCONVW] + jj * DM + c8 + 4); }
        bv[0] = *(const f32x4*)(ap->in[I_RCONVB] + c8); bv[1] = *(const f32x4*)(ap->in[I_RCONVB] + c8 + 4);
        for (int it = gt_; it < (MROWS / 4) * 256; it += NGT) {
            const int row0 = (it >> 8) * 4; const int b = row0 / TT, t0 = row0 - b * TT; const int lo = (t0 < CTXL) ? 0 : CTXL, hi_ = (t0 < CTXL) ? CTXL : TT;
            u32x4 rv[7];
#pragma unroll
            for (int q = 0; q < 7; ++q) { const int ts = t0 + q - 2; rv[q] = (ts >= lo && ts < hi_) ? *(const u32x4*)(U + (size_t)(b * TT + ts) * R_IN + c8) : (u32x4){0u, 0u, 0u, 0u}; }
#pragma unroll
            for (int r = 0; r < 4; ++r) { f32x4 a0 = bv[0], a1 = bv[1];
#pragma unroll
                for (int jj = 0; jj < 4; ++jj) { const u32x4 x = rv[r + jj]; a0 += (f32x4){bflo(x.x), bfhi(x.x), bflo(x.y), bfhi(x.y)} * wv[jj][0]; a1 += (f32x4){bflo(x.z), bfhi(x.z), bflo(x.w), bfhi(x.w)} * wv[jj][1]; }
                u32x4 o; o.x = pk2(a0.x, a0.y); o.y = pk2(a0.z, a0.w); o.z = pk2(a1.x, a1.y); o.w = pk2(a1.z, a1.w);
                *(u32x4*)(UP + (size_t)(row0 + r) * DM + c8) = o; }
        }
    }
    else if constexpr (KIND == K_SCAN_AGG) {
        const float* __restrict__ AGA = (const float*)(ws + WS_AG16); const float* __restrict__ AGB = AGA + (size_t)576 * 2 * DM; float* __restrict__ CAR = (float*)(ws + WS_CARRY);
        if (wave == 0 && vcu < 256) { const int b = vcu >> 6, dir = (vcu >> 5) & 1, ch = (vcu & 31) * 64 + lane; float h = 0.f;
            for (int k = 0; k < 9; ++k) {
                float av[16], bv[16]; unsigned off[16];
#pragma unroll
                for (int j = 0; j < 16; ++j) { const int q = 16 * k + j; const int c = dir ? (q < 16 ? 15 - q : 159 - q) : q; off[j] = (unsigned)(((b * 144 + c) * 2 + dir) * DM + ch); av[j] = AGA[off[j]]; bv[j] = AGB[off[j]]; }
#pragma unroll
                for (int j = 0; j < 16; ++j) { CAR[off[j]] = h; h = fmaf(av[j], h, bv[j]); }
            } }
    }
    else if constexpr (KIND == K_SCAN_APPLY) {
        const float* __restrict__ CAR = (const float*)(ws + WS_CARRY); const unsigned* __restrict__ SABr = SAB; const bf16_t* __restrict__ Ur = U; bf16_t* __restrict__ Yr = Y;
        for (int it = gt_; it < 576 * 512; it += NGT) {
            const int c4 = it & 511, g = it >> 9; const unsigned r0 = (unsigned)g * 16u;
            f32x4 hf = *(const f32x4*)(CAR + ((size_t)g * 2) * DM + c4 * 4), hr = *(const f32x4*)(CAR + ((size_t)g * 2 + 1) * DM + c4 * 4);
            u32x4 wf[16], wrv[16]; u32x2 zr[16];
#pragma unroll
            for (int s = 0; s < 16; ++s) { wf[s] = *(const u32x4*)(SABr + ((size_t)(r0 + s) * 2) * DM + c4 * 4); wrv[s] = *(const u32x4*)(SABr + ((size_t)(r0 + s) * 2 + 1) * DM + c4 * 4); zr[s] = *(const u32x2*)(Ur + (size_t)(r0 + s) * R_IN + DM + c4 * 4); }
            f32x4 hfv[16];
#pragma unroll
            for (int s = 0; s < 16; ++s) { const u32x4 w = wf[s];
                const f32x4 a = {__expf(bflo(w.x)), __expf(bflo(w.y)), __expf(bflo(w.z)), __expf(bflo(w.w))}, bb = {bfhi(w.x), bfhi(w.y), bfhi(w.z), bfhi(w.w)}; hf = a * hf + bb; hfv[s] = hf; }
#pragma unroll
            for (int s = 15; s >= 0; --s) { const u32x4 w = wrv[s];
                const f32x4 a = {__expf(bflo(w.x)), __expf(bflo(w.y)), __expf(bflo(w.z)), __expf(bflo(w.w))}, bb = {bfhi(w.x), bfhi(w.y), bfhi(w.z), bfhi(w.w)}; hr = a * hr + bb;
                const f32x4 y = hfv[s] + hr;
                u32x2 o; o.x = pk2(y.x * siluf_(bflo(zr[s].x)), y.y * siluf_(bfhi(zr[s].x))); o.y = pk2(y.z * siluf_(bflo(zr[s].y)), y.w * siluf_(bfhi(zr[s].y)));
                *(u32x2*)(Yr + (size_t)(r0 + s) * DM + c4 * 4) = o; }
        }
    }
    else {
        const float* gsrc = ap->in[I_NORMF];
        for (int r = gw; r < NB * SEQ; r += NGW) {
            const int b = r >> 11, t = r & (SEQ - 1); const size_t row = (size_t)b * TT + CTXL + t;
            const f32x4* xr = (const f32x4*)(X + row * DM) + lane; f32x4 v[8]; float s = 0.f;
#pragma unroll
            for (int j = 0; j < 8; ++j) { v[j] = xr[64 * j]; s += (v[j].x * v[j].x + v[j].y * v[j].y) + (v[j].z * v[j].z + v[j].w * v[j].w); }
            const float rstd = 1.0f / sqrtf(wave_sum(s) * (1.0f / DM) + EPS);
            f32x4* o = (f32x4*)(ap->out + (size_t)r * DM) + lane;
#pragma unroll
            for (int j = 0; j < 8; ++j) { const f32x4 g = *(const f32x4*)(gsrc + 4 * lane + 256 * j); o[64 * j] = (v[j] * rstd) * g; }
        }
    }
}

constexpr int N_PHASES_C = 19;
__global__ void __launch_bounds__(NWAVES * 64, 2) fwd_mega(Args args) {
    extern __shared__ __attribute__((aligned(16))) unsigned char lds[];
    LAS unsigned char* ldsl0 = (LAS unsigned char*)lds;
    for (int u = threadIdx.x; u < (LDS_BYTES - LDSCTL_OFF) / 4; u += NWAVES * 64) ((LAS unsigned*)(ldsl0 + LDSCTL_OFF))[u] = 0u;
    __syncthreads();
    { const int wv = __builtin_amdgcn_readfirstlane((int)threadIdx.x >> 6); if ((threadIdx.x & 63) == 0) ((volatile LAS unsigned*)(ldsl0 + LDSCTL_OFF))[hw_slot()] = (unsigned)wv;
      if (threadIdx.x == 0) ((volatile LAS unsigned*)(ldsl0 + MISC_OFF))[12] = blockIdx.x;
      if (!MK_PER_PHASE) (void)xcd_barrier_post((unsigned*)((gu32*)(args.ws + WS_CTL) + CW_BAR), (volatile LAS unsigned*)(ldsl0 + MISC_OFF) + 8, threadIdx.x == 0); }
    __syncthreads();
#define WAVE_IDX() ((int)__builtin_amdgcn_readfirstlane((int)((volatile LAS unsigned*)((LAS unsigned char*)lds + LDSCTL_OFF))[hw_slot()]))
#define KARG() ({ CArgsP ap_ = (CArgsP)__builtin_amdgcn_kernarg_segment_ptr(); asm volatile("" : "+s"(ap_)); ap_; })
#define GRID_BAR() do { CArgsP ap_ = KARG(); XcdBarrier b_; b_.bar = (unsigned*)((gu32*)(ap_->ws + WS_CTL) + CW_BAR); b_.x = xb_xcc_id(); b_.st = (volatile LAS unsigned*)((LAS unsigned char*)lds + MISC_OFF) + 8; xcd_barrier(b_, WAVE_IDX()); } while (0)
#if MK_PER_PHASE
#define PHASE(k, KIND, LAYER) if constexpr ((PH_MASK >> (k)) & 1) { CArgsP apq_ = KARG(); const int lo = apq_->ph_lo, hi = apq_->ph_hi; if (lo <= (k) && (k) < hi) { run_phase<KIND, LAYER, (k)>((char*)lds, WAVE_IDX()); } }
#else
#define PHASE(k, KIND, LAYER) if constexpr ((PH_MASK >> (k)) & 1) { run_phase<KIND, LAYER, (k)>((char*)lds, WAVE_IDX()); \
        if constexpr ((DUP_MASK >> (k)) & 1) { GRID_BAR(); run_phase<KIND, LAYER, 24 + ((k) & 7), true>((char*)lds, WAVE_IDX()); } \
        if constexpr ((k) + 1 < N_PHASES_C) { GRID_BAR(); if (DUP_BAR) GRID_BAR(); } }
#endif
    PHASE(0, K_PRO, 0) PHASE(1, K_MODRED, 0) PHASE(2, K_PRE0, 0)
    PHASE(3, K_GEMM_BF16, 0) PHASE(4, K_ATT_A, 0) PHASE(5, K_GEMM_RES, 0)
    PHASE(6, K_GEMM_BF16, 1) PHASE(7, K_ATT_B, 1) PHASE(9, K_GEMM_RES, 1)
    PHASE(10, K_GEMM_BF16, 2) PHASE(11, K_CONV, 2) PHASE(12, K_GEMM_GATES, 2) PHASE(13, K_SCAN_AGG, 2) PHASE(14, K_SCAN_APPLY, 2) PHASE(15, K_GEMM_RES, 2)
    PHASE(16, K_GEMM_BF16, 3) PHASE(17, K_ATT_A, 3) PHASE(18, K_GEMM_RES, 3)
#undef PHASE
#undef GRID_BAR
#undef KARG
#undef WAVE_IDX
}

constexpr int N_PHASES = N_PHASES_C;
extern "C" void kernel_launch(void* const* d_in, const int* in_sizes, int n_in, void* d_out, int out_size, void* d_ws, size_t ws_size, hipStream_t stream) {
    static int grid = 0;
    if (grid == 0) {
        if (n_in != 25 || in_sizes[0] != NB * SEQ * DM || out_size != NB * SEQ * DM || ws_size < WS_END) {
            fprintf(stderr, "kernel_launch: unexpected shapes: n_in %d in0 %d out %d ws %zu (need %zu)\n", n_in, n_in > 0 ? in_sizes[0] : -1, out_size, ws_size, (size_t)WS_END); grid = -1; return; }
        int dev = 0, cus = 0, per_cu = 0;
        if (hipGetDevice(&dev) != hipSuccess || hipDeviceGetAttribute(&cus, hipDeviceAttributeMultiprocessorCount, dev) != hipSuccess) { fprintf(stderr, "kernel_launch: device query failed\n"); grid = -1; return; }
        if (hipFuncSetAttribute((const void*)fwd_mega, hipFuncAttributeMaxDynamicSharedMemorySize, LDS_BYTES) != hipSuccess) { fprintf(stderr, "kernel_launch: hipFuncSetAttribute failed\n"); grid = -1; return; }
        if (hipOccupancyMaxActiveBlocksPerMultiprocessor(&per_cu, (const void*)fwd_mega, NWAVES * 64, LDS_BYTES) != hipSuccess || per_cu < 1) { fprintf(stderr, "kernel_launch: occupancy query says %d blocks/CU\n", per_cu); grid = -1; (void)hipGetLastError(); return; }
        if (cus != 256) { fprintf(stderr, "kernel_launch: built for a 256-CU device (MI355X), found %d CUs; nothing launched\n", cus); grid = -1; return; }
        grid = cus;
    }
    if (grid < 0) return;
    (void)hipMemsetAsync((char*)d_ws + WS_CTL, 0, CTL_ZERO_BYTES, stream);
    Args a{};
    for (int i = 0; i < 25; ++i) a.in[i] = (const float*)d_in[i];
    a.out = (float*)d_out; a.ws = (unsigned char*)d_ws;
#if MK_PER_PHASE
    for (int p = 0; p < N_PHASES; ++p) { a.ph_lo = p; a.ph_hi = p + 1; hipLaunchKernelGGL(fwd_mega, dim3(grid), dim3(NWAVES * 64), LDS_BYTES, stream, a); }
#else
    a.ph_lo = 0; a.ph_hi = N_PHASES;
    void* kargs[] = {&a};
    hipError_t e = hipLaunchCooperativeKernel((const void*)fwd_mega, dim3(grid), dim3(NWAVES * 64), kargs, LDS_BYTES, stream);
    if (e != hipSuccess) fprintf(stderr, "kernel_launch: cooperative launch failed: %s (grid %d)\n", hipGetErrorString(e), grid);
#endif
}
```
